# Optimizing an MI355X kernel written in HIP

```python
import jax, jax.numpy as jnp
from jax import lax
import numpy as np

D_MODEL = 1024
BATCH = 8
SEQ = 4096
DEPTH = 1

ATTN_HEADS = 8
ATTN_WIDTH = D_MODEL // 2
ATTN_HEAD_DIM = ATTN_WIDTH // ATTN_HEADS
MLSTM_HEADS = 4
MLSTM_WIDTH = D_MODEL - ATTN_WIDTH
MLSTM_HEAD_DIM = MLSTM_WIDTH // MLSTM_HEADS
IN_COLS = 3 * ATTN_WIDTH + 2 * MLSTM_WIDTH
CONV_WIDTH = 4
MLSTM_CHUNK = 64
MOBA_BLOCK = 256
MOBA_TOPK = 3
MOBA_QCHUNK = 32
D_FF = ((8 * D_MODEL // 3 + 127) // 128) * 128
N_MOD = 9
EPS = 1e-6

kernel_name = 'hymba_moba_mlstm_macaron_adaln'


def rmsnorm(x, g):
    xf = x.astype(jnp.float32)
    y = xf * lax.rsqrt(jnp.mean(xf * xf, axis=-1, keepdims=True) + EPS)
    return (y * g.astype(jnp.float32)).astype(x.dtype)


def modulate(h, shift, scale):
    return h * (1 + scale) + shift


def swiglu(h, w_gate, w_up, w_down):
    return (jax.nn.silu(h @ w_gate) * (h @ w_up)) @ w_down


def causal_depthwise_conv(x, w, b):
    C = x.shape[-1]
    out = lax.conv_general_dilated(x, w[:, None, :], window_strides=(1,),
                                   padding=((CONV_WIDTH - 1, 0),),
                                   dimension_numbers=('NWC', 'WIO', 'NWC'),
                                   feature_group_count=C)
    return out + b


def moba_attention(q, k, v):
    B, H, S, d = q.shape
    s_pad = -(-S // MOBA_BLOCK) * MOBA_BLOCK
    pad = s_pad - S
    if pad:
        padw = ((0, 0), (0, 0), (0, pad), (0, 0))
        q, k, v = jnp.pad(q, padw), jnp.pad(k, padw), jnp.pad(v, padw)
    nb = s_pad // MOBA_BLOCK
    topk = min(MOBA_TOPK, nb)
    k_blocks = k.reshape(B, H, nb, MOBA_BLOCK, d)
    v_blocks = v.reshape(B, H, nb, MOBA_BLOCK, d)
    k_mean = jnp.mean(k_blocks.astype(jnp.float32), axis=3)
    gate = jnp.einsum('bhsd,bhnd->bhsn', q.astype(jnp.float32), k_mean)
    q_block = jnp.arange(s_pad) // MOBA_BLOCK
    fully_past = jnp.arange(nb)[None, :] < q_block[:, None]
    gate = jnp.where(fully_past, gate, -jnp.inf)
    top_val, top_idx = lax.top_k(gate, topk)
    sel_valid = jnp.isfinite(top_val)

    n_chunks = s_pad // MOBA_QCHUNK

    def to_chunks(a):
        return jnp.moveaxis(a.reshape(B, H, n_chunks, MOBA_QCHUNK, *a.shape[3:]), 2, 0)

    b_idx = jnp.arange(B)[:, None, None]
    h_idx = jnp.arange(H)[None, :, None]
    scale = d ** -0.5
    n_sel = topk * MOBA_BLOCK

    def attend_chunk(args):
        q_c, idx_c, valid_c, ci = args
        blk = ci * MOBA_QCHUNK // MOBA_BLOCK
        flat = idx_c.reshape(B, H, MOBA_QCHUNK * topk)
        k_sel = k_blocks[b_idx, h_idx, flat].reshape(B, H, MOBA_QCHUNK, n_sel, d)
        v_sel = v_blocks[b_idx, h_idx, flat].reshape(B, H, MOBA_QCHUNK, n_sel, d)
        s_sel = jnp.einsum('bhqd,bhqnd->bhqn', q_c, k_sel).astype(jnp.float32) * scale
        s_sel = jnp.where(jnp.repeat(valid_c, MOBA_BLOCK, axis=-1), s_sel, -jnp.inf)
        k_own = lax.dynamic_index_in_dim(k_blocks, blk, axis=2, keepdims=False)
        v_own = lax.dynamic_index_in_dim(v_blocks, blk, axis=2, keepdims=False)
        s_own = jnp.einsum('bhqd,bhkd->bhqk', q_c, k_own).astype(jnp.float32) * scale
        q_pos = ci * MOBA_QCHUNK + jnp.arange(MOBA_QCHUNK)
        k_pos = blk * MOBA_BLOCK + jnp.arange(MOBA_BLOCK)
        s_own = jnp.where(k_pos[None, :] <= q_pos[:, None], s_own, -jnp.inf)
        p = jax.nn.softmax(jnp.concatenate([s_sel, s_own], axis=-1), axis=-1).astype(v.dtype)
        return (jnp.einsum('bhqn,bhqnd->bhqd', p[..., :n_sel], v_sel)
                + jnp.einsum('bhqk,bhkd->bhqd', p[..., n_sel:], v_own))

    out = lax.map(attend_chunk, (to_chunks(q), to_chunks(top_idx), to_chunks(sel_valid),
                                 jnp.arange(n_chunks)))
    out = jnp.moveaxis(out, 0, 2).reshape(B, H, s_pad, d)
    return out[:, :, :S]


def mlstm_chunkwise(q, k, v, i_pre, log_f):
    B, H, S, d = q.shape
    L = MLSTM_CHUNK
    nc = S // L

    def chunks(a):
        return jnp.moveaxis(a.reshape(B, H, nc, L, *a.shape[3:]), 2, 0)

    qc, kc, vc, ic = chunks(q), chunks(k), chunks(v), chunks(i_pre)
    bc = jnp.cumsum(chunks(log_f), axis=-1)
    causal = jnp.tril(jnp.ones((L, L), dtype=bool))

    def step(carry, xs):
        C, n, m = carry
        q_, k_, v_, i_, b_ = xs
        log_d = jnp.where(causal, b_[..., :, None] - b_[..., None, :] + i_[..., None, :], -jnp.inf)
        log_inter = b_ + m[..., None]
        m_t = jnp.maximum(log_inter, jnp.max(log_d, axis=-1))
        w_intra = jnp.exp(log_d - m_t[..., None])
        w_inter = jnp.exp(log_inter - m_t)
        s = jnp.einsum('bhtd,bhsd->bhts', q_, k_) * w_intra
        num = (jnp.einsum('bhts,bhsv->bhtv', s, v_)
               + w_inter[..., None] * jnp.einsum('bhvk,bhtk->bhtv', C, q_))
        den = jnp.sum(s, axis=-1) + w_inter * jnp.einsum('bhk,bhtk->bht', n, q_)
        h = num / jnp.maximum(jnp.abs(den), jnp.exp(-m_t))[..., None]
        b_last = b_[..., -1]
        log_g = b_last[..., None] - b_ + i_
        m_new = jnp.maximum(b_last + m, jnp.max(log_g, axis=-1))
        w_g = jnp.exp(log_g - m_new[..., None])
        decay = jnp.exp(b_last + m - m_new)
        C = decay[..., None, None] * C + jnp.einsum('bhsv,bhsk->bhvk', v_ * w_g[..., None], k_)
        n = decay[..., None] * n + jnp.einsum('bhs,bhsk->bhk', w_g, k_)
        return (C, n, m_new), h

    init = (jnp.zeros((B, H, d, d), jnp.float32), jnp.zeros((B, H, d), jnp.float32),
            jnp.zeros((B, H), jnp.float32))
    _, h = lax.scan(step, init, (qc, kc, vc, ic, bc))
    return jnp.moveaxis(h, 0, 2).reshape(B, H, S, d)


def hybrid_mixer(h, w_in, conv_w, conv_b, w_q_m, w_k_m, w_v_m, w_if, b_if,
                 mlstm_norm, mlstm_skip, attn_norm, w_out):
    B, S, _ = h.shape
    proj = h @ w_in
    q_a, k_a, v_a, x_m, z = jnp.split(
        proj, [ATTN_WIDTH, 2 * ATTN_WIDTH, 3 * ATTN_WIDTH, 3 * ATTN_WIDTH + MLSTM_WIDTH], axis=-1)

    def heads_a(t):
        return t.reshape(B, S, ATTN_HEADS, ATTN_HEAD_DIM).transpose(0, 2, 1, 3)
    o_a = moba_attention(heads_a(q_a), heads_a(k_a), heads_a(v_a))
    o_a = rmsnorm(o_a.transpose(0, 2, 1, 3).reshape(B, S, ATTN_WIDTH), attn_norm)

    x_conv = jax.nn.silu(causal_depthwise_conv(x_m, conv_w, conv_b))
    def headwise(t, w):
        return jnp.einsum('bshd,hde->bshe', t.reshape(B, S, MLSTM_HEADS, MLSTM_HEAD_DIM), w)
    q_m = headwise(x_conv, w_q_m)
    k_m = headwise(x_conv, w_k_m)
    v_m = headwise(x_m, w_v_m)
    gates = (jnp.concatenate([q_m, k_m, v_m], axis=-1).reshape(B, S, 3 * MLSTM_WIDTH) @ w_if
             + b_if).astype(jnp.float32)
    i_pre = gates[..., :MLSTM_HEADS].transpose(0, 2, 1)
    log_f = jax.nn.log_sigmoid(gates[..., MLSTM_HEADS:]).transpose(0, 2, 1)
    to_h = lambda t: t.transpose(0, 2, 1, 3).astype(jnp.float32)
    h_m = mlstm_chunkwise(to_h(q_m), to_h(k_m) * MLSTM_HEAD_DIM ** -0.5, to_h(v_m), i_pre, log_f)
    h_m = h_m.transpose(0, 2, 1, 3)
    mu = jnp.mean(h_m, axis=-1, keepdims=True)
    var = jnp.mean(jnp.square(h_m - mu), axis=-1, keepdims=True)
    h_m = ((h_m - mu) * lax.rsqrt(var + EPS)).reshape(B, S, MLSTM_WIDTH)
    h_m = h_m * mlstm_norm.astype(jnp.float32)
    o_m = (h_m.astype(h.dtype) + mlstm_skip * x_conv) * jax.nn.silu(z)

    return jnp.concatenate([o_a, o_m], axis=-1) @ w_out


def setup_inputs(seed: int = 0) -> dict:
    key = jax.random.key(seed)
    ks = jax.random.split(key, 32)
    L, D, F = DEPTH, D_MODEL, D_FF
    H, W, dh = MLSTM_HEADS, MLSTM_WIDTH, MLSTM_HEAD_DIM

    def nrm(k, shape, scale):
        return jax.random.normal(k, shape, jnp.float32) * scale

    b_if = jnp.concatenate([nrm(ks[15], (L, H), 0.1),
                            jnp.broadcast_to(jnp.linspace(3.0, 6.0, H, dtype=jnp.float32), (L, H))
                            + nrm(ks[16], (L, H), 0.1)], axis=-1)
    return {
        'x': nrm(ks[0], (BATCH, SEQ, D), 1.0),
        'c': nrm(ks[1], (BATCH, D), 1.0),
        'w_ada': nrm(ks[2], (L, D, N_MOD * D), 0.2 * D ** -0.5),
        'b_ada': nrm(ks[3], (L, N_MOD * D), 0.02),
        'ffn1_norm': 1.0 + nrm(ks[4], (L, D), 0.02),
        'ffn1_w_gate': nrm(ks[5], (L, D, F), D ** -0.5),
        'ffn1_w_up': nrm(ks[6], (L, D, F), D ** -0.5),
        'ffn1_w_down': nrm(ks[7], (L, F, D), F ** -0.5),
        'mix_norm': 1.0 + nrm(ks[8], (L, D), 0.02),
        'w_in': nrm(ks[9], (L, D, IN_COLS), D ** -0.5),
        'conv_w': nrm(ks[10], (L, CONV_WIDTH, W), CONV_WIDTH ** -0.5),
        'conv_b': nrm(ks[11], (L, W), 0.02),
        'w_q_m': nrm(ks[12], (L, H, dh, dh), dh ** -0.5),
        'w_k_m': nrm(ks[13], (L, H, dh, dh), dh ** -0.5),
        'w_v_m': nrm(ks[14], (L, H, dh, dh), dh ** -0.5),
        'w_if': nrm(ks[17], (L, 3 * W, 2 * H), 0.1 * (3 * W) ** -0.5),
        'b_if': b_if,
        'mlstm_norm': 1.0 + nrm(ks[18], (L, W), 0.02),
        'mlstm_skip': 1.0 + nrm(ks[19], (L, W), 0.02),
        'attn_norm': 1.0 + nrm(ks[20], (L, ATTN_WIDTH), 0.02),
        'w_out': nrm(ks[21], (L, D, D), D ** -0.5),
        'ffn2_norm': 1.0 + nrm(ks[22], (L, D), 0.02),
        'ffn2_w_gate': nrm(ks[23], (L, D, F), D ** -0.5),
        'ffn2_w_up': nrm(ks[24], (L, D, F), D ** -0.5),
        'ffn2_w_down': nrm(ks[25], (L, F, D), F ** -0.5),
        'final_norm': 1.0 + nrm(ks[26], (D,), 0.02),
    }


def reference(x, c, w_ada, b_ada, ffn1_norm, ffn1_w_gate, ffn1_w_up, ffn1_w_down,
              mix_norm, w_in, conv_w, conv_b, w_q_m, w_k_m, w_v_m, w_if, b_if,
              mlstm_norm, mlstm_skip, attn_norm, w_out,
              ffn2_norm, ffn2_w_gate, ffn2_w_up, ffn2_w_down, final_norm):
    B = x.shape[0]
    for l in range(DEPTH):
        mod = (c @ w_ada[l] + b_ada[l]).reshape(B, N_MOD, D_MODEL)
        sh1, sc1, g1, sh2, sc2, g2, sh3, sc3, g3 = [mod[:, None, i] for i in range(N_MOD)]
        h = modulate(rmsnorm(x, ffn1_norm[l]), sh1, sc1)
        x = x + 0.5 * (1 + g1) * swiglu(h, ffn1_w_gate[l], ffn1_w_up[l], ffn1_w_down[l])
        h = modulate(rmsnorm(x, mix_norm[l]), sh2, sc2)
        x = x + (1 + g2) * hybrid_mixer(h, w_in[l], conv_w[l], conv_b[l], w_q_m[l], w_k_m[l],
                                        w_v_m[l], w_if[l], b_if[l], mlstm_norm[l], mlstm_skip[l],
                                        attn_norm[l], w_out[l])
        h = modulate(rmsnorm(x, ffn2_norm[l]), sh3, sc3)
        x = x + 0.5 * (1 + g3) * swiglu(h, ffn2_w_gate[l], ffn2_w_up[l], ffn2_w_down[l])
    return rmsnorm(x, final_norm)
```

```cpp
#define DBG_SAN 1
#define DBG_SAN2 1
#include <hip/hip_runtime.h>
#include <cstdio>
#include <cstdint>
namespace pg8 {
#define PG8_LAS __attribute__((address_space(3)))
typedef unsigned short bf16_t;
typedef short bf16x8 __attribute__((ext_vector_type(8)));
typedef float f32x4 __attribute__((ext_vector_type(4)));
typedef unsigned u32x4 __attribute__((ext_vector_type(4)));
constexpr int BM = 256, BK = 64, HALF = 128, HTB = HALF * BK * 2  , STAGE_BYTES = 8 * HTB, NXCD = 8, WGM = 8;

__host__ __device__ __forceinline__ int lds_byte(int r, int c) { const int st = (r >> 4) * 2 + (c >> 5), rr = r & 15, cc = c & 31, ob = rr * 64 + cc * 2; return st * 1024 + (ob ^ (((ob >> 9) & 1) << 5)); }
__host__ __device__ __forceinline__ void stage_rc(int b, int& R, int& C) { const int st = b / 1024, sb = b % 1024, swz = sb ^ (((sb >> 9) & 1) << 5); R = (st >> 1) * 16 + swz / 64; C = (st & 1) * 32 + (swz % 64) / 2; }
__host__ __device__ __forceinline__ int perm32(int rho) { const int n = rho >> 4, i = rho & 15; return 8 * (i >> 2) + 4 * n + (i & 3); }

struct Unit { int pm, pn; };
struct Gemm { const bf16_t* A; const bf16_t* Bt; int M, N, K; };

struct StaticOrder {
    int nM, nN, nwg, G, c;
    __host__ __device__ void init(int M, int N, int G_, int c_) { nM = M / BM; nN = N / BM; nwg = nM * nN; G = G_; c = c_; }
    __host__ __device__ bool next(int i, Unit& u) const {
        const long L = (long)i * G + c; if (L >= nwg) return false;
        int wgid = (int)L; { const int q = nwg / NXCD, r = nwg % NXCD, xcd = wgid % NXCD, off = wgid / NXCD; wgid = (xcd < r ? xcd * (q + 1) : r * (q + 1) + (xcd - r) * q) + off; }
        const int nig = WGM * nN, gid = wgid / nig, fm = gid * WGM, gsz = (nM - fm) < WGM ? (nM - fm) : WGM;
        u.pm = fm + ((wgid % nig) % gsz); u.pn = (wgid % nig) / gsz; return true;
    }
    __device__ __forceinline__ void a_ready(const Unit&) const {}
    __device__ __forceinline__ void done(const Unit&) const {}
};

__device__ __forceinline__ unsigned cvt_pk_bf16(float lo, float hi) { unsigned r; asm volatile("v_cvt_pk_bf16_f32 %0, %1, %2" : "=v"(r) : "v"(lo), "v"(hi)); return r; }
typedef float f32x2 __attribute__((ext_vector_type(2)));
__device__ __forceinline__ f32x2 gelu_pk(f32x2 v) {
    const f32x2 av = __builtin_elementwise_abs(v), d = av * 0.2316418882f + 1.0f;
    f32x2 t; t.x = __builtin_amdgcn_rcpf(d.x); t.y = __builtin_amdgcn_rcpf(d.y);
    f32x2 q = t * 0.5307027145f + (-0.7265760135f); q = q * t + 0.7107068705f; q = q * t + (-0.142248368f); q = q * t + 0.127414796f; q = q * t;
    const f32x2 s = (v * v) * (-0.72134752044f);
    f32x2 e; e.x = __builtin_amdgcn_exp2f(s.x); e.y = __builtin_amdgcn_exp2f(s.y);
    const f32x2 m = v * (q * e), r = v - m;
    f32x2 o; o.x = v.x < 0.f ? m.x : r.x; o.y = v.y < 0.f ? m.y : r.y; return o;
}

template <int ACT  > struct EpiBf16 {
    static constexpr bool PERM = true, AFTER_DRAIN = false; static_assert(ACT == 0 || ACT == 1, "EpiBf16: ACT is 0 (none) or 1 (gelu_pk)");
    bf16_t* O; int ldc; const float* bias; int split_cols; size_t split_stride; float scale0;
    __device__ __forceinline__ void operator()(const f32x4 (&acc)[2][2][4][2], const Unit& u, int wr, int wc, int fr, int fq) const {
        const int row0 = u.pm * BM + wr * 64 + fr; int colt = u.pn * BM; bf16_t* base = O;
        float sc = 1.f; if (split_cols) { const int t = colt / split_cols; base += (size_t)t * split_stride; colt -= t * split_cols; if (t == 0) sc = scale0; }
        const int col0 = colt + wc * 32 + 8 * fq, bcol0 = u.pn * BM + wc * 32 + 8 * fq;
        f32x4 bv[2][2];
#pragma unroll
        for (int bj = 0; bj < 2; ++bj)
#pragma unroll
            for (int n = 0; n < 2; ++n) bv[bj][n] = bias ? *(const f32x4*)(bias + bcol0 + bj * HALF + 4 * n) : (f32x4){0.f, 0.f, 0.f, 0.f};
#pragma unroll
        for (int ai = 0; ai < 2; ++ai)
#pragma unroll
            for (int m = 0; m < 4; ++m) { bf16_t* rowp = base + (size_t)(row0 + ai * HALF + m * 16) * ldc + col0;
#pragma unroll
                for (int bj = 0; bj < 2; ++bj) { f32x4 v0 = acc[ai][bj][m][0] + bv[bj][0], v1 = acc[ai][bj][m][1] + bv[bj][1];
                    if (ACT == 1) { f32x2 a = gelu_pk((f32x2){v0[0], v0[1]}), b = gelu_pk((f32x2){v0[2], v0[3]}), c = gelu_pk((f32x2){v1[0], v1[1]}), d = gelu_pk((f32x2){v1[2], v1[3]});
                        v0 = (f32x4){a.x, a.y, b.x, b.y}; v1 = (f32x4){c.x, c.y, d.x, d.y}; }
                    v0 = v0 * sc; v1 = v1 * sc; u32x4 w; w.x = cvt_pk_bf16(v0[0], v0[1]); w.y = cvt_pk_bf16(v0[2], v0[3]); w.z = cvt_pk_bf16(v1[0], v1[1]); w.w = cvt_pk_bf16(v1[2], v1[3]);
                    *(u32x4*)(rowp + bj * HALF) = w; } }
    }
};
struct EpiSwiGLU {
    static constexpr bool PERM = true, AFTER_DRAIN = false;
    bf16_t* O; int ldc;
    __device__ __forceinline__ void operator()(const f32x4 (&acc)[2][2][4][2], const Unit& u, int wr, int wc, int fr, int fq) const {
        const int row0 = u.pm * BM + wr * 64 + fr, col0 = u.pn * HALF + wc * 32 + 8 * fq;
#pragma unroll
        for (int ai = 0; ai < 2; ++ai)
#pragma unroll
            for (int m = 0; m < 4; ++m) { bf16_t* rowp = O + (size_t)(row0 + ai * HALF + m * 16) * ldc + col0;
                float hv[8];
#pragma unroll
                for (int n = 0; n < 2; ++n)
#pragma unroll
                    for (int j = 0; j < 4; ++j) { const float g = acc[ai][0][m][n][j], up = acc[ai][1][m][n][j];
                        const float e = __builtin_amdgcn_exp2f(g * -1.4426950408889634f); hv[4 * n + j] = g * __builtin_amdgcn_rcpf(1.0f + e) * up; }
                u32x4 w; w.x = cvt_pk_bf16(hv[0], hv[1]); w.y = cvt_pk_bf16(hv[2], hv[3]); w.z = cvt_pk_bf16(hv[4], hv[5]); w.w = cvt_pk_bf16(hv[6], hv[7]);
                *(u32x4*)rowp = w; }
    }
};
struct EpiResid {
    static constexpr bool PERM = false, AFTER_DRAIN = false;
    const float* base; float* out; int ldc; const float* gate; int tiles_per_batch;
    __device__ __forceinline__ void operator()(const f32x4 (&acc)[2][2][4][2], const Unit& u, int wr, int wc, int fr, int fq) const {
        const int row0 = u.pm * BM + wr * 64 + fr, col0 = u.pn * BM + wc * 32 + 4 * fq;
        const float* gp = gate + (size_t)(u.pm / tiles_per_batch) * ldc + col0;
        f32x4 gv[2][2];
#pragma unroll
        for (int bj = 0; bj < 2; ++bj)
#pragma unroll
            for (int n = 0; n < 2; ++n) gv[bj][n] = *(const f32x4*)(gp + bj * HALF + n * 16);
#pragma unroll
        for (int ai = 0; ai < 2; ++ai)
#pragma unroll
            for (int m = 0; m < 4; ++m) { const size_t off = (size_t)(row0 + ai * HALF + m * 16) * ldc + col0;
#pragma unroll
                for (int bj = 0; bj < 2; ++bj)
#pragma unroll
                    for (int n = 0; n < 2; ++n) { const f32x4 bs = *(const f32x4*)(base + off + bj * HALF + n * 16);
                        *(f32x4*)(out + off + bj * HALF + n * 16) = bs + gv[bj][n] * acc[ai][bj][m][n]; } }
    }
};
template <class Epi, class Sched, bool ALIGN_EPI = false, bool SP2 = false>
__device__ __forceinline__ void gemm_phase(PG8_LAS unsigned char* lds, const Gemm g, const Sched& S, const Epi& E) {
    const int tid = threadIdx.x, wid = __builtin_amdgcn_readfirstlane(tid >> 6), lane = tid & 63, wr = wid >> 2, wc = wid & 3, fr = lane & 15, fq = lane >> 4;
    const int K = g.K, nt = K / BK;
    unsigned voffA[2], voffB[2];
#pragma unroll
    for (int i = 0; i < 2; ++i) { int R, C; stage_rc(tid * 16 + i * 8192, R, C); const int Rb = Epi::PERM ? ((R & ~31) + perm32(R & 31)) : R;
        voffA[i] = (unsigned)(R * K + C) * 2u; voffB[i] = (unsigned)(Rb * K + C) * 2u; }
    const size_t kstep = (size_t)(BK * 2);
    const size_t hstep = (size_t)HALF * K * 2;
    const size_t tstep = 2 * hstep;
    const unsigned ldsw = (unsigned)wid * 1024u;
    const int aoff = lds_byte(wr * 64 + fr, fq * 8), boff = lds_byte(wc * 32 + fr, fq * 8);
#define PG8_SA(b, h) (((b) * 2 + (h)) * HTB)
#define PG8_SB(b, h) ((4 + (b) * 2 + (h)) * HTB)
#define PG8_STAGE(bufoff, gbase, voff) do { _Pragma("unroll") for (int _i = 0; _i < 2; ++_i) \
        __builtin_amdgcn_global_load_lds((const unsigned*)((const char*)(gbase) + (voff)[_i]), (PG8_LAS unsigned*)(lds + (bufoff) + ldsw + _i * 8192), 16, 0, 0); } while (0)
#define PG8_LDA(dst, b, h) do { _Pragma("unroll") for (int m = 0; m < 4; ++m) _Pragma("unroll") for (int k = 0; k < 2; ++k) dst[m][k] = *(const PG8_LAS bf16x8*)(lds + PG8_SA(b, h) + aoff + m * 2048 + k * 1024); } while (0)
#define PG8_LDB(dst, b, h) do { _Pragma("unroll") for (int n = 0; n < 2; ++n) _Pragma("unroll") for (int k = 0; k < 2; ++k) dst[n][k] = *(const PG8_LAS bf16x8*)(lds + PG8_SB(b, h) + boff + n * 2048 + k * 1024); } while (0)
#define PG8_MMA(ai, bj, At, Bt) do { __builtin_amdgcn_s_setprio(1); _Pragma("unroll") for (int m = 0; m < 4; ++m) _Pragma("unroll") for (int n = 0; n < 2; ++n) _Pragma("unroll") for (int k = 0; k < 2; ++k) \
        acc[ai][bj][m][n] = __builtin_amdgcn_mfma_f32_16x16x32_bf16(Bt[n][k], At[m][k], acc[ai][bj][m][n], 0, 0, 0); __builtin_amdgcn_s_setprio(0); } while (0)
#define PG8_WAIT_V(n) asm volatile("s_waitcnt vmcnt(" #n ")" ::: "memory")
#define PG8_WAIT_L(n) asm volatile("s_waitcnt lgkmcnt(" #n ")" ::: "memory")
#define PG8_BAR __builtin_amdgcn_s_barrier()
#define PG8_SCHED __builtin_amdgcn_sched_barrier(0)
    Unit cur, nxt; int ui = 0;
    if (!S.next(0, cur)) return;
    f32x4 acc[2][2][4][2];
#pragma unroll
    for (int a = 0; a < 2; ++a)
#pragma unroll
        for (int b = 0; b < 2; ++b)
#pragma unroll
            for (int m = 0; m < 4; ++m)
#pragma unroll
                for (int n = 0; n < 2; ++n) acc[a][b][m][n] = (f32x4){0.f, 0.f, 0.f, 0.f};
    bf16x8 At[4][2], B0[2][2], B1[2][2];
    const char* cA = (const char*)g.A + (size_t)cur.pm * tstep; const char* cB = (const char*)g.Bt + (size_t)cur.pn * tstep;
    S.a_ready(cur);
    if constexpr (SP2) {
        PG8_STAGE(PG8_SB(0, 0), cB, voffB); PG8_STAGE(PG8_SB(0, 1), cB + hstep, voffB); PG8_STAGE(PG8_SA(0, 0), cA, voffA); PG8_STAGE(PG8_SA(0, 1), cA + hstep, voffA);
        if (wr == 1) PG8_BAR;
        PG8_WAIT_V(2); PG8_BAR;
        PG8_STAGE(PG8_SB(1, 0), cB + kstep, voffB); PG8_STAGE(PG8_SA(1, 0), cA + kstep, voffA); PG8_STAGE(PG8_SB(1, 1), cB + hstep + kstep, voffB);
        PG8_WAIT_V(6); PG8_BAR;
    } else {
        PG8_STAGE(PG8_SB(0, 0), cB, voffB); PG8_STAGE(PG8_SA(0, 0), cA, voffA); PG8_STAGE(PG8_SB(0, 1), cB + hstep, voffB); PG8_STAGE(PG8_SA(0, 1), cA + hstep, voffA);
        if (wr == 1) PG8_BAR;
        PG8_WAIT_V(4); PG8_BAR;
        PG8_STAGE(PG8_SB(1, 0), cB + kstep, voffB); PG8_STAGE(PG8_SA(1, 0), cA + kstep, voffA); PG8_STAGE(PG8_SB(1, 1), cB + hstep + kstep, voffB);
        PG8_WAIT_V(6); PG8_BAR;
    }
    for (;;) {
        const bool has_next = S.next(ui + 1, nxt);
        const char* nA = has_next ? (const char*)g.A + (size_t)nxt.pm * tstep : cA; const char* nB = has_next ? (const char*)g.Bt + (size_t)nxt.pn * tstep : cB;
        for (int t = 0; t < nt; t += 2) {
            const bool last = (t == nt - 2);
            const char* a1 = cA + (size_t)(t + 1) * kstep;
            const char* a2 = last ? nA : cA + (size_t)(t + 2) * kstep; const char* b2 = last ? nB : cB + (size_t)(t + 2) * kstep;
            const char* a3 = a2 + kstep; const char* b3 = b2 + kstep;
            if (last && has_next) S.a_ready(nxt);
            if constexpr (SP2) {
            PG8_LDB(B0, 0, 0); PG8_LDB(B1, 0, 1); PG8_SCHED; PG8_LDA(At, 0, 0); PG8_STAGE(PG8_SA(1, 1), a1 + hstep, voffA);
            PG8_WAIT_V(8); PG8_WAIT_L(0); PG8_BAR; PG8_MMA(0, 0, At, B0); PG8_MMA(0, 1, At, B1); PG8_BAR; PG8_SCHED;
            PG8_LDA(At, 0, 1); PG8_STAGE(PG8_SB(0, 0), b2, voffB); PG8_STAGE(PG8_SB(0, 1), b2 + hstep, voffB); PG8_STAGE(PG8_SA(0, 0), a2, voffA);
            PG8_WAIT_V(8); PG8_WAIT_L(0); PG8_BAR; PG8_MMA(1, 0, At, B0); PG8_MMA(1, 1, At, B1); PG8_BAR; PG8_SCHED;
            PG8_LDB(B0, 1, 0); PG8_LDB(B1, 1, 1); PG8_SCHED; PG8_LDA(At, 1, 0); PG8_STAGE(PG8_SA(0, 1), a2 + hstep, voffA);
            PG8_WAIT_V(8); PG8_WAIT_L(0); PG8_BAR; PG8_MMA(0, 0, At, B0); PG8_MMA(0, 1, At, B1); PG8_BAR; PG8_SCHED;
            PG8_LDA(At, 1, 1); PG8_STAGE(PG8_SB(1, 0), b3, voffB); PG8_STAGE(PG8_SB(1, 1), b3 + hstep, voffB); PG8_STAGE(PG8_SA(1, 0), a3, voffA);
            PG8_WAIT_V(8); PG8_WAIT_L(0); PG8_BAR; PG8_MMA(1, 0, At, B0); PG8_MMA(1, 1, At, B1); PG8_BAR; PG8_SCHED;
            } else {
            PG8_LDB(B0, 0, 0); PG8_SCHED; PG8_LDA(At, 0, 0); PG8_STAGE(PG8_SA(1, 1), a1 + hstep, voffA);
            PG8_WAIT_L(8); PG8_BAR; PG8_WAIT_L(0); PG8_MMA(0, 0, At, B0); PG8_BAR; PG8_SCHED;
            PG8_LDB(B1, 0, 1); PG8_STAGE(PG8_SB(0, 0), b2, voffB);
            PG8_BAR; PG8_WAIT_L(0); PG8_MMA(0, 1, At, B1); PG8_BAR;
            PG8_LDA(At, 0, 1); PG8_STAGE(PG8_SA(0, 0), a2, voffA);
            PG8_BAR; PG8_WAIT_L(0); PG8_MMA(1, 0, At, B0); PG8_BAR; PG8_SCHED;
            PG8_STAGE(PG8_SB(0, 1), b2 + hstep, voffB);
            PG8_WAIT_V(6); PG8_BAR; PG8_MMA(1, 1, At, B1); PG8_BAR;
            PG8_LDB(B0, 1, 0); PG8_SCHED; PG8_LDA(At, 1, 0); PG8_STAGE(PG8_SA(0, 1), a2 + hstep, voffA);
            PG8_WAIT_L(8); PG8_BAR; PG8_WAIT_L(0); PG8_MMA(0, 0, At, B0); PG8_BAR; PG8_SCHED;
            PG8_LDB(B1, 1, 1); PG8_STAGE(PG8_SB(1, 0), b3, voffB);
            PG8_BAR; PG8_WAIT_L(0); PG8_MMA(0, 1, At, B1); PG8_BAR;
            PG8_LDA(At, 1, 1); PG8_STAGE(PG8_SA(1, 0), a3, voffA);
            PG8_BAR; PG8_WAIT_L(0); PG8_MMA(1, 0, At, B0); PG8_BAR; PG8_SCHED;
            PG8_STAGE(PG8_SB(1, 1), b3 + hstep, voffB);
            PG8_WAIT_V(6); PG8_BAR; PG8_MMA(1, 1, At, B1); PG8_BAR;
            }
        }
        if constexpr (ALIGN_EPI) { if (wr == 0) PG8_BAR; }
        if constexpr (!Epi::AFTER_DRAIN) { E(acc, cur, wr, wc, fr, fq); S.done(cur); }
        if (!has_next) break;
#pragma unroll
        for (int a = 0; a < 2; ++a)
#pragma unroll
            for (int b = 0; b < 2; ++b)
#pragma unroll
                for (int m = 0; m < 4; ++m)
#pragma unroll
                    for (int n = 0; n < 2; ++n) acc[a][b][m][n] = (f32x4){0.f, 0.f, 0.f, 0.f};
        cur = nxt; cA = nA; cB = nB; ++ui;
        if constexpr (ALIGN_EPI) { if (wr == 1) PG8_BAR; }
    }
    PG8_WAIT_V(0);
    if constexpr (!ALIGN_EPI) { if (wr == 0) PG8_BAR; }
    PG8_BAR;
    if constexpr (Epi::AFTER_DRAIN) { E.fused(acc, cur, wr, wc, fr, fq, lds, wid, lane); S.done(cur); }
#undef PG8_SA
#undef PG8_SB
#undef PG8_STAGE
#undef PG8_LDA
#undef PG8_LDB
#undef PG8_MMA
#undef PG8_WAIT_V
#undef PG8_WAIT_L
#undef PG8_BAR
#undef PG8_SCHED
}
}

#ifndef PG8_SP2
#define PG8_SP2 true
#endif
#ifndef PG8_ALIGN
#define PG8_ALIGN true
#endif
#include <hip/hip_bf16.h>
#include <cmath>
namespace attn_body {
using bf16=__hip_bfloat16;
using bf16x8=__attribute__((ext_vector_type(8)))short;
using s16x4=__attribute__((ext_vector_type(4)))short;
using f32x16=__attribute__((ext_vector_type(16)))float;
using u32x4=__attribute__((ext_vector_type(4)))unsigned;
constexpr int BATCH=8,NHEAD=8,SEQ=4096,D=64,DM=NHEAD*D,ODM=1024;
constexpr int NW=8,QBLK=32,QB=QBLK*NW,KVBLK=64,NQB=SEQ/QB;
constexpr int ATTN_PITCH=DM, ATTN_UNIT_ROWS=QB;
__device__ __forceinline__ int crow(int r,int hi){return (r&3)+8*(r>>2)+4*hi;}
#define SBAR() __builtin_amdgcn_sched_barrier(0)
__device__ __forceinline__ void cmask(f32x16&p0,f32x16&p1,int jb,int qrel,int hi){
  const float NEG=-INFINITY; int kb=64*jb+4*hi;
  #pragma unroll
  for(int r=0;r<16;++r){int kv=kb+(r&3)+8*(r>>2); if(kv>qrel)p0[r]=NEG; if(kv+32>qrel)p1[r]=NEG;}
}

constexpr int NSLOT=3, SLOTB=8192;
constexpr int LDS_K=0, LDS_V=NSLOT*SLOTB, LDS_WS=2*NSLOT*SLOTB, LDS_OST=LDS_WS+NW*64*4, LDS_BYTES=LDS_OST+NW*4096;
constexpr float C2=0.125f*1.4426950408889634f;
__device__ __forceinline__ void glds16(const void*gsrc,unsigned lds_dst){unsigned keep;
  asm volatile("s_mov_b32 %0, m0\n\ts_mov_b32 m0, %2\n\ts_nop 0\n\tglobal_load_lds_dwordx4 %1, off\n\ts_mov_b32 m0, %0":"=&s"(keep):"v"(gsrc),"s"(lds_dst):"memory");}
__device__ __forceinline__ float max3f(float a,float b,float c){float r;asm("v_max3_f32 %0, %1, %2, %3":"=v"(r):"v"(a),"v"(b),"v"(c));return r;}
__device__ __forceinline__ float max2f(float a,float b){float r;asm("v_max_f32_e32 %0, %1, %2":"=v"(r):"v"(a),"v"(b));return r;}
__device__ __forceinline__ float fadd_s(float a,float b){float r;asm("v_add_f32_e32 %0, %1, %2":"=v"(r):"v"(a),"v"(b));return r;}
__device__ __forceinline__ float fsub_s(float a,float b){float r;asm("v_sub_f32_e32 %0, %1, %2":"=v"(r):"v"(a),"v"(b));return r;}
typedef float f32x2_t __attribute__((ext_vector_type(2))); typedef __bf16 bf16x2_t __attribute__((ext_vector_type(2)));
__device__ __forceinline__ unsigned cvtpk_s(float lo,float hi){f32x2_t v={lo,hi};bf16x2_t b=__builtin_convertvector(v,bf16x2_t);return __builtin_bit_cast(unsigned,b);}
#define WAIT_BAR(N) asm volatile("s_waitcnt vmcnt(" #N ") lgkmcnt(0)\n\ts_barrier":::"memory")

__device__ __forceinline__ void qkt(f32x16&p0,f32x16&p1,const char*Kslot,const bf16x8*qr,const f32x16&negm,int r32,int hi){
  const char*kb=Kslot+hi*1024+r32*16;
  #pragma unroll
  for(int d0=0;d0<4;++d0){
    const bf16x8 b0=*reinterpret_cast<const bf16x8*>(kb+d0*2048);
    const bf16x8 b1=*reinterpret_cast<const bf16x8*>(kb+d0*2048+512);
    if(d0==0){p0=__builtin_amdgcn_mfma_f32_32x32x16_bf16(b0,qr[0],negm,0,0,0);p1=__builtin_amdgcn_mfma_f32_32x32x16_bf16(b1,qr[0],negm,0,0,0);}
    else{p0=__builtin_amdgcn_mfma_f32_32x32x16_bf16(b0,qr[d0],p0,0,0,0);p1=__builtin_amdgcn_mfma_f32_32x32x16_bf16(b1,qr[d0],p1,0,0,0);}}
}
typedef __attribute__((address_space(3))) const char* lds_cptr;
typedef short v4i16_t __attribute__((ext_vector_type(4)));
__device__ __forceinline__ void kload8(bf16x8*kf,lds_cptr kp){
  kf[0]=*(const __attribute__((address_space(3))) bf16x8*)(kp);      kf[1]=*(const __attribute__((address_space(3))) bf16x8*)(kp+512);
  kf[2]=*(const __attribute__((address_space(3))) bf16x8*)(kp+2048); kf[3]=*(const __attribute__((address_space(3))) bf16x8*)(kp+2560);
  kf[4]=*(const __attribute__((address_space(3))) bf16x8*)(kp+4096); kf[5]=*(const __attribute__((address_space(3))) bf16x8*)(kp+4608);
  kf[6]=*(const __attribute__((address_space(3))) bf16x8*)(kp+6144); kf[7]=*(const __attribute__((address_space(3))) bf16x8*)(kp+6656);
}
__device__ __forceinline__ void kload2(bf16x8*kf,lds_cptr kp,int j){ kf[2*j]=*(const __attribute__((address_space(3))) bf16x8*)(kp+j*2048); kf[2*j+1]=*(const __attribute__((address_space(3))) bf16x8*)(kp+j*2048+512); }
__device__ __forceinline__ s16x4 vtr(lds_cptr p){ return __builtin_bit_cast(s16x4,__builtin_amdgcn_ds_read_tr16_b64_v4i16((__attribute__((address_space(3))) v4i16_t*)p)); }
__device__ __forceinline__ float rowmax(const f32x16&p0,const f32x16&p1){
  float a=max3f(p0[0],p0[1],p1[0]),b=max3f(p0[2],p0[3],p1[1]);a=max3f(a,p1[2],p1[3]);
  #pragma unroll
  for(int r=4;r<16;r+=4){a=max3f(a,p0[r],p0[r+1]);b=max3f(b,p0[r+2],p0[r+3]);a=max3f(a,p1[r],p1[r+1]);b=max3f(b,p1[r+2],p1[r+3]);}
  const float m=max2f(a,b);
  auto rr=__builtin_amdgcn_permlane32_swap(__float_as_uint(m),__float_as_uint(m),false,false);
  return max2f(__uint_as_float(rr[0]),__uint_as_float(rr[1]));
}
__device__ __forceinline__ void pv(f32x16*o,int vb,bf16x8 pa0,bf16x8 pa1,bf16x8 pa2,bf16x8 pa3){
  #pragma unroll
  for(int d0=0;d0<2;++d0){s16x4 lo[4],hi[4];
    #pragma unroll
    for(int ks=0;ks<4;++ks){
      asm volatile("ds_read_b64_tr_b16 %0,%1 offset:%c2":"=&v"(lo[ks]):"v"(vb),"i"(d0*4096+ks*1024):"memory");
      asm volatile("ds_read_b64_tr_b16 %0,%1 offset:%c2":"=&v"(hi[ks]):"v"(vb),"i"(d0*4096+ks*1024+512):"memory");}
    asm volatile("s_waitcnt lgkmcnt(0)":::"memory");SBAR();
    #define PK(k) (bf16x8){lo[k][0],lo[k][1],lo[k][2],lo[k][3],hi[k][0],hi[k][1],hi[k][2],hi[k][3]}
    o[d0]=__builtin_amdgcn_mfma_f32_32x32x16_bf16(pa0,PK(0),o[d0],0,0,0);
    o[d0]=__builtin_amdgcn_mfma_f32_32x32x16_bf16(pa1,PK(1),o[d0],0,0,0);
    o[d0]=__builtin_amdgcn_mfma_f32_32x32x16_bf16(pa2,PK(2),o[d0],0,0,0);
    o[d0]=__builtin_amdgcn_mfma_f32_32x32x16_bf16(pa3,PK(3),o[d0],0,0,0);
    #undef PK
  }
}

#ifndef ATTN_STORE16
#define ATTN_STORE16(p,v) (*(u32x4*)(p)=(v))
#endif
template<int THRL> __device__ __forceinline__ void attn_unit(int b,int h,int qb,const bf16*Q,const bf16*__restrict__ K,const bf16*__restrict__ V,bf16*O,const unsigned short*SEL,char*shm){
  const int tid=threadIdx.x,lane=tid&63,r32=lane&31,hi=lane>>5; const int wid=__builtin_amdgcn_readfirstlane(tid>>6);
  const long rowbase=(long)b*SEQ; const int q0=qb*QB;
  const bf16*Qw=Q+(rowbase+q0+wid*QBLK)*DM+h*D;
  const bf16*Kh=K+rowbase*DM+h*D,*Vh=V+rowbase*DM+h*D;
  const unsigned lds0=(unsigned)(uintptr_t)shm;
  float*wsf=(float*)(shm+LDS_WS)+wid*64;
  const bf16*ksrc=Kh+(long)lane*DM+wid*8;
  const bf16*vsrc=Vh+(long)(16*(wid&3)+(lane>>2))*DM+(wid>>2)*32+(lane&3)*8;
  const unsigned kdst=lds0+LDS_K+wid*1024, vdst=lds0+LDS_V+wid*1024;
  #define DMA_K(t,slot) glds16(ksrc+(long)(t)*KVBLK*DM,(unsigned)__builtin_amdgcn_readfirstlane(kdst+(slot)))
  #define DMA_V(t,slot) glds16(vsrc+(long)(t)*KVBLK*DM,(unsigned)__builtin_amdgcn_readfirstlane(vdst+(slot)))
  const int vb0=(int)(lds0+LDS_V)+((lane>>4)&1)*32+(lane&3)*8+(4*hi+((lane&15)>>2))*64;
  const char*Kbase=shm+LDS_K; bf16x8 kf[8];
  const lds_cptr shm3=(lds_cptr)shm; const lds_cptr kp0=shm3+LDS_K+hi*1024+r32*16; const lds_cptr vp0=shm3+LDS_V+((lane>>4)&1)*32+(lane&3)*8+(4*hi+((lane&15)>>2))*64;
  const int NT=(q0+QB)/KVBLK;
  DMA_K(0,0);DMA_V(0,0);DMA_K(1,SLOTB);
  bf16x8 qr[4];
  #pragma unroll
  for(int d0=0;d0<4;++d0)qr[d0]=*reinterpret_cast<const bf16x8*>(&Qw[(long)r32*DM+d0*16+hi*8]);
  float mhat=0.f,l_reg=0.f;f32x16 o[2];o[0]=f32x16{};o[1]=f32x16{};f32x16 negm=f32x16{};asm volatile("":"+v"(negm));
  const int qrel=wid*QBLK+r32;
  const unsigned selm=(unsigned)SEL[((long)(b*NHEAD+h))*SEQ+q0+qrel]|(1u<<qb);
  #define SELNEGM(t) do{ const bool on_=((selm>>((t)>>2))&1u)!=0u; const float nv_=on_?-mhat:-INFINITY; _Pragma("unroll") for(int r=0;r<16;++r)negm[r]=nv_; asm volatile("":"+v"(negm)); }while(0)
  #define CMASK(P0,P1,t) do{int jb_=(t)-(NT-4); if(jb_>=0)cmask(P0,P1,jb_,qrel,hi);}while(0)
  bool resc=false;
  #define START(P0,P1) do{ const float rm=rowmax(P0,P1); resc=false; \
    { const float dl=(rm==-INFINITY)?0.f:rm; mhat=fadd_s(mhat,dl); \
      _Pragma("unroll") for(int r=0;r<16;++r){P0[r]=fsub_s(P0[r],dl);P1[r]=fsub_s(P1[r],dl);} \
      _Pragma("unroll") for(int r=0;r<16;++r)negm[r]=-mhat; asm volatile("":"+v"(negm)); } \
    _Pragma("unroll") for(int r=0;r<16;++r)P0[r]=__builtin_amdgcn_exp2f(P0[r]); }while(0)
  #define RESC() do{ if(resc){ asm volatile("s_waitcnt lgkmcnt(0)":::"memory"); \
      _Pragma("unroll") for(int d_=0;d_<2;++d_) _Pragma("unroll") for(int r=0;r<16;++r)o[d_][r]*=wsf[crow(r,hi)]; } }while(0)
  f32x16 pA0,pA1,pB0,pB1;
  int sl_prev=0,sl_cur=0,sl_next=SLOTB;
  #define ROT() do{sl_prev=sl_cur;sl_cur=sl_next;sl_next=(sl_next==(NSLOT-1)*SLOTB)?0:sl_next+SLOTB;}while(0)
  DMA_K(2,2*SLOTB);
  WAIT_BAR(3);
  SELNEGM(0);
  qkt(pA0,pA1,Kbase,qr,negm,r32,hi);asm volatile("s_nop 15\n\ts_nop 7":"+v"(pA0),"+v"(pA1));CMASK(pA0,pA1,0);
  START(pA0,pA1);
  _Pragma("unroll") for(int r=0;r<16;++r)pA1[r]=__builtin_amdgcn_exp2f(pA1[r]);
  WAIT_BAR(0);
  DMA_K(3,0);DMA_V(1,SLOTB);
  ROT();
  kload8(kf,kp0+sl_cur);
  WAIT_BAR(2);
  s16x4 vlo[8],vhi[8]; u32x4 pw0,pw1,pw2,pw3;
  #define PKW(P,B) cvtpk_s(P[B],P[B+1])
  #define PAF(k) __builtin_bit_cast(bf16x8,pw##k)
  #define VFR(i) (bf16x8){vlo[i][0],vlo[i][1],vlo[i][2],vlo[i][3],vhi[i][0],vhi[i][1],vhi[i][2],vhi[i][3]}
  #define PIN(x) asm volatile("":"+v"(x))
  #define MX3(a,b,c) __builtin_fmaxf(__builtin_fmaxf((a),(b)),(c))
  #define GAPA(MF,A0,A1,A2,A3,W0,W1,PW) do{ MF; sacc+=A0; sacc+=A1; sacc+=A2; sacc+=A3; PIN(sacc); W0; W1; PIN(PW); SBAR(); }while(0)
  #define EX(v) __builtin_amdgcn_exp2f(v)
  #define GAPB(MF,X,B) do{ MF; X[B]=EX(X[B]); X[B+1]=EX(X[B+1]); X[B+2]=EX(X[B+2]); X[B+3]=EX(X[B+3]); PIN(X); SBAR(); }while(0)
  #define VRD(i) do{ vlo[i]=vtr(vp_+(((i)>>2)*4096+((i)&3)*1024)); vhi[i]=vtr(vp_+(((i)>>2)*4096+((i)&3)*1024+512)); }while(0)
  #define KRD(G,j) do{ if(G){ kload2(kf,kp0+sl_next,j); SBAR(); } }while(0)
  #define STEP(C0,C1,P0,P1,t,GK,GV,GL) do{ SBAR(); SELNEGM(t); SBAR(); \
    const lds_cptr vp_=vp0+sl_prev; \
    VRD(0); SBAR(); float sacc=(P0[0]+P0[1]); \
    GAPA(C0=__builtin_amdgcn_mfma_f32_32x32x16_bf16(kf[0],qr[0],negm,0,0,0), P0[2],P0[3],P0[4],P0[5],     pw0[0]=PKW(P0,0), pw0[1]=PKW(P0,2), pw0); \
    VRD(4); SBAR(); GAPA(C1=__builtin_amdgcn_mfma_f32_32x32x16_bf16(kf[1],qr[0],negm,0,0,0), P0[6],P0[7],P0[8],P0[9],     pw0[2]=PKW(P0,4), pw0[3]=PKW(P0,6), pw0); \
    VRD(1); SBAR(); GAPA(C0=__builtin_amdgcn_mfma_f32_32x32x16_bf16(kf[2],qr[1],C0,0,0,0),   P0[10],P0[11],P0[12],P0[13], pw1[0]=PKW(P0,8), pw1[1]=PKW(P0,10), pw1); \
    VRD(5); SBAR(); GAPA(C1=__builtin_amdgcn_mfma_f32_32x32x16_bf16(kf[3],qr[1],C1,0,0,0),   P0[14],P0[15],P1[0],P1[1],   pw1[2]=PKW(P0,12),pw1[3]=PKW(P0,14), pw1); \
    VRD(2); SBAR(); GAPA(C0=__builtin_amdgcn_mfma_f32_32x32x16_bf16(kf[4],qr[2],C0,0,0,0),   P1[2],P1[3],P1[4],P1[5],     pw2[0]=PKW(P1,0), pw2[1]=PKW(P1,2), pw2); \
    VRD(6); SBAR(); GAPA(C1=__builtin_amdgcn_mfma_f32_32x32x16_bf16(kf[5],qr[2],C1,0,0,0),   P1[6],P1[7],P1[8],P1[9],     pw2[2]=PKW(P1,4), pw2[3]=PKW(P1,6), pw2); \
    VRD(3); SBAR(); GAPA(C0=__builtin_amdgcn_mfma_f32_32x32x16_bf16(kf[6],qr[3],C0,0,0,0),   P1[10],P1[11],P1[12],P1[13], pw3[0]=PKW(P1,8), pw3[1]=PKW(P1,10), pw3); \
    VRD(7); SBAR(); GAPA(C1=__builtin_amdgcn_mfma_f32_32x32x16_bf16(kf[7],qr[3],C1,0,0,0),   P1[14],P1[15],0.f,0.f,       pw3[2]=PKW(P1,12),pw3[3]=PKW(P1,14), pw3); \
    l_reg+=sacc; \
    if(GK){DMA_K((t)+3,sl_cur);} if(GV){DMA_V((t)+1,sl_next);} \
    CMASK(C0,C1,t); \
    { float a=MX3(C0[0],C0[1],C1[0]),b=MX3(C0[2],C0[3],C1[1]); a=MX3(a,C1[2],C1[3]); \
      _Pragma("unroll") for(int r=4;r<16;r+=4){a=MX3(a,C0[r],C0[r+1]);b=MX3(b,C0[r+2],C0[r+3]);a=MX3(a,C1[r],C1[r+1]);b=MX3(b,C1[r+2],C1[r+3]);} \
      float rm=__builtin_fmaxf(a,b); { auto rr=__builtin_amdgcn_permlane32_swap(__float_as_uint(rm),__float_as_uint(rm),false,false); rm=__builtin_fmaxf(__uint_as_float(rr[0]),__uint_as_float(rr[1])); } \
      resc=false; \
      if(__builtin_expect(__any(rm>(float)THRL),0)){ const float dl=__builtin_fmaxf(rm,0.f); mhat+=dl; \
        _Pragma("unroll") for(int r=0;r<16;++r){C0[r]-=dl;C1[r]-=dl;} \
        _Pragma("unroll") for(int r=0;r<16;++r)negm[r]=-mhat; asm volatile("":"+v"(negm)); \
        const float f=__builtin_amdgcn_exp2f(-dl); l_reg*=f; if(hi==0)wsf[r32]=f; resc=true; } } \
    SBAR(); \
    GAPB(o[0]=__builtin_amdgcn_mfma_f32_32x32x16_bf16(PAF(0),VFR(0),o[0],0,0,0), C0,0); \
    GAPB(o[1]=__builtin_amdgcn_mfma_f32_32x32x16_bf16(PAF(0),VFR(4),o[1],0,0,0), C0,4); \
    KRD(GL,0); GAPB(o[0]=__builtin_amdgcn_mfma_f32_32x32x16_bf16(PAF(1),VFR(1),o[0],0,0,0), C0,8); \
    KRD(GL,1); GAPB(o[1]=__builtin_amdgcn_mfma_f32_32x32x16_bf16(PAF(1),VFR(5),o[1],0,0,0), C0,12); \
    KRD(GL,2); GAPB(o[0]=__builtin_amdgcn_mfma_f32_32x32x16_bf16(PAF(2),VFR(2),o[0],0,0,0), C1,0); \
    KRD(GL,3); GAPB(o[1]=__builtin_amdgcn_mfma_f32_32x32x16_bf16(PAF(2),VFR(6),o[1],0,0,0), C1,4); \
    GAPB(o[0]=__builtin_amdgcn_mfma_f32_32x32x16_bf16(PAF(3),VFR(3),o[0],0,0,0), C1,8); \
    GAPB(o[1]=__builtin_amdgcn_mfma_f32_32x32x16_bf16(PAF(3),VFR(7),o[1],0,0,0), C1,12); \
    }while(0)
  int t=1;
  #undef CMASK
  #define CMASK(P0,P1,t) do{}while(0)
  for(;t+5<NT;t+=2){
    STEP(pB0,pB1,pA0,pA1,t,true,true,true);     WAIT_BAR(2); RESC(); ROT();
    STEP(pA0,pA1,pB0,pB1,t+1,true,true,true);   WAIT_BAR(2); RESC(); ROT();
  }
  #undef CMASK
  #define CMASK(P0,P1,t) do{int jb_=(t)-(NT-4); if(jb_>=0)cmask(P0,P1,jb_,qrel,hi);}while(0)
  #define ENDW(tt) do{ if((tt)+3<NT){WAIT_BAR(2);} else if((tt)+2<NT){WAIT_BAR(1);} else {WAIT_BAR(0);} }while(0)
  for(;t+1<NT;t+=2){
    STEP(pB0,pB1,pA0,pA1,t,(t+3<NT),(t+1<NT),(t+1<NT));       ENDW(t);   RESC(); ROT();
    STEP(pA0,pA1,pB0,pB1,t+1,(t+4<NT),(t+2<NT),(t+2<NT));     ENDW(t+1); RESC(); ROT();
  }
  STEP(pB0,pB1,pA0,pA1,NT-1,false,false,false); RESC();
  { float sacc=pB0[0]+pB0[1]; _Pragma("unroll") for(int r=2;r<16;++r)sacc+=pB0[r]; _Pragma("unroll") for(int r=0;r<16;++r)sacc+=pB1[r]; l_reg+=sacc;
    pw0=(u32x4){PKW(pB0,0),PKW(pB0,2),PKW(pB0,4),PKW(pB0,6)};pw1=(u32x4){PKW(pB0,8),PKW(pB0,10),PKW(pB0,12),PKW(pB0,14)};pw2=(u32x4){PKW(pB1,0),PKW(pB1,2),PKW(pB1,4),PKW(pB1,6)};pw3=(u32x4){PKW(pB1,8),PKW(pB1,10),PKW(pB1,12),PKW(pB1,14)};
    SBAR(); pv(o,vb0+sl_cur,PAF(0),PAF(1),PAF(2),PAF(3)); }
  #undef PKW
  #undef PAF
  #undef VFR
  #undef PIN
  #undef MX3
  #undef GAPA
  #undef GAPB
  #undef EX
  #undef VRD
  #undef KRD
  #undef STEP
  #undef ENDW
  {auto rr=__builtin_amdgcn_permlane32_swap(__float_as_uint(l_reg),__float_as_uint(l_reg),false,false);l_reg=__uint_as_float(rr[0])+__uint_as_float(rr[1]);}
  if(hi==0)wsf[32+r32]=l_reg;asm volatile("s_waitcnt lgkmcnt(0)":::"memory");
  float rli[16];
  #pragma unroll
  for(int r=0;r<16;++r)rli[r]=__builtin_amdgcn_rcpf(wsf[32+crow(r,hi)]);
  bf16*Ow=O+(rowbase+q0+wid*QBLK)*ODM+h*D;
  { bf16*stg=(bf16*)(shm+LDS_OST)+wid*2048;
    #pragma unroll
    for(int r=0;r<16;++r){const int orow=crow(r,hi);
      #pragma unroll
      for(int d0=0;d0<2;++d0)stg[orow*64+d0*32+r32]=__float2bfloat16(o[d0][r]*rli[r]);}
    asm volatile("s_waitcnt lgkmcnt(0)":::"memory");
    #pragma unroll
    for(int i=0;i<4;++i){const int row=i*8+(lane>>3),ch=lane&7; const u32x4 v=*(const u32x4*)(stg+row*64+ch*8); ATTN_STORE16(Ow+(long)row*ODM+ch*8,v);} }
  asm volatile("s_waitcnt lgkmcnt(0)\n\ts_barrier":::"memory");
  #undef DMA_K
  #undef DMA_V
  #undef CMASK
  #undef START
  #undef RESC
  #undef ROT
  #undef SELNEGM
}
constexpr int ATTN_LDS_BYTES=LDS_BYTES;
struct AttnTensors { const bf16* Q; const bf16* K; const bf16* V; bf16* O; const unsigned short* SEL; };
struct AttnUnit { int bh; int qb; };
struct StaticOrder {
  int vcu,G;
  __device__ __forceinline__ explicit StaticOrder(int grid,int block):vcu((grid%8==0)?(block%8)*(grid/8)+block/8:block),G(grid){}
  __device__ __forceinline__ bool next(int i,AttnUnit&u)const{ const int v=vcu+(i>>2)*G; if(v>=256)return false; const int s=v&3,k=i&3; u.bh=v>>2; u.qb=(k==0)?s:(k==1)?7-s:(k==2)?8+s:15-s; return true; }
  __device__ __forceinline__ void a_ready(const AttnUnit&)const{}
  __device__ __forceinline__ void done(const AttnUnit&)const{}
};
template<class Sched,int THRL=8> __device__ __forceinline__ void attn_phase(char*lds,const AttnTensors&T,const Sched&S){
  AttnUnit u;
  for(int i=0;S.next(i,u);++i){ S.a_ready(u); attn_unit<THRL>(u.bh/NHEAD,u.bh%NHEAD,u.qb,T.Q,T.K,T.V,T.O,T.SEL,lds); S.done(u); }
}
#undef SBAR
#undef WAIT_BAR
}
constexpr int NWAVES = 8;
constexpr int BATCH = 8, SEQ = 4096, D = 1024, M = BATCH * SEQ, FF = 2816, NGU = 2 * FF, NIN = 2560, AW = 512, MW = 512;
constexpr int MH = 4, MHD = 128, AHN = 8, NB = 16;
constexpr int SV = 144;
constexpr float EPS = 1e-6f;
constexpr size_t MiB = 1u << 20;
constexpr size_t WS_CTL = 0, CTL_ZERO_BYTES = 1 * MiB;
constexpr size_t WS_MOD = 1 * MiB;
constexpr size_t WS_WGU1 = 2 * MiB, WS_WD1 = 13 * MiB, WS_WGU2 = 19 * MiB, WS_WD2 = 30 * MiB, WS_WIN = 36 * MiB, WS_WOUT = 41 * MiB;
constexpr size_t WS_WQM = 43 * MiB, WS_WKM = WS_WQM + 131072, WS_WVM = WS_WKM + 131072, WS_WEC = WS_WVM + 131072, WS_WEM = WS_WEC + 16384;
constexpr size_t WS_KMEAN = 50 * MiB, WS_SEL = 50 * MiB + 524288, WS_GP = 51 * MiB, WS_GSUP = 55 * MiB;
constexpr size_t WS_XN = 64 * MiB, WS_KMT = 64 * MiB, WS_VMT = 96 * MiB;
constexpr size_t WS_HB = 128 * MiB, WS_Q = 128 * MiB, WS_K = 160 * MiB, WS_V = 192 * MiB, WS_XM = 224 * MiB, WS_Z = 256 * MiB, WS_SST = 224 * MiB;
constexpr size_t WS_QM = 304 * MiB, WS_KM = 336 * MiB, WS_XC = 368 * MiB, WS_DST = 400 * MiB, WS_CAT = 448 * MiB, WS_END = 512 * MiB;
static_assert(WS_HB + (size_t)M * FF * 2 <= WS_QM && WS_DST + (size_t)512 * SV * 128 * 4 <= WS_CAT && WS_SST + (size_t)512 * SV * 128 * 2 <= WS_Z, "d_ws map");
constexpr int CW_TMO = 0, CW_CODE = 1, CW_BAR = 4096;
constexpr int RING_OFF = 0, RING_BYTES = 131072;
constexpr int LDSCTL_OFF = RING_BYTES, MISC_OFF = LDSCTL_OFF + 320;
constexpr int LDS_BYTES = 147456;
#define GAS __attribute__((address_space(1)))
#define LAS __attribute__((address_space(3)))
typedef unsigned short bf16;
typedef unsigned v4u __attribute__((ext_vector_type(4)));
typedef float f32x4 __attribute__((ext_vector_type(4)));
typedef short bf16x8 __attribute__((ext_vector_type(8)));
typedef GAS unsigned gu32;
typedef GAS unsigned long long gu64;
#define RLX_AGENT __ATOMIC_RELAXED, __HIP_MEMORY_SCOPE_AGENT
#define LDS_WAIT() asm volatile("s_waitcnt lgkmcnt(0)" ::: "memory")
#define VM_WAIT() asm volatile("s_waitcnt vmcnt(0)" ::: "memory")
__device__ __forceinline__ unsigned long long rt() { return __builtin_amdgcn_s_memrealtime(); }
__device__ __forceinline__ unsigned f2bf(float f) { unsigned u = __builtin_bit_cast(unsigned, f); return (u + 0x7fffu + ((u >> 16) & 1u)) >> 16; }
__device__ __forceinline__ unsigned pk2(float lo, float hi) { return f2bf(lo) | (f2bf(hi) << 16); }

#define XB_TMO      128
#define XB_XCNT(j)  (256  + 64 * (j))
#define XB_XSUB(j)  (1280 + 64 * (j))
#define XB_XGEN(j)  (2304 + 64 * (j))
#define XB_TOP      3328
#define XB_TOPGEN   3392
#define XCD_BAR_WORDS 3456
#define XB_SPIN_CAP (1u << 18)

__device__ __forceinline__ unsigned xb_ld(unsigned* p)              { return __hip_atomic_load(p, __ATOMIC_RELAXED, __HIP_MEMORY_SCOPE_AGENT); }
__device__ __forceinline__ unsigned xb_add(unsigned* p, unsigned v) { return __hip_atomic_fetch_add(p, v, __ATOMIC_RELAXED, __HIP_MEMORY_SCOPE_AGENT); }
__device__ __forceinline__ unsigned xb_xcc_id() { return (unsigned)__builtin_amdgcn_s_getreg((3 << 11) | 20) & 0xFu; }
#define XB_SPIN(cond, bar) do { unsigned _sp = 0; while (cond) { __builtin_amdgcn_s_sleep(1); \
    if ((++_sp & 255u) == 0u) { if (xb_ld(&(bar)[XB_TMO])) break; if (_sp > XB_SPIN_CAP) { atomicAdd(&(bar)[XB_TMO], 1u); break; } } } } while (0)

struct XcdBarrier {
    unsigned* bar; unsigned x;
    volatile LAS unsigned* st;
};

__device__ __forceinline__ XcdBarrier xcd_barrier_post(unsigned* bar, volatile LAS unsigned* st) {
    XcdBarrier b; b.bar = bar; b.x = xb_xcc_id(); b.st = st;
    if (threadIdx.x == 0) (void)xb_add(&bar[XB_XCNT(b.x)], 1u);
    return b;
}
__device__ __forceinline__ void xcd_barrier_complete(unsigned* bar, unsigned x, unsigned& nloc, unsigned& nx) {
    const unsigned G = gridDim.x * gridDim.y * gridDim.z;
    unsigned sum, cnt, mine, sp = 0u;
    for (;;) {
        sum = 0u; cnt = 0u; mine = 0u;
#pragma unroll
        for (unsigned j = 0; j < 16; ++j) { const unsigned c = xb_ld(&bar[XB_XCNT(j)]); sum += c; cnt += (c > 0u) ? 1u : 0u; mine = (j == x) ? c : mine; }
        if (sum == G) break;
        __builtin_amdgcn_s_sleep(1);
        if ((++sp & 255u) == 0u) { if (xb_ld(&bar[XB_TMO])) break; if (sp > XB_SPIN_CAP) { atomicAdd(&bar[XB_TMO], 1u); break; } }
    }
    nloc = mine > 0u ? mine : 1u; nx = cnt > 0u ? cnt : 1u;
}

__device__ __forceinline__ void xcd_barrier(const XcdBarrier& b) {
    asm volatile("s_waitcnt vmcnt(0)" ::: "memory");
    __syncthreads();
    if (threadIdx.x == 0) {
        unsigned* bar = b.bar;
        __builtin_amdgcn_s_waitcnt(0);
        unsigned nloc = b.st[0], nx = b.st[1];
        if (nloc == 0u) { xcd_barrier_complete(bar, b.x, nloc, nx); b.st[0] = nloc; b.st[1] = nx; }
        const unsigned old = xb_add(&bar[XB_XSUB(b.x)], 1u);
        const unsigned gen = old / nloc;
        if (old + 1u == (gen + 1u) * nloc) {
            __builtin_amdgcn_fence(__ATOMIC_RELEASE, "agent");
            asm volatile("s_waitcnt vmcnt(0)" ::: "memory");
            const unsigned og = xb_add(&bar[XB_TOP], 1u);
            const unsigned tg = og / nx;
            if (og + 1u == (tg + 1u) * nx) xb_add(&bar[XB_TOPGEN], 1u);
            else XB_SPIN(xb_ld(&bar[XB_TOPGEN]) == tg, bar);
            __builtin_amdgcn_fence(__ATOMIC_ACQUIRE, "agent");
            xb_add(&bar[XB_XGEN(b.x)], 1u);
            asm volatile("s_waitcnt vmcnt(0)" ::: "memory");
        } else {
            XB_SPIN(xb_ld(&bar[XB_XGEN(b.x)]) == gen, bar);
            __builtin_amdgcn_fence(__ATOMIC_ACQUIRE, "agent");
            asm volatile("s_waitcnt vmcnt(0)" ::: "memory");
        }
    }
    __syncthreads();
}
#define DEVI __device__ __forceinline__
typedef unsigned u32x2 __attribute__((ext_vector_type(2)));
DEVI float bf2f(unsigned short v) { return __builtin_bit_cast(float, (unsigned)v << 16); }
DEVI float bflo(unsigned w) { return __builtin_bit_cast(float, w << 16); }
DEVI float bfhi(unsigned w) { return __builtin_bit_cast(float, w & 0xffff0000u); }
DEVI float wave_sum(float v) {
#pragma unroll
    for (int o = 1; o < 64; o <<= 1) v += __shfl_xor(v, o);
    return v;
}
DEVI float silu_f(float x) { return x * __builtin_amdgcn_rcpf(1.0f + __builtin_amdgcn_exp2f(x * -1.4426950408889634f)); }
#define MMA16(p1, p2, acc) __builtin_amdgcn_mfma_f32_16x16x32_bf16(p1, p2, acc, 0, 0, 0)
DEVI bf16x8 ldfrag(const LAS unsigned char* img, int stride, int row0, int k0, int lane) {
    return *(const LAS bf16x8*)(img + (row0 + (lane & 15)) * stride + (k0 + 8 * (lane >> 4)) * 2);
}

DEVI void phase_mod(const float* c, const float* w_ada, const float* b_ada, const float* n1, const float* n2, const float* n3, float* MOD,
                    LAS unsigned char* lds, int vcu, int G, int tid) {
    LAS float* cb = (LAS float*)lds;
    LAS float* part = cb + 8192;
    for (int i = tid; i < 8192; i += 512) { const int b = i >> 10, k = i & 1023; cb[k * 8 + b] = c[i]; }
    __syncthreads();
    const int lane = tid & 63, wave = tid >> 6;
    constexpr int NC = 9 * D;
    int per = (NC + G - 1) / G; if (per > 64) per = 64;
    for (int base = vcu * per; base < NC; base += G * per) {
        const int j = base + lane; const bool act = lane < per && j < NC;
        float acc[8];
#pragma unroll
        for (int b = 0; b < 8; ++b) acc[b] = 0.f;
        if (act) {
            const float* wp = w_ada + (size_t)(wave * 128) * NC + j;
#pragma unroll 8
            for (int k = 0; k < 128; ++k) {
                const float wv = wp[(size_t)k * NC];
                const LAS f32x4* cp = (const LAS f32x4*)(cb + (wave * 128 + k) * 8); const f32x4 c0 = cp[0], c1 = cp[1];
                acc[0] += c0.x * wv; acc[1] += c0.y * wv; acc[2] += c0.z * wv; acc[3] += c0.w * wv;
                acc[4] += c1.x * wv; acc[5] += c1.y * wv; acc[6] += c1.z * wv; acc[7] += c1.w * wv;
            }
        }
#pragma unroll
        for (int b = 0; b < 8; ++b) part[(wave * 8 + b) * 64 + lane] = acc[b];
        __syncthreads();
        { const int b = tid >> 6;
          if (act) { float s = 0.f;
#pragma unroll
              for (int w = 0; w < 8; ++w) s += part[(w * 8 + b) * 64 + lane];
              s += b_ada[j];
              const int i = j >> 10, d = j & 1023, r3 = i % 3; float v;
              if (r3 == 0) v = s;
              else if (r3 == 1) { const float* nw = (i == 1) ? n1 : (i == 4) ? n2 : n3; v = nw[d] * (1.0f + s); }
              else v = ((i == 5) ? 1.0f : 0.5f) * (1.0f + s);
              MOD[(size_t)(i * 8 + b) * D + d] = v; } }
        __syncthreads();
    }
}

DEVI void transpose_item(const float* W, int K, int N, bf16* WT, int mode, float scale, LAS float* scr, int item, int lane) {
    const int nblk = N / 32, kb = item / nblk, nb = item % nblk, k0 = 64 * kb, n0 = 32 * nb;
    const int rb = (mode == 0) ? n0 : ((n0 >> 7) * 256 + (n0 & 127) + (mode == 2 ? 128 : 0));
#pragma unroll 8
    for (int i = 0; i < 32; ++i) { const int kk = 2 * i + (lane >> 5); scr[kk * 33 + (lane & 31)] = W[(size_t)(k0 + kk) * N + n0 + (lane & 31)] * scale; }
    LDS_WAIT(); asm volatile("" ::: "memory");
    const int c = lane & 7;
#pragma unroll
    for (int j = 0; j < 4; ++j) { const int n = (lane >> 3) + 8 * j; const LAS float* s = scr + (8 * c) * 33 + n;
        v4u o; o.x = pk2(s[0 * 33], s[1 * 33]); o.y = pk2(s[2 * 33], s[3 * 33]); o.z = pk2(s[4 * 33], s[5 * 33]); o.w = pk2(s[6 * 33], s[7 * 33]);
        *(GAS v4u*)(WT + (size_t)(rb + n) * K + k0 + 8 * c) = o; }
    LDS_WAIT(); asm volatile("" ::: "memory");
}
struct WPtrs { const float *g1, *u1, *d1, *g2, *u2, *d2, *win, *wout, *wq, *wk, *wv, *wif; };
DEVI void phase_weights(const WPtrs& P, unsigned char* ws, LAS unsigned char* lds, int gw, int NGW, int wave, int lane) {
    LAS float* scr = (LAS float*)(lds + wave * 16384);
    constexpr int I_GU = (D / 64) * (FF / 32), I_DN = (FF / 64) * (D / 32), I_IN = (D / 64) * (NIN / 32), I_OUT = (D / 64) * (D / 32), I_MH = 2 * 4;
    constexpr int NITEMS = 4 * I_GU + 2 * I_DN + I_IN + I_OUT + 12 * I_MH;
    for (int it = gw; it < NITEMS; it += NGW) {
        int r = it;
        if (r < I_GU) { transpose_item(P.g1, D, FF, (bf16*)(ws + WS_WGU1), 1, 1.f, scr, r, lane); continue; } r -= I_GU;
        if (r < I_GU) { transpose_item(P.u1, D, FF, (bf16*)(ws + WS_WGU1), 2, 1.f, scr, r, lane); continue; } r -= I_GU;
        if (r < I_GU) { transpose_item(P.g2, D, FF, (bf16*)(ws + WS_WGU2), 1, 1.f, scr, r, lane); continue; } r -= I_GU;
        if (r < I_GU) { transpose_item(P.u2, D, FF, (bf16*)(ws + WS_WGU2), 2, 1.f, scr, r, lane); continue; } r -= I_GU;
        if (r < I_DN) { transpose_item(P.d1, FF, D, (bf16*)(ws + WS_WD1), 0, 1.f, scr, r, lane); continue; } r -= I_DN;
        if (r < I_DN) { transpose_item(P.d2, FF, D, (bf16*)(ws + WS_WD2), 0, 1.f, scr, r, lane); continue; } r -= I_DN;
        if (r < I_IN) { transpose_item(P.win, D, NIN, (bf16*)(ws + WS_WIN), 0, 1.f, scr, r, lane); continue; } r -= I_IN;
        if (r < I_OUT) { transpose_item(P.wout, D, D, (bf16*)(ws + WS_WOUT), 0, 1.f, scr, r, lane); continue; } r -= I_OUT;
        const int which = r / (4 * I_MH), hh = (r / I_MH) & 3, sub = r % I_MH; const size_t ho = (size_t)hh * MHD * MHD;
        if (which == 0) transpose_item(P.wq + ho, MHD, MHD, (bf16*)(ws + WS_WQM) + ho, 0, 1.f, scr, sub, lane);
        else if (which == 1) transpose_item(P.wk + ho, MHD, MHD, (bf16*)(ws + WS_WKM) + ho, 0, 0.08838834764831845f, scr, sub, lane);
        else transpose_item(P.wv + ho, MHD, MHD, (bf16*)(ws + WS_WVM) + ho, 0, 1.f, scr, sub, lane);
    }
}
DEVI void phase_weff(const WPtrs& P, unsigned char* ws, int gtid, int NT_) {
    bf16* WEC = (bf16*)(ws + WS_WEC); bf16* WEM = (bf16*)(ws + WS_WEM);
    for (int o = gtid; o < 2 * MH * 16 * MHD; o += NT_) {
        const int m = o / (MH * 16 * MHD), r = o % (MH * 16 * MHD), hh = r / (16 * MHD), g = (r / MHD) & 15, d = r % MHD;
        float s = 0.f;
        if (g < 8) {
            if (m == 0) { const float* a = P.wq + ((size_t)hh * MHD + d) * MHD; const float* b2 = P.wk + ((size_t)hh * MHD + d) * MHD;
                for (int e = 0; e < MHD; ++e) s += a[e] * P.wif[(size_t)(hh * 384 + e) * 8 + g] + b2[e] * P.wif[(size_t)(hh * 384 + 128 + e) * 8 + g]; }
            else { const float* a = P.wv + ((size_t)hh * MHD + d) * MHD;
                for (int e = 0; e < MHD; ++e) s += a[e] * P.wif[(size_t)(hh * 384 + 256 + e) * 8 + g]; }
        }
        (m == 0 ? WEC : WEM)[r] = (bf16)f2bf(s);
    }
}
DEVI void modnorm_rows(const float* X, const float* A, const float* Bv, bf16* XN, int gw, int NGW, int lane) {
    for (int m = gw; m < M; m += NGW) {
        const GAS f32x4* xr = (const GAS f32x4*)(X + (size_t)m * D) + lane; const int b = m / SEQ;
        f32x4 v[4]; float s = 0.f;
#pragma unroll
        for (int j = 0; j < 4; ++j) { v[j] = xr[64 * j]; s += (v[j].x * v[j].x + v[j].y * v[j].y) + (v[j].z * v[j].z + v[j].w * v[j].w); }
        const float rstd = 1.0f / sqrtf(wave_sum(s) * (1.f / D) + EPS);
        const f32x4* ap = (const f32x4*)(A + (size_t)b * D) + lane; const f32x4* bp = (const f32x4*)(Bv + (size_t)b * D) + lane;
        GAS unsigned long long* o8 = (GAS unsigned long long*)(XN + (size_t)m * D) + lane;
#pragma unroll
        for (int j = 0; j < 4; ++j) { const f32x4 a = ap[64 * j], bb = bp[64 * j]; const f32x4 o = v[j] * rstd * a + bb;
            o8[64 * j] = (unsigned long long)pk2(o.x, o.y) | ((unsigned long long)pk2(o.z, o.w) << 32); }
    }
}
DEVI void final_rows(float* X, const float* w, int gw, int NGW, int lane) {
    for (int m = gw; m < M; m += NGW) {
        GAS f32x4* xr = (GAS f32x4*)(X + (size_t)m * D) + lane;
        f32x4 v[4]; float s = 0.f;
#pragma unroll
        for (int j = 0; j < 4; ++j) { v[j] = xr[64 * j]; s += (v[j].x * v[j].x + v[j].y * v[j].y) + (v[j].z * v[j].z + v[j].w * v[j].w); }
        const float rstd = 1.0f / sqrtf(wave_sum(s) * (1.f / D) + EPS);
        const f32x4* wp = (const f32x4*)w + lane;
#pragma unroll
        for (int j = 0; j < 4; ++j) xr[64 * j] = v[j] * rstd * wp[64 * j];
    }
}
DEVI void catnorm_rows(bf16* CAT, const float* w, int gw, int NGW, int lane) {
    for (int m = gw; m < M; m += NGW) {
        GAS v4u* p = (GAS v4u*)(CAT + (size_t)m * D) + lane; const v4u q = *p;
        float f[8] = {bflo(q.x), bfhi(q.x), bflo(q.y), bfhi(q.y), bflo(q.z), bfhi(q.z), bflo(q.w), bfhi(q.w)};
        float s = 0.f;
#pragma unroll
        for (int j = 0; j < 8; ++j) s += f[j] * f[j];
        const float rstd = 1.0f / sqrtf(wave_sum(s) * (1.f / AW) + EPS);
        const f32x4 w0 = ((const f32x4*)w)[2 * lane], w1 = ((const f32x4*)w)[2 * lane + 1];
        v4u o; o.x = pk2(f[0] * rstd * w0.x, f[1] * rstd * w0.y); o.y = pk2(f[2] * rstd * w0.z, f[3] * rstd * w0.w);
        o.z = pk2(f[4] * rstd * w1.x, f[5] * rstd * w1.y); o.w = pk2(f[6] * rstd * w1.z, f[7] * rstd * w1.w);
        *p = o;
    }
}

DEVI void phase_kmean(const bf16* K, float* KMEAN, int vcu, int G, int tid) {
    for (int u = vcu; u < BATCH * NB; u += G) {
        const int b = u / NB, n = u % NB; const bf16* kp = K + ((size_t)b * SEQ + n * 256) * AW + tid;
        float s = 0.f;
#pragma unroll 16
        for (int r = 0; r < 256; ++r) s += bf2f(kp[(size_t)r * AW]);
        KMEAN[((size_t)(b * AHN + (tid >> 6)) * NB + n) * 64 + (tid & 63)] = s * (1.0f / 256.0f);
    }
}
DEVI void phase_topk(const bf16* Q, const float* KMEAN, unsigned short* SEL, LAS unsigned char* lds, int vcu, int G, int tid) {
    LAS float* km = (LAS float*)lds;
    for (int u = vcu; u < BATCH * AHN * 4; u += G) {
        const int bh = u >> 2, qtr = u & 3, b = bh / AHN, h = bh % AHN;
        __syncthreads();
        for (int i = tid; i < NB * 64; i += 512) km[i] = KMEAN[(size_t)bh * NB * 64 + i];
        __syncthreads();
        for (int it = 0; it < 2; ++it) {
            const int s = qtr * 1024 + it * 512 + tid, bq = s >> 8;
            const v4u* qp = (const v4u*)(Q + ((size_t)b * SEQ + s) * AW + h * 64);
            float q[64];
#pragma unroll
            for (int c = 0; c < 8; ++c) { const v4u w = qp[c]; q[8 * c] = bflo(w.x); q[8 * c + 1] = bfhi(w.x); q[8 * c + 2] = bflo(w.y); q[8 * c + 3] = bfhi(w.y);
                q[8 * c + 4] = bflo(w.z); q[8 * c + 5] = bfhi(w.z); q[8 * c + 6] = bflo(w.w); q[8 * c + 7] = bfhi(w.w); }
            float v1 = -INFINITY, v2 = -INFINITY, v3 = -INFINITY; int i1 = -1, i2 = -1, i3 = -1;
            for (int n = 0; n < bq; ++n) {
                float g = 0.f;
#pragma unroll
                for (int d = 0; d < 64; ++d) g += q[d] * km[n * 64 + d];
                if (g > v1) { v3 = v2; i3 = i2; v2 = v1; i2 = i1; v1 = g; i1 = n; }
                else if (g > v2) { v3 = v2; i3 = i2; v2 = g; i2 = n; }
                else if (g > v3) { v3 = g; i3 = n; }
            }
            unsigned mk = 0u; if (i1 >= 0) mk |= 1u << i1; if (i2 >= 0) mk |= 1u << i2; if (i3 >= 0) mk |= 1u << i3;
            SEL[(size_t)bh * SEQ + s] = (unsigned short)mk;
        }
    }
}
DEVI unsigned pkbf(float lo, float hi) { return pk2(lo, hi); }
constexpr int ST128 = 272, ST64 = 144;
DEVI void mlstm_pre_unit(int tt, int h, const bf16* XM, const float* conv_w, const float* conv_b, const bf16* WQ, const bf16* WK, const bf16* WV, const bf16* WEC, const bf16* WEM,
                         bf16* XC, bf16* QM, bf16* KM, bf16* KMT, bf16* VMT, float* GP, LAS unsigned char* lds, int tid) {
    const int lane = tid & 63, wave = __builtin_amdgcn_readfirstlane(tid >> 6);
    LAS unsigned char* XmI = lds;
    LAS unsigned char* XcI = lds + 68 * ST128;
    const int R0 = tt * 64, t0 = R0 % SEQ, b = R0 / SEQ;
    for (int ch = tid; ch < 67 * 16; ch += 512) { const int ir = ch >> 4, cc = ch & 15; v4u v = {0u, 0u, 0u, 0u};
        if (ir >= 3 || t0 > 0) v = *(const v4u*)(XM + (size_t)(R0 - 3 + ir) * MW + h * MHD + cc * 8);
        *(LAS v4u*)(XmI + ir * ST128 + cc * 16) = v; }
    __syncthreads();
    { const int t = tid >> 3, c0 = (tid & 7) * 16;
#pragma unroll
      for (int hf = 0; hf < 2; ++hf) { const int cb = c0 + 8 * hf; float a[8];
#pragma unroll
          for (int j = 0; j < 8; ++j) a[j] = conv_b[h * MHD + cb + j];
#pragma unroll
          for (int j4 = 0; j4 < 4; ++j4) { const v4u xv = *(const LAS v4u*)(XmI + (t + j4) * ST128 + cb * 2); const float* wp = conv_w + j4 * MW + h * MHD + cb;
              a[0] += wp[0] * bflo(xv.x); a[1] += wp[1] * bfhi(xv.x); a[2] += wp[2] * bflo(xv.y); a[3] += wp[3] * bfhi(xv.y);
              a[4] += wp[4] * bflo(xv.z); a[5] += wp[5] * bfhi(xv.z); a[6] += wp[6] * bflo(xv.w); a[7] += wp[7] * bfhi(xv.w); }
#pragma unroll
          for (int j = 0; j < 8; ++j) a[j] = silu_f(a[j]);
          v4u o; o.x = pkbf(a[0], a[1]); o.y = pkbf(a[2], a[3]); o.z = pkbf(a[4], a[5]); o.w = pkbf(a[6], a[7]);
          *(LAS v4u*)(XcI + t * ST128 + cb * 2) = o; *(v4u*)(XC + (size_t)(R0 + t) * MW + h * MHD + cb) = o; } }
    __syncthreads();
    const int e0 = wave * 16, lr = lane & 15, lg = lane >> 4;
    bf16x8 wq[4], wk[4], wv[4];
#pragma unroll
    for (int ks = 0; ks < 4; ++ks) { const size_t o = ((size_t)(h * MHD + e0 + lr)) * MHD + 32 * ks + 8 * lg;
        wq[ks] = *(const bf16x8*)(WQ + o); wk[ks] = *(const bf16x8*)(WK + o); wv[ks] = *(const bf16x8*)(WV + o); }
    f32x4 aQ[4], aK[4], aKT[4], aVT[4];
#pragma unroll
    for (int i = 0; i < 4; ++i) { aQ[i] = (f32x4){0.f, 0.f, 0.f, 0.f}; aK[i] = aQ[i]; aKT[i] = aQ[i]; aVT[i] = aQ[i]; }
#pragma unroll
    for (int t4 = 0; t4 < 4; ++t4)
#pragma unroll
        for (int ks = 0; ks < 4; ++ks) { const bf16x8 xc = ldfrag(XcI, ST128, 16 * t4, 32 * ks, lane), xm = ldfrag(XmI, ST128, 16 * t4 + 3, 32 * ks, lane);
            aQ[t4] = MMA16(wq[ks], xc, aQ[t4]); aK[t4] = MMA16(wk[ks], xc, aK[t4]); aKT[t4] = MMA16(xc, wk[ks], aKT[t4]); aVT[t4] = MMA16(xm, wv[ks], aVT[t4]); }
    const size_t cbase = ((size_t)((b * MH + h) * 64 + (t0 >> 6))) * (MHD * 64);
#pragma unroll
    for (int t4 = 0; t4 < 4; ++t4) {
        { const size_t o = (size_t)(R0 + 16 * t4 + lr) * MW + h * MHD + e0 + 4 * lg;
          *(u32x2*)(QM + o) = (u32x2){pkbf(aQ[t4][0], aQ[t4][1]), pkbf(aQ[t4][2], aQ[t4][3])};
          *(u32x2*)(KM + o) = (u32x2){pkbf(aK[t4][0], aK[t4][1]), pkbf(aK[t4][2], aK[t4][3])}; }
        { const size_t o = cbase + (size_t)(e0 + lr) * 64 + 16 * t4 + 4 * lg;
          *(u32x2*)(KMT + o) = (u32x2){pkbf(aKT[t4][0], aKT[t4][1]), pkbf(aKT[t4][2], aKT[t4][3])};
          *(u32x2*)(VMT + o) = (u32x2){pkbf(aVT[t4][0], aVT[t4][1]), pkbf(aVT[t4][2], aVT[t4][3])}; }
    }
    if (wave < 4) {
        f32x4 aG = (f32x4){0.f, 0.f, 0.f, 0.f};
#pragma unroll
        for (int ks = 0; ks < 4; ++ks) { const size_t o = ((size_t)(h * 16 + lr)) * MHD + 32 * ks + 8 * lg;
            const bf16x8 wc = *(const bf16x8*)(WEC + o), wm = *(const bf16x8*)(WEM + o);
            const bf16x8 xc = ldfrag(XcI, ST128, 16 * wave, 32 * ks, lane), xm = ldfrag(XmI, ST128, 16 * wave + 3, 32 * ks, lane);
            aG = MMA16(wc, xc, aG); aG = MMA16(wm, xm, aG); }
        if (lg < 2) *(f32x4*)(GP + (size_t)(R0 + 16 * wave + lr) * 32 + h * 8 + 4 * lg) = aG;
    }
    __syncthreads();
}
constexpr int L_QI = 0, L_KI = L_QI + 64 * ST128, L_KTW = L_KI + 64 * ST128, L_VTI = L_KTW + 128 * ST64, L_PI = L_VTI + SV * ST64, L_SI = L_PI + 64 * ST64, L_MISC = L_SI + SV * ST128;
static_assert(L_MISC + 4096 <= RING_BYTES, "mLSTM LDS map");
DEVI void mlstm_gates(const float* GP, const float* b_if, size_t row0, int h, LAS float* misc, int tid) {
    if (tid < 64) { const int t = tid; const float* gp = GP + (row0 + t) * 32; float ip = b_if[h], fp = b_if[4 + h];
#pragma unroll
        for (int hh = 0; hh < 4; ++hh) { ip += gp[hh * 8 + h]; fp += gp[hh * 8 + 4 + h]; }
        const float lf = fminf(fp, 0.f) - log1pf(expf(-fabsf(fp)));
        float F = lf;
#pragma unroll
        for (int o = 1; o < 64; o <<= 1) { const float v = __shfl_up(F, o); if (t >= o) F += v; }
        const float Fend = __shfl(F, 63);
        misc[t] = F; misc[64 + t] = ip - F; misc[128 + t] = expf(Fend - F + ip); misc[192 + t] = expf(F);
        if (t == 0) { misc[576] = expf(Fend); misc[577] = Fend; } }
}
DEVI void stage_rows64(const bf16* src, int pitch, LAS unsigned char* img, int tid) {
    for (int ch = tid; ch < 64 * 16; ch += 512) { const int r = ch >> 4, cc = ch & 15; *(LAS v4u*)(img + r * ST128 + cc * 16) = *(const v4u*)(src + (size_t)r * pitch + cc * 8); }
}
DEVI void stage_T(const bf16* src, LAS unsigned char* img, const LAS float* wS, int tid) {
    for (int ch = tid; ch < 128 * 8; ch += 512) { const int r = ch >> 3, cc = ch & 7; v4u v = *(const v4u*)(src + (size_t)r * 64 + cc * 8);
        if (wS) { const LAS float* w = wS + cc * 8;
            v.x = pkbf(bflo(v.x) * w[0], bfhi(v.x) * w[1]); v.y = pkbf(bflo(v.y) * w[2], bfhi(v.y) * w[3]); v.z = pkbf(bflo(v.z) * w[4], bfhi(v.z) * w[5]); v.w = pkbf(bflo(v.w) * w[6], bfhi(v.w) * w[7]); }
        *(LAS v4u*)(img + r * ST64 + cc * 16) = v; }
}
DEVI void ones_rows(LAS unsigned char* VTi, int tid) {
    for (int ch = tid; ch < 16 * 8; ch += 512) { const int r = ch >> 3, cc = ch & 7; const unsigned w = (r == 0) ? 0x3f803f80u : 0u; *(LAS v4u*)(VTi + (128 + r) * ST64 + cc * 16) = (v4u){w, w, w, w}; }
}
DEVI void state_update(f32x4 (&accS)[9], const LAS unsigned char* lds, float g, int wave, int lane) {
    const bf16x8 k0 = ldfrag(lds + L_KTW, ST64, 16 * wave, 0, lane), k1 = ldfrag(lds + L_KTW, ST64, 16 * wave, 32, lane);
#pragma unroll
    for (int vt = 0; vt < 9; ++vt) { accS[vt] = accS[vt] * g;
        accS[vt] = MMA16(k0, ldfrag(lds + L_VTI, ST64, 16 * vt, 0, lane), accS[vt]); accS[vt] = MMA16(k1, ldfrag(lds + L_VTI, ST64, 16 * vt, 32, lane), accS[vt]); }
}
DEVI void mlstm_chunkstate_unit(int bh, int sc, const bf16* KMT, const bf16* VMT, const float* GP, const float* b_if, float* DST, float* GSUP, LAS unsigned char* lds, int tid) {
    const int lane = tid & 63, wave = __builtin_amdgcn_readfirstlane(tid >> 6), b = bh / MH, h = bh % MH;
    LAS float* misc = (LAS float*)(lds + L_MISC);
    f32x4 accS[9];
#pragma unroll
    for (int i = 0; i < 9; ++i) accS[i] = (f32x4){0.f, 0.f, 0.f, 0.f};
    ones_rows(lds + L_VTI, tid);
    float Ftot = 0.f;
    for (int j = 0; j < 4; ++j) {
        const int ck = sc * 4 + j; const size_t row0 = (size_t)b * SEQ + (size_t)ck * 64, cbase = ((size_t)(bh * 64 + ck)) * (MHD * 64);
        mlstm_gates(GP, b_if, row0, h, misc, tid);
        __syncthreads();
        stage_T(KMT + cbase, lds + L_KTW, misc + 128, tid); stage_T(VMT + cbase, lds + L_VTI, nullptr, tid);
        __syncthreads();
        state_update(accS, lds, misc[576], wave, lane); Ftot += misc[577];
        __syncthreads();
    }
    const size_t ub = ((size_t)(bh * 16 + sc)) * (SV * MHD);
#pragma unroll
    for (int vt = 0; vt < 9; ++vt) *(f32x4*)(DST + ub + (size_t)(16 * vt + (lane & 15)) * MHD + 16 * wave + 4 * (lane >> 4)) = accS[vt];
    if (tid == 0) GSUP[bh * 16 + sc] = expf(Ftot);
}
DEVI void phase_scan(const float* DST, const float* GSUP, bf16* SST, int gtid, int NT_) {
    constexpr int E = SV * MHD;
    for (int e = gtid; e < BATCH * MH * E; e += NT_) { const int bh = e / E, idx = e % E; float s = 0.f;
        for (int c = 0; c < 16; ++c) { const size_t o = ((size_t)(bh * 16 + c)) * E + idx; SST[o] = (bf16)f2bf(s); s = GSUP[bh * 16 + c] * s + DST[o]; } }
}
DEVI void mlstm_out_unit(int bh, int sc, const bf16* QM, const bf16* KM, const bf16* KMT, const bf16* VMT, const float* GP, const float* b_if, const bf16* SST,
                         const bf16* XC, const bf16* Z, const float* normw, const float* skipw, bf16* CAT, LAS unsigned char* lds, int tid) {
    const int lane = tid & 63, wave = __builtin_amdgcn_readfirstlane(tid >> 6), b = bh / MH, h = bh % MH, lr = lane & 15, lg = lane >> 4;
    LAS float* misc = (LAS float*)(lds + L_MISC);
    const size_t ub = ((size_t)(bh * 16 + sc)) * (SV * MHD);
    f32x4 accS[9];
#pragma unroll
    for (int vt = 0; vt < 9; ++vt) { const u32x2 w = *(const u32x2*)(SST + ub + (size_t)(16 * vt + lr) * MHD + 16 * wave + 4 * lg); accS[vt] = (f32x4){bflo(w.x), bfhi(w.x), bflo(w.y), bfhi(w.y)}; }
#if defined(DBG_SAN)
    { auto san = [](unsigned w) -> unsigned { float lo = bflo(w), hi = bfhi(w); if (!(fabsf(lo) < 1e6f)) lo = 0.f; if (!(fabsf(hi) < 1e6f)) hi = 0.f; return pk2(lo, hi); };
#pragma unroll
      for (int vt = 0; vt < 9; ++vt) for (int r = 0; r < 4; ++r) if (!(fabsf(accS[vt][r]) < 1e6f)) accS[vt][r] = 0.f;
      for (int ch = tid; ch < SV * 16; ch += 512) { const int r = ch >> 4, cc = ch & 15; v4u v = *(const v4u*)(SST + ub + (size_t)r * MHD + cc * 8); v.x = san(v.x); v.y = san(v.y); v.z = san(v.z); v.w = san(v.w); *(LAS v4u*)(lds + L_SI + r * ST128 + cc * 16) = v; } }
#else
    for (int ch = tid; ch < SV * 16; ch += 512) { const int r = ch >> 4, cc = ch & 15; *(LAS v4u*)(lds + L_SI + r * ST128 + cc * 16) = *(const v4u*)(SST + ub + (size_t)r * MHD + cc * 8); }
#endif
    ones_rows(lds + L_VTI, tid);
    for (int j = 0; j < 4; ++j) {
        const int ck = sc * 4 + j; const size_t row0 = (size_t)b * SEQ + (size_t)ck * 64, cbase = ((size_t)(bh * 64 + ck)) * (MHD * 64);
        mlstm_gates(GP, b_if, row0, h, misc, tid);
        stage_rows64(QM + row0 * MW + h * MHD, MW, lds + L_QI, tid); stage_rows64(KM + row0 * MW + h * MHD, MW, lds + L_KI, tid);
        stage_T(VMT + cbase, lds + L_VTI, nullptr, tid);
        __syncthreads();
        stage_T(KMT + cbase, lds + L_KTW, misc + 128, tid);
        { const int tt = wave >> 1, t = 16 * tt + lr; const float Ft = misc[t];
#pragma unroll
          for (int q2 = 0; q2 < 2; ++q2) { const int st = 2 * (wave & 1) + q2; f32x4 a = (f32x4){0.f, 0.f, 0.f, 0.f};
              if (st <= tt) {
#pragma unroll
                  for (int ks = 0; ks < 4; ++ks) a = MMA16(ldfrag(lds + L_KI, ST128, 16 * st, 32 * ks, lane), ldfrag(lds + L_QI, ST128, 16 * tt, 32 * ks, lane), a);
#pragma unroll
                  for (int r = 0; r < 4; ++r) { const int s = 16 * st + 4 * lg + r; a[r] = (s <= t) ? a[r] * expf(Ft + misc[64 + s]) : 0.f; } }
              *(LAS u32x2*)(lds + L_PI + t * ST64 + (16 * st + 4 * lg) * 2) = (u32x2){pkbf(a[0], a[1]), pkbf(a[2], a[3])}; } }
        __syncthreads();
        const int tt = wave & 3, hf = wave >> 2, t = 16 * tt + lr; const float aT = misc[192 + t];
        f32x4 num[5];
#pragma unroll
        for (int i = 0; i < 5; ++i) { const int vt = (i < 4) ? (4 * hf + i) : 8; f32x4 aI = (f32x4){0.f, 0.f, 0.f, 0.f}, aX = aI;
            if (i < 4 || hf == 0) {
#pragma unroll
                for (int ks = 0; ks < 2; ++ks) aI = MMA16(ldfrag(lds + L_VTI, ST64, 16 * vt, 32 * ks, lane), ldfrag(lds + L_PI, ST64, 16 * tt, 32 * ks, lane), aI);
#pragma unroll
                for (int ks = 0; ks < 4; ++ks) aX = MMA16(ldfrag(lds + L_SI, ST128, 16 * vt, 32 * ks, lane), ldfrag(lds + L_QI, ST128, 16 * tt, 32 * ks, lane), aX); }
#if defined(DBG_NOSTATE)
            num[i] = aI + aX * 0.f; }
#else
            num[i] = aI + aX * aT; }
#endif
        if (hf == 0 && lg == 0) misc[256 + t] = num[4][0];
        __syncthreads();
        { const float dinv = 1.0f / fmaxf(fabsf(misc[256 + t]), 1.0f); float s1 = 0.f, s2 = 0.f;
#pragma unroll
          for (int i = 0; i < 4; ++i) { num[i] = num[i] * dinv; s1 += (num[i][0] + num[i][1]) + (num[i][2] + num[i][3]); s2 += (num[i][0] * num[i][0] + num[i][1] * num[i][1]) + (num[i][2] * num[i][2] + num[i][3] * num[i][3]); }
          s1 += __shfl_xor(s1, 16); s1 += __shfl_xor(s1, 32); s2 += __shfl_xor(s2, 16); s2 += __shfl_xor(s2, 32);
          if (lg == 0) { misc[320 + hf * 64 + t] = s1; misc[448 + hf * 64 + t] = s2; } }
        __syncthreads();
        { const float mean = (misc[320 + t] + misc[384 + t]) * (1.0f / MHD), var = (misc[448 + t] + misc[512 + t]) * (1.0f / MHD) - mean * mean, rstd = 1.0f / sqrtf(fmaxf(var, 0.f) + EPS);
#pragma unroll
          for (int i = 0; i < 4; ++i) { const int v = 16 * (4 * hf + i) + 4 * lg, col = h * MHD + v; const size_t ro = row0 + t;
              const u32x2 xw = *(const u32x2*)(XC + ro * MW + col), zw = *(const u32x2*)(Z + ro * MW + col);
              const f32x4 nw = *(const f32x4*)(normw + col), sw = *(const f32x4*)(skipw + col);
              const float xc[4] = {bflo(xw.x), bfhi(xw.x), bflo(xw.y), bfhi(xw.y)}, zz[4] = {bflo(zw.x), bfhi(zw.x), bflo(zw.y), bfhi(zw.y)}; float o[4];
#pragma unroll
              for (int r = 0; r < 4; ++r) { const float hn = (num[i][r] - mean) * rstd * nw[r]; o[r] = (hn + sw[r] * xc[r]) * silu_f(zz[r]); }
              *(u32x2*)(CAT + ro * D + AW + col) = (u32x2){pkbf(o[0], o[1]), pkbf(o[2], o[3])}; } }
#if !defined(DBG_NOUPD)
        state_update(accS, lds, misc[576], wave, lane);
#endif
#if defined(DBG_SAN2)
        for (int vt = 0; vt < 9; ++vt) for (int r = 0; r < 4; ++r) if (!(fabsf(accS[vt][r]) < 1e6f)) accS[vt][r] = 0.f;
#endif
        __syncthreads();
        if (j < 3) {
#pragma unroll
            for (int vt = 0; vt < 9; ++vt) *(LAS u32x2*)(lds + L_SI + (16 * vt + lr) * ST128 + (16 * wave + 4 * lg) * 2) = (u32x2){pkbf(accS[vt][0], accS[vt][1]), pkbf(accS[vt][2], accS[vt][3])};
        }
    }
    __syncthreads();
}
#ifndef MK_PER_PHASE
#define MK_PER_PHASE 1
#endif
constexpr int NPHASE = 15;
struct Args { const float* in[26]; float* out; unsigned char* ws; int ph_lo, ph_hi; };
__global__ void __launch_bounds__(NWAVES * 64, 2) mk_fwd(Args args) {
    extern __shared__ __attribute__((aligned(16))) unsigned char lds_raw[];
    LAS unsigned char* lds = (LAS unsigned char*)lds_raw;
    volatile LAS unsigned* MISC = (volatile LAS unsigned*)(lds + MISC_OFF);
    const int tid = threadIdx.x, lane = tid & 63, wave = __builtin_amdgcn_readfirstlane(tid >> 6);
    const int G = gridDim.x; const int bx = blockIdx.x; const int vcu = (G % 8 == 0) ? (bx % 8) * (G / 8) + bx / 8 : bx;
    const int gw = vcu * NWAVES + wave, NGW = G * NWAVES, gtid = vcu * (NWAVES * 64) + tid, NTH = G * NWAVES * 64;
    unsigned char* ws = args.ws;
    gu32* ctl = (gu32*)(ws + WS_CTL);
    const float* x = args.in[0]; const float* cvec = args.in[1]; const float* w_ada = args.in[2]; const float* b_ada = args.in[3];
    const float* ffn1_norm = args.in[4]; const float* mix_norm = args.in[8]; const float* conv_w = args.in[10]; const float* conv_b = args.in[11];
    const float* b_if = args.in[16]; const float* mlstm_norm = args.in[17]; const float* mlstm_skip = args.in[18]; const float* attn_norm = args.in[19];
    const float* ffn2_norm = args.in[21]; const float* final_norm = args.in[25];
    float* out = args.out;
    float* MOD = (float*)(ws + WS_MOD);
    bf16* XN = (bf16*)(ws + WS_XN); bf16* HB = (bf16*)(ws + WS_HB); bf16* CAT = (bf16*)(ws + WS_CAT);
    bf16* Qb = (bf16*)(ws + WS_Q); bf16* Kb = (bf16*)(ws + WS_K); bf16* Vb = (bf16*)(ws + WS_V); bf16* XMb = (bf16*)(ws + WS_XM); bf16* Zb = (bf16*)(ws + WS_Z);
    bf16* QM = (bf16*)(ws + WS_QM); bf16* KM = (bf16*)(ws + WS_KM); bf16* KMT = (bf16*)(ws + WS_KMT); bf16* VMT = (bf16*)(ws + WS_VMT); bf16* XC = (bf16*)(ws + WS_XC);
    float* GP = (float*)(ws + WS_GP); float* GSUP = (float*)(ws + WS_GSUP); float* DST = (float*)(ws + WS_DST); bf16* SST = (bf16*)(ws + WS_SST);
    float* KMEAN = (float*)(ws + WS_KMEAN); unsigned short* SEL = (unsigned short*)(ws + WS_SEL);

    for (int u = tid; u < (LDS_BYTES - LDSCTL_OFF) / 4; u += NWAVES * 64) ((LAS unsigned*)(lds + LDSCTL_OFF))[u] = 0u;
    __syncthreads();
    XcdBarrier bar; bar.bar = (unsigned*)(ctl + CW_BAR); bar.x = 0; bar.st = nullptr;
    if (!MK_PER_PHASE) bar = xcd_barrier_post((unsigned*)(ctl + CW_BAR), MISC + 8);
    const int lo = args.ph_lo, hi = args.ph_hi;
#ifndef DBG_SKIP_LO
#define DBG_SKIP_LO 99
#define DBG_SKIP_HI 99
#endif
#define IN(k) (lo <= (k) && (k) < hi && !((k) >= DBG_SKIP_LO && (k) < DBG_SKIP_HI))
#ifndef DBG_FLAGS
#define DBG_FLAGS 0
#endif
#define NO_ATTN (DBG_FLAGS & 1)
#define NO_MLSTM (DBG_FLAGS & 2)
#define NO_CHUNK (DBG_FLAGS & 4)
#define SEAM(k) do { if (IN(k) && IN((k) + 1)) xcd_barrier(bar); } while (0)

    if (IN(0)) { phase_mod(cvec, w_ada, b_ada, ffn1_norm, mix_norm, ffn2_norm, MOD, lds, vcu, G, tid); __syncthreads(); }
    SEAM(0);
    if (IN(1)) {
        WPtrs P{args.in[5], args.in[6], args.in[7], args.in[22], args.in[23], args.in[24], args.in[9], args.in[20], args.in[12], args.in[13], args.in[14], args.in[15]};
        phase_weights(P, ws, lds, gw, NGW, wave, lane);
        phase_weff(P, ws, gtid, NTH);
        modnorm_rows(x, MOD + 1 * 8 * D, MOD + 0 * 8 * D, XN, gw, NGW, lane);
    }
    SEAM(1);
    if (IN(2)) { pg8::Gemm g{XN, (const bf16*)(ws + WS_WGU1), M, NGU, D}; pg8::StaticOrder S; S.init(M, NGU, G, bx);
        pg8::EpiSwiGLU E{HB, FF}; pg8::gemm_phase<pg8::EpiSwiGLU, pg8::StaticOrder, PG8_ALIGN, PG8_SP2>(lds + RING_OFF, g, S, E); }
    SEAM(2);
    if (IN(3)) { pg8::Gemm g{HB, (const bf16*)(ws + WS_WD1), M, D, FF}; pg8::StaticOrder S; S.init(M, D, G, bx);
        pg8::EpiResid E{x, out, D, MOD + 2 * 8 * D, SEQ / 256}; pg8::gemm_phase<pg8::EpiResid, pg8::StaticOrder, PG8_ALIGN, PG8_SP2>(lds + RING_OFF, g, S, E); }
    SEAM(3);
    if (IN(4)) modnorm_rows(out, MOD + 4 * 8 * D, MOD + 3 * 8 * D, XN, gw, NGW, lane);
    SEAM(4);
    if (IN(5)) { pg8::Gemm g{XN, (const bf16*)(ws + WS_WIN), M, NIN, D}; pg8::StaticOrder S; S.init(M, NIN, G, bx);
        pg8::EpiBf16<0> E{Qb, AW, nullptr, AW, (size_t)(WS_K - WS_Q) / 2, attn_body::C2}; pg8::gemm_phase<pg8::EpiBf16<0>, pg8::StaticOrder, PG8_ALIGN, PG8_SP2>(lds + RING_OFF, g, S, E); }
    SEAM(5);
    if (IN(6)) {
        if (!NO_ATTN) phase_kmean(Kb, KMEAN, vcu, G, tid);
        if (!NO_MLSTM) for (int u = vcu; u < (M / 64) * MH; u += G)
            mlstm_pre_unit(u >> 2, u & 3, XMb, conv_w, conv_b, (const bf16*)(ws + WS_WQM), (const bf16*)(ws + WS_WKM), (const bf16*)(ws + WS_WVM), (const bf16*)(ws + WS_WEC), (const bf16*)(ws + WS_WEM),
                           XC, QM, KM, KMT, VMT, GP, lds, tid);
    }
    SEAM(6);
    if (IN(7)) {
        if (!NO_ATTN) phase_topk(Qb, KMEAN, SEL, lds, vcu, G, tid);
        __syncthreads();
        if (!NO_MLSTM && !NO_CHUNK) for (int u = vcu; u < BATCH * MH * 16; u += G) mlstm_chunkstate_unit(u >> 4, u & 15, KMT, VMT, GP, b_if, DST, GSUP, lds, tid);
    }
    SEAM(7);
    if (IN(8)) {
        if (!NO_MLSTM && !NO_CHUNK) phase_scan(DST, GSUP, SST, gtid, NTH);
        const attn_body::AttnTensors AT{(const attn_body::bf16*)Qb, (const attn_body::bf16*)Kb, (const attn_body::bf16*)Vb, (attn_body::bf16*)CAT, SEL};
        const attn_body::StaticOrder S(G, bx);
        if (!NO_ATTN) attn_body::attn_phase<attn_body::StaticOrder>((char*)lds_raw + RING_OFF, AT, S);
    }
    SEAM(8);
    if (IN(9)) {
        if (!NO_MLSTM) for (int u = vcu; u < BATCH * MH * 16; u += G) mlstm_out_unit(u >> 4, u & 15, QM, KM, KMT, VMT, GP, b_if, SST, XC, Zb, mlstm_norm, mlstm_skip, CAT, lds, tid);
        if (!NO_ATTN) catnorm_rows(CAT, attn_norm, gw, NGW, lane);
    }
    SEAM(9);
    if (IN(10)) { pg8::Gemm g{CAT, (const bf16*)(ws + WS_WOUT), M, D, D}; pg8::StaticOrder S; S.init(M, D, G, bx);
        pg8::EpiResid E{out, out, D, MOD + 5 * 8 * D, SEQ / 256}; pg8::gemm_phase<pg8::EpiResid, pg8::StaticOrder, PG8_ALIGN, PG8_SP2>(lds + RING_OFF, g, S, E); }
    SEAM(10);
    if (IN(11)) modnorm_rows(out, MOD + 7 * 8 * D, MOD + 6 * 8 * D, XN, gw, NGW, lane);
    SEAM(11);
    if (IN(12)) { pg8::Gemm g{XN, (const bf16*)(ws + WS_WGU2), M, NGU, D}; pg8::StaticOrder S; S.init(M, NGU, G, bx);
        pg8::EpiSwiGLU E{HB, FF}; pg8::gemm_phase<pg8::EpiSwiGLU, pg8::StaticOrder, PG8_ALIGN, PG8_SP2>(lds + RING_OFF, g, S, E); }
    SEAM(12);
    if (IN(13)) { pg8::Gemm g{HB, (const bf16*)(ws + WS_WD2), M, D, FF}; pg8::StaticOrder S; S.init(M, D, G, bx);
        pg8::EpiResid E{out, out, D, MOD + 8 * 8 * D, SEQ / 256}; pg8::gemm_phase<pg8::EpiResid, pg8::StaticOrder, PG8_ALIGN, PG8_SP2>(lds + RING_OFF, g, S, E); }
    SEAM(13);
    if (IN(14)) final_rows(out, final_norm, gw, NGW, lane);
#undef IN
#undef SEAM
}

extern "C" void kernel_launch(void* const* d_in, const int* in_sizes, int n_in, void* d_out, int out_size, void* d_ws, size_t ws_size, hipStream_t stream) {
    static int grid = 0;
    if (grid == 0) {
        if (n_in != 26 || in_sizes[0] != M * D || out_size != M * D || ws_size < WS_END) { fprintf(stderr, "kernel_launch: unexpected shapes (n_in %d, in0 %d, out %d, ws %zu); nothing launched\n", n_in, n_in > 0 ? in_sizes[0] : -1, out_size, ws_size); grid = -1; return; }
        int dev = 0, cus = 0, per_cu = 0;
        if (hipGetDevice(&dev) != hipSuccess || hipDeviceGetAttribute(&cus, hipDeviceAttributeMultiprocessorCount, dev) != hipSuccess) { grid = -1; return; }
        if (hipFuncSetAttribute((const void*)mk_fwd, hipFuncAttributeMaxDynamicSharedMemorySize, LDS_BYTES) != hipSuccess) { fprintf(stderr, "kernel_launch: hipFuncSetAttribute failed\n"); grid = -1; return; }
        if (hipOccupancyMaxActiveBlocksPerMultiprocessor(&per_cu, (const void*)mk_fwd, NWAVES * 64, LDS_BYTES) != hipSuccess || per_cu < 1) { fprintf(stderr, "kernel_launch: occupancy query says %d blocks per CU\n", per_cu); per_cu = 1; }
        (void)hipGetLastError();
        grid = cus;
        if (grid > 256) grid = 256;
    }
    if (grid < 0) return;
    if (hipMemsetAsync((char*)d_ws + WS_CTL, 0, CTL_ZERO_BYTES, stream) != hipSuccess) return;
    Args a{};
    for (int i = 0; i < 26; ++i) a.in[i] = (const float*)d_in[i];
    a.out = (float*)d_out; a.ws = (unsigned char*)d_ws;
#if MK_PER_PHASE
    for (int p = 0; p < NPHASE; ++p) { a.ph_lo = p; a.ph_hi = p + 1; hipLaunchKernelGGL(mk_fwd, dim3(grid), dim3(NWAVES * 64), LDS_BYTES, stream, a); }
#else
    a.ph_lo = 0; a.ph_hi = NPHASE;
    void* kargs[] = {&a};
    hipError_t e = hipLaunchCooperativeKernel((const void*)mk_fwd, dim3(grid), dim3(NWAVES * 64), kargs, LDS_BYTES, stream);
    if (e != hipSuccess) fprintf(stderr, "kernel_launch: cooperative launch failed: %s (grid %d)\n", hipGetErrorString(e), grid);
#endif
}
```

```cpp
#include <hip/hip_runtime.h>
#include <cstdio>
#include <cstdint>
namespace pg8 {
#define PG8_LAS __attribute__((address_space(3)))
typedef unsigned short bf16_t;
typedef short bf16x8 __attribute__((ext_vector_type(8)));
typedef float f32x4 __attribute__((ext_vector_type(4)));
typedef unsigned u32x4 __attribute__((ext_vector_type(4)));
constexpr int BM = 256, BK = 64, HALF = 128, HTB = HALF * BK * 2  , STAGE_BYTES = 8 * HTB, NXCD = 8, WGM = 8;

__host__ __device__ __forceinline__ int lds_byte(int r, int c) { const int st = (r >> 4) * 2 + (c >> 5), rr = r & 15, cc = c & 31, ob = rr * 64 + cc * 2; return st * 1024 + (ob ^ (((ob >> 9) & 1) << 5)); }
__host__ __device__ __forceinline__ void stage_rc(int b, int& R, int& C) { const int st = b / 1024, sb = b % 1024, swz = sb ^ (((sb >> 9) & 1) << 5); R = (st >> 1) * 16 + swz / 64; C = (st & 1) * 32 + (swz % 64) / 2; }
__host__ __device__ __forceinline__ int perm32(int rho) { const int n = rho >> 4, i = rho & 15; return 8 * (i >> 2) + 4 * n + (i & 3); }

struct Unit { int pm, pn; };
struct Gemm { const bf16_t* A; const bf16_t* Bt; int M, N, K; };

struct StaticOrder {
    int nM, nN, nwg, G, c;
    __host__ __device__ void init(int M, int N, int G_, int c_) { nM = M / BM; nN = N / BM; nwg = nM * nN; G = G_; c = c_; }
    __host__ __device__ bool next(int i, Unit& u) const {
        const long L = (long)i * G + c; if (L >= nwg) return false;
        int wgid = (int)L; { const int q = nwg / NXCD, r = nwg % NXCD, xcd = wgid % NXCD, off = wgid / NXCD; wgid = (xcd < r ? xcd * (q + 1) : r * (q + 1) + (xcd - r) * q) + off; }
        const int nig = WGM * nN, gid = wgid / nig, fm = gid * WGM, gsz = (nM - fm) < WGM ? (nM - fm) : WGM;
        u.pm = fm + ((wgid % nig) % gsz); u.pn = (wgid % nig) / gsz; return true;
    }
    __device__ __forceinline__ void a_ready(const Unit&) const {}
    __device__ __forceinline__ void done(const Unit&) const {}
};

__device__ __forceinline__ unsigned cvt_pk_bf16(float lo, float hi) { unsigned r; asm volatile("v_cvt_pk_bf16_f32 %0, %1, %2" : "=v"(r) : "v"(lo), "v"(hi)); return r; }
typedef float f32x2 __attribute__((ext_vector_type(2)));
__device__ __forceinline__ f32x2 gelu_pk(f32x2 v) {
    const f32x2 av = __builtin_elementwise_abs(v), d = av * 0.2316418882f + 1.0f;
    f32x2 t; t.x = __builtin_amdgcn_rcpf(d.x); t.y = __builtin_amdgcn_rcpf(d.y);
    f32x2 q = t * 0.5307027145f + (-0.7265760135f); q = q * t + 0.7107068705f; q = q * t + (-0.142248368f); q = q * t + 0.127414796f; q = q * t;
    const f32x2 s = (v * v) * (-0.72134752044f);
    f32x2 e; e.x = __builtin_amdgcn_exp2f(s.x); e.y = __builtin_amdgcn_exp2f(s.y);
    const f32x2 m = v * (q * e), r = v - m;
    f32x2 o; o.x = v.x < 0.f ? m.x : r.x; o.y = v.y < 0.f ? m.y : r.y; return o;
}

template <int ACT  > struct EpiBf16 {
    static constexpr bool PERM = true, AFTER_DRAIN = false; static_assert(ACT == 0 || ACT == 1, "EpiBf16: ACT is 0 (none) or 1 (gelu_pk)");
    bf16_t* O; int ldc; const float* bias; int split_cols; size_t split_stride; float scale0;
    __device__ __forceinline__ void operator()(const f32x4 (&acc)[2][2][4][2], const Unit& u, int wr, int wc, int fr, int fq) const {
        const int row0 = u.pm * BM + wr * 64 + fr; int colt = u.pn * BM; bf16_t* base = O;
        float sc = 1.f; if (split_cols) { const int t = colt / split_cols; base += (size_t)t * split_stride; colt -= t * split_cols; if (t == 0) sc = scale0; }
        const int col0 = colt + wc * 32 + 8 * fq, bcol0 = u.pn * BM + wc * 32 + 8 * fq;
        f32x4 bv[2][2];
#pragma unroll
        for (int bj = 0; bj < 2; ++bj)
#pragma unroll
            for (int n = 0; n < 2; ++n) bv[bj][n] = bias ? *(const f32x4*)(bias + bcol0 + bj * HALF + 4 * n) : (f32x4){0.f, 0.f, 0.f, 0.f};
#pragma unroll
        for (int ai = 0; ai < 2; ++ai)
#pragma unroll
            for (int m = 0; m < 4; ++m) { bf16_t* rowp = base + (size_t)(row0 + ai * HALF + m * 16) * ldc + col0;
#pragma unroll
                for (int bj = 0; bj < 2; ++bj) { f32x4 v0 = acc[ai][bj][m][0] + bv[bj][0], v1 = acc[ai][bj][m][1] + bv[bj][1];
                    if (ACT == 1) { f32x2 a = gelu_pk((f32x2){v0[0], v0[1]}), b = gelu_pk((f32x2){v0[2], v0[3]}), c = gelu_pk((f32x2){v1[0], v1[1]}), d = gelu_pk((f32x2){v1[2], v1[3]});
                        v0 = (f32x4){a.x, a.y, b.x, b.y}; v1 = (f32x4){c.x, c.y, d.x, d.y}; }
                    v0 = v0 * sc; v1 = v1 * sc; u32x4 w; w.x = cvt_pk_bf16(v0[0], v0[1]); w.y = cvt_pk_bf16(v0[2], v0[3]); w.z = cvt_pk_bf16(v1[0], v1[1]); w.w = cvt_pk_bf16(v1[2], v1[3]);
                    *(u32x4*)(rowp + bj * HALF) = w; }
                asm volatile("s_waitcnt vmcnt(32)" ::: "memory");     }
    }
};
__device__ __forceinline__ float row_rstd(const float* SSQ, int row, int fq) {
    const f32x4 q = *(const f32x4*)(SSQ + (size_t)row * 16 + 4 * fq); float s = (q[0] + q[1]) + (q[2] + q[3]);
    s += __shfl_xor(s, 16); s += __shfl_xor(s, 32); return 1.0f / sqrtf(s * (1.0f / 1024.0f) + 1e-6f);
}
__device__ __forceinline__ unsigned pk4_fp8_(float a, float b, float c, float d) {
    a = __builtin_amdgcn_fmed3f(a, -448.f, 448.f); b = __builtin_amdgcn_fmed3f(b, -448.f, 448.f); c = __builtin_amdgcn_fmed3f(c, -448.f, 448.f); d = __builtin_amdgcn_fmed3f(d, -448.f, 448.f);
    int w = __builtin_amdgcn_cvt_pk_fp8_f32(a, b, 0, false); w = __builtin_amdgcn_cvt_pk_fp8_f32(c, d, w, true); return (unsigned)w; }
template <bool OUT8> struct EpiSwiGLU {
    static constexpr bool PERM = true, AFTER_DRAIN = false;
    unsigned char* wsb; unsigned oO, oSSQ, oBW; int ldc; float dsc; int nbw; int tiles_per_batch;
    __device__ __forceinline__ void operator()(const f32x4 (&acc)[2][2][4][2], const Unit& u, int wr, int wc, int fr, int fq) const {
        const int row0 = u.pm * BM + wr * 64 + fr, col0 = u.pn * HALF + wc * 32 + 8 * fq;
        bf16_t* const O = (bf16_t*)(wsb + oO); const float* const SSQ = oSSQ ? (const float*)(wsb + oSSQ) : nullptr; const float* const BW = (const float*)(wsb + oBW);
        const float* const bwq = BW + (size_t)(u.pm / tiles_per_batch) * nbw + u.pn * BM + wc * 32 + 8 * fq;
#pragma unroll
        for (int ai = 0; ai < 2; ++ai)
#pragma unroll
            for (int m = 0; m < 4; ++m) { bf16_t* rowp = O + (size_t)(row0 + ai * HALF + m * 16) * ldc + col0;
                const float rs = SSQ ? row_rstd(SSQ, row0 + ai * HALF + m * 16, fq) * dsc : dsc;
                float hv[8];
                if (!SSQ) {
#pragma unroll
                    for (int n = 0; n < 2; ++n) { const f32x4 G = acc[ai][0][m][n] * rs, GE = acc[ai][0][m][n] * (rs * -1.4426950408889634f); f32x4 R;
                        R[0] = __builtin_amdgcn_rcpf(1.0f + __builtin_amdgcn_exp2f(GE[0])); R[1] = __builtin_amdgcn_rcpf(1.0f + __builtin_amdgcn_exp2f(GE[1]));
                        R[2] = __builtin_amdgcn_rcpf(1.0f + __builtin_amdgcn_exp2f(GE[2])); R[3] = __builtin_amdgcn_rcpf(1.0f + __builtin_amdgcn_exp2f(GE[3]));
                        const f32x4 H = (G * R) * (acc[ai][1][m][n] * rs);
#pragma unroll
                        for (int j = 0; j < 4; ++j) hv[4 * n + j] = H[j]; }
                } else
#pragma unroll
                for (int n = 0; n < 2; ++n) { const f32x4 bg4 = SSQ ? *(const f32x4*)(bwq + 4 * n) : (f32x4){0.f, 0.f, 0.f, 0.f}, bu4 = SSQ ? *(const f32x4*)(bwq + HALF + 4 * n) : (f32x4){0.f, 0.f, 0.f, 0.f};
#pragma unroll
                    for (int j = 0; j < 4; ++j) {
                        const float g = acc[ai][0][m][n][j] * rs + bg4[j], up = acc[ai][1][m][n][j] * rs + bu4[j];
                        const float e = __builtin_amdgcn_exp2f(g * -1.4426950408889634f); hv[4 * n + j] = g * __builtin_amdgcn_rcpf(1.0f + e) * up; } }
                if (OUT8) { unsigned char* p8 = (unsigned char*)O + (size_t)(row0 + ai * HALF + m * 16) * ldc + col0;
                    typedef unsigned u32x2_ __attribute__((ext_vector_type(2)));
                    __builtin_nontemporal_store((u32x2_){pk4_fp8_(hv[0], hv[1], hv[2], hv[3]), pk4_fp8_(hv[4], hv[5], hv[6], hv[7])}, (u32x2_*)p8); }
                else { u32x4 w; w.x = cvt_pk_bf16(hv[0], hv[1]); w.y = cvt_pk_bf16(hv[2], hv[3]); w.z = cvt_pk_bf16(hv[4], hv[5]); w.w = cvt_pk_bf16(hv[6], hv[7]);
                    *(u32x4*)rowp = w; }
                asm volatile("s_waitcnt vmcnt(32)" ::: "memory");     }
    }
};
struct EpiResid {
    static constexpr bool PERM = false, AFTER_DRAIN = false;
    const float* base; float* out; int ldc; const float* gate; int tiles_per_batch; float dsc;
    __device__ __forceinline__ void operator()(const f32x4 (&acc)[2][2][4][2], const Unit& u, int wr, int wc, int fr, int fq) const {
        const int row0 = u.pm * BM + wr * 64 + fr, col0 = u.pn * BM + wc * 32 + 4 * fq;
        const float* gp = gate + (size_t)(u.pm / tiles_per_batch) * ldc + col0;
        f32x4 gv[2][2];
#pragma unroll
        for (int bj = 0; bj < 2; ++bj)
#pragma unroll
            for (int n = 0; n < 2; ++n) gv[bj][n] = *(const f32x4*)(gp + bj * HALF + n * 16);
#pragma unroll
        for (int ai = 0; ai < 2; ++ai)
#pragma unroll
            for (int m = 0; m < 4; ++m) { const size_t off = (size_t)(row0 + ai * HALF + m * 16) * ldc + col0;
#pragma unroll
                for (int bj = 0; bj < 2; ++bj)
#pragma unroll
                    for (int n = 0; n < 2; ++n) { const f32x4 bs = *(const f32x4*)(base + off + bj * HALF + n * 16);
                        *(f32x4*)(out + off + bj * HALF + n * 16) = bs + gv[bj][n] * (acc[ai][bj][m][n] * dsc); }
                asm volatile("s_waitcnt vmcnt(32)" ::: "memory");     }
    }
};

struct EpiResidB {
    static constexpr bool PERM = true, AFTER_DRAIN = false;
    const bf16_t* base; bf16_t* out; const float* gate; int ldc; int tiles_per_batch; float dsc; int pad_;
    __device__ __forceinline__ void operator()(const f32x4 (&acc)[2][2][4][2], const Unit& u, int wr, int wc, int fr, int fq) const {
        const int row0 = u.pm * BM + wr * 64 + fr, col0 = u.pn * BM + wc * 32 + 8 * fq; const size_t bo = (size_t)(u.pm / tiles_per_batch) * ldc + col0;
        f32x4 gv[2][2];
#pragma unroll
        for (int bj = 0; bj < 2; ++bj)
#pragma unroll
            for (int n = 0; n < 2; ++n) gv[bj][n] = *(const f32x4*)(gate + bo + bj * HALF + 4 * n) * dsc;
        u32x4 nb[2];
#pragma unroll
        for (int bj = 0; bj < 2; ++bj) nb[bj] = *(const u32x4*)(base + (size_t)row0 * ldc + col0 + bj * HALF);
#pragma unroll
        for (int g = 0; g < 8; ++g) { const int ai = g >> 2, m = g & 3; const size_t off = (size_t)(row0 + ai * HALF + m * 16) * ldc + col0;
            u32x4 cb[2]; cb[0] = nb[0]; cb[1] = nb[1];
            if (g < 7) { const int ai2 = (g + 1) >> 2, m2 = (g + 1) & 3; const size_t off2 = (size_t)(row0 + ai2 * HALF + m2 * 16) * ldc + col0;
#pragma unroll
                for (int bj = 0; bj < 2; ++bj) nb[bj] = *(const u32x4*)(base + off2 + bj * HALF); }
#pragma unroll
            for (int bj = 0; bj < 2; ++bj) { const u32x4 b = cb[bj];
                const f32x4 x0 = (f32x4){__builtin_bit_cast(float, b.x << 16), __builtin_bit_cast(float, b.x & 0xffff0000u), __builtin_bit_cast(float, b.y << 16), __builtin_bit_cast(float, b.y & 0xffff0000u)} + gv[bj][0] * acc[ai][bj][m][0];
                const f32x4 x1 = (f32x4){__builtin_bit_cast(float, b.z << 16), __builtin_bit_cast(float, b.z & 0xffff0000u), __builtin_bit_cast(float, b.w << 16), __builtin_bit_cast(float, b.w & 0xffff0000u)} + gv[bj][1] * acc[ai][bj][m][1];
                u32x4 w; w.x = cvt_pk_bf16(x0[0], x0[1]); w.y = cvt_pk_bf16(x0[2], x0[3]); w.z = cvt_pk_bf16(x1[0], x1[1]); w.w = cvt_pk_bf16(x1[2], x1[3]);
                *(u32x4*)(out + off + bj * HALF) = w; }
            asm volatile("s_waitcnt vmcnt(32)" ::: "memory");     }
    }
};

template <bool Y8> struct EpiResidY {
    static constexpr bool PERM = true, AFTER_DRAIN = false;
    const float* base; bf16_t* out; const float* gate; const float* Amod; void* Y; float* SSQ; int ldc; int tiles_per_batch; float dsc; int pad_;
    __device__ __forceinline__ void operator()(const f32x4 (&acc)[2][2][4][2], const Unit& u, int wr, int wc, int fr, int fq) const {
        const int row0 = u.pm * BM + wr * 64 + fr, col0 = u.pn * BM + wc * 32 + 8 * fq; const size_t bo = (size_t)(u.pm / tiles_per_batch) * ldc + col0;
        f32x4 gv[2][2], av[2][2];
#pragma unroll
        for (int bj = 0; bj < 2; ++bj)
#pragma unroll
            for (int n = 0; n < 2; ++n) { gv[bj][n] = *(const f32x4*)(gate + bo + bj * HALF + 4 * n) * dsc; av[bj][n] = *(const f32x4*)(Amod + bo + bj * HALF + 4 * n); }
        f32x4 nx[2];
#pragma unroll
        for (int n = 0; n < 2; ++n) nx[n] = *(const f32x4*)(base + (size_t)row0 * ldc + col0 + 4 * n);
#pragma unroll
        for (int ai = 0; ai < 2; ++ai)
#pragma unroll
            for (int m = 0; m < 4; ++m) { const int row = row0 + ai * HALF + m * 16; const size_t off = (size_t)row * ldc + col0; float ss = 0.f;
#pragma unroll
                for (int bj = 0; bj < 2; ++bj) { f32x4 xn[2], xr[2], cx[2]; cx[0] = nx[0]; cx[1] = nx[1];
                    { const int st2 = (ai * 4 + m) * 2 + bj + 1;
                      if (st2 < 16) { const int g2 = st2 >> 1, bj2 = st2 & 1; const size_t off2 = (size_t)(row0 + (g2 >> 2) * HALF + (g2 & 3) * 16) * ldc + col0 + bj2 * HALF;
#pragma unroll
                          for (int n = 0; n < 2; ++n) nx[n] = *(const f32x4*)(base + off2 + 4 * n); } }
#pragma unroll
                    for (int n = 0; n < 2; ++n) { xn[n] = cx[n] + gv[bj][n] * acc[ai][bj][m][n];
                        ss += (xn[n][0] * xn[n][0] + xn[n][1] * xn[n][1]) + (xn[n][2] * xn[n][2] + xn[n][3] * xn[n][3]); xr[n] = xn[n]; xn[n] = xn[n] * av[bj][n]; }
                    { u32x4 w; w.x = cvt_pk_bf16(xr[0][0], xr[0][1]); w.y = cvt_pk_bf16(xr[0][2], xr[0][3]); w.z = cvt_pk_bf16(xr[1][0], xr[1][1]); w.w = cvt_pk_bf16(xr[1][2], xr[1][3]); *(u32x4*)(out + off + bj * HALF) = w; }
                    if (Y8) { typedef unsigned u32x2_ __attribute__((ext_vector_type(2)));
                        *(u32x2_*)((unsigned char*)Y + off + bj * HALF) = (u32x2_){pk4_fp8_(xn[0][0], xn[0][1], xn[0][2], xn[0][3]), pk4_fp8_(xn[1][0], xn[1][1], xn[1][2], xn[1][3])}; }
                    else { u32x4 w; w.x = cvt_pk_bf16(xn[0][0], xn[0][1]); w.y = cvt_pk_bf16(xn[0][2], xn[0][3]); w.z = cvt_pk_bf16(xn[1][0], xn[1][1]); w.w = cvt_pk_bf16(xn[1][2], xn[1][3]);
                        *(u32x4*)((bf16_t*)Y + off + bj * HALF) = w; } }
                ss += __shfl_xor(ss, 16); ss += __shfl_xor(ss, 32);
                if (fq == 0) SSQ[(size_t)row * 16 + 4 * u.pn + wc] = ss;
                asm volatile("s_waitcnt vmcnt(32)" ::: "memory");     }
    }
};
struct EpiBf16N {
    static constexpr bool PERM = true, AFTER_DRAIN = false;
    bf16_t* O; const float* BW; const float* SSQ; size_t split_stride; int ldc; int nbw; int split_cols; int tiles_per_batch; float scale0; int pad_;
    __device__ __forceinline__ void operator()(const f32x4 (&acc)[2][2][4][2], const Unit& u, int wr, int wc, int fr, int fq) const {
        const int row0 = u.pm * BM + wr * 64 + fr; int colt = u.pn * BM; bf16_t* obase = O;
        float sc = 1.f; { const int t = colt / split_cols; obase += (size_t)t * split_stride; colt -= t * split_cols; if (t == 0) sc = scale0; }
        const int col0 = colt + wc * 32 + 8 * fq, bcol0 = u.pn * BM + wc * 32 + 8 * fq; const float* bwp = BW + (size_t)(u.pm / tiles_per_batch) * nbw + bcol0;
        f32x4 bv[2][2];
#pragma unroll
        for (int bj = 0; bj < 2; ++bj)
#pragma unroll
            for (int n = 0; n < 2; ++n) bv[bj][n] = *(const f32x4*)(bwp + bj * HALF + 4 * n);
        f32x4 nq = *(const f32x4*)(SSQ + (size_t)row0 * 16 + 4 * fq);
#pragma unroll
        for (int ai = 0; ai < 2; ++ai)
#pragma unroll
            for (int m = 0; m < 4; ++m) { const int row = row0 + ai * HALF + m * 16; const f32x4 q = nq;
                if (ai * 4 + m < 7) { const int g2 = ai * 4 + m + 1; nq = *(const f32x4*)(SSQ + (size_t)(row0 + (g2 >> 2) * HALF + (g2 & 3) * 16) * 16 + 4 * fq); }
                float s_ = (q[0] + q[1]) + (q[2] + q[3]); s_ += __shfl_xor(s_, 16); s_ += __shfl_xor(s_, 32); const float rs = 1.0f / sqrtf(s_ * (1.0f / 1024.0f) + 1e-6f);
                bf16_t* rowp = obase + (size_t)row * ldc + col0;
#pragma unroll
                for (int bj = 0; bj < 2; ++bj) { const f32x4 v0 = (acc[ai][bj][m][0] * rs + bv[bj][0]) * sc, v1 = (acc[ai][bj][m][1] * rs + bv[bj][1]) * sc;
                    u32x4 w; w.x = cvt_pk_bf16(v0[0], v0[1]); w.y = cvt_pk_bf16(v0[2], v0[3]); w.z = cvt_pk_bf16(v1[0], v1[1]); w.w = cvt_pk_bf16(v1[2], v1[3]);
                    *(u32x4*)(rowp + bj * HALF) = w; }
                asm volatile("s_waitcnt vmcnt(32)" ::: "memory");     }
    }
};
template <class Epi, class Sched, bool ALIGN_EPI = false, bool SP2 = false>
__device__ __forceinline__ void gemm_phase(PG8_LAS unsigned char* lds, const Gemm g, const Sched S, const Epi E) {
    const int tid = threadIdx.x, wid = __builtin_amdgcn_readfirstlane(tid >> 6), lane = tid & 63, wr = wid >> 2, wc = wid & 3, fr = lane & 15, fq = lane >> 4;
    const int K = g.K, nt = K / BK;
    unsigned voffA[2], voffB[2];
#pragma unroll
    for (int i = 0; i < 2; ++i) { int R, C; stage_rc(tid * 16 + i * 8192, R, C); const int Rb = Epi::PERM ? ((R & ~31) + perm32(R & 31)) : R;
        voffA[i] = (unsigned)(R * K + C) * 2u; voffB[i] = (unsigned)(Rb * K + C) * 2u; }
    const size_t kstep = (size_t)(BK * 2);
    const size_t hstep = (size_t)HALF * K * 2;
    const size_t tstep = 2 * hstep;
    const unsigned ldsw = (unsigned)wid * 1024u;
    const int aoff = lds_byte(wr * 64 + fr, fq * 8), boff = lds_byte(wc * 32 + fr, fq * 8);
#define PG8_SA(b, h) (((b) * 2 + (h)) * HTB)
#define PG8_SB(b, h) ((4 + (b) * 2 + (h)) * HTB)
#define PG8_STAGE(bufoff, gbase, voff) do { _Pragma("unroll") for (int _i = 0; _i < 2; ++_i) \
        __builtin_amdgcn_global_load_lds((const unsigned*)((const char*)(gbase) + (voff)[_i]), (PG8_LAS unsigned*)(lds + (bufoff) + ldsw + _i * 8192), 16, 0, 0); } while (0)
#define PG8_LDA(dst, b, h) do { _Pragma("unroll") for (int m = 0; m < 4; ++m) _Pragma("unroll") for (int k = 0; k < 2; ++k) dst[m][k] = *(const PG8_LAS bf16x8*)(lds + PG8_SA(b, h) + aoff + m * 2048 + k * 1024); } while (0)
#define PG8_LDB(dst, b, h) do { _Pragma("unroll") for (int n = 0; n < 2; ++n) _Pragma("unroll") for (int k = 0; k < 2; ++k) dst[n][k] = *(const PG8_LAS bf16x8*)(lds + PG8_SB(b, h) + boff + n * 2048 + k * 1024); } while (0)
#define PG8_MMA(ai, bj, At, Bt) do { __builtin_amdgcn_s_setprio(1); _Pragma("unroll") for (int m = 0; m < 4; ++m) _Pragma("unroll") for (int n = 0; n < 2; ++n) _Pragma("unroll") for (int k = 0; k < 2; ++k) \
        acc[ai][bj][m][n] = __builtin_amdgcn_mfma_f32_16x16x32_bf16(Bt[n][k], At[m][k], acc[ai][bj][m][n], 0, 0, 0); __builtin_amdgcn_s_setprio(0); } while (0)
#define PG8_WAIT_V(n) asm volatile("s_waitcnt vmcnt(" #n ")" ::: "memory")
#define PG8_WAIT_L(n) asm volatile("s_waitcnt lgkmcnt(" #n ")" ::: "memory")
#define PG8_BAR __builtin_amdgcn_s_barrier()
#define PG8_SCHED __builtin_amdgcn_sched_barrier(0)
    Unit cur, nxt; int ui = 0;
    if (!S.next(0, cur)) return;
    f32x4 acc[2][2][4][2];
#pragma unroll
    for (int a = 0; a < 2; ++a)
#pragma unroll
        for (int b = 0; b < 2; ++b)
#pragma unroll
            for (int m = 0; m < 4; ++m)
#pragma unroll
                for (int n = 0; n < 2; ++n) acc[a][b][m][n] = (f32x4){0.f, 0.f, 0.f, 0.f};
    bf16x8 At[4][2], B0[2][2], B1[2][2];
    const char* cA = (const char*)g.A + (size_t)cur.pm * tstep; const char* cB = (const char*)g.Bt + (size_t)cur.pn * tstep;
    S.a_ready(cur);
    if constexpr (SP2) {
        PG8_STAGE(PG8_SB(0, 0), cB, voffB); PG8_STAGE(PG8_SB(0, 1), cB + hstep, voffB); PG8_STAGE(PG8_SA(0, 0), cA, voffA); PG8_STAGE(PG8_SA(0, 1), cA + hstep, voffA);
        if (wr == 1) PG8_BAR;
        PG8_WAIT_V(2); PG8_BAR;
        PG8_STAGE(PG8_SB(1, 0), cB + kstep, voffB); PG8_STAGE(PG8_SA(1, 0), cA + kstep, voffA); PG8_STAGE(PG8_SB(1, 1), cB + hstep + kstep, voffB);
        PG8_WAIT_V(6); PG8_BAR;
    } else {
        PG8_STAGE(PG8_SB(0, 0), cB, voffB); PG8_STAGE(PG8_SA(0, 0), cA, voffA); PG8_STAGE(PG8_SB(0, 1), cB + hstep, voffB); PG8_STAGE(PG8_SA(0, 1), cA + hstep, voffA);
        if (wr == 1) PG8_BAR;
        PG8_WAIT_V(4); PG8_BAR;
        PG8_STAGE(PG8_SB(1, 0), cB + kstep, voffB); PG8_STAGE(PG8_SA(1, 0), cA + kstep, voffA); PG8_STAGE(PG8_SB(1, 1), cB + hstep + kstep, voffB);
        PG8_WAIT_V(6); PG8_BAR;
    }
    for (;;) {
        const bool has_next = S.next(ui + 1, nxt);
        const char* nA = has_next ? (const char*)g.A + (size_t)nxt.pm * tstep : cA; const char* nB = has_next ? (const char*)g.Bt + (size_t)nxt.pn * tstep : cB;
        for (int t = 0; t < nt; t += 2) {
            const bool last = (t == nt - 2);
            const char* a1 = cA + (size_t)(t + 1) * kstep;
            const char* a2 = last ? nA : cA + (size_t)(t + 2) * kstep; const char* b2 = last ? nB : cB + (size_t)(t + 2) * kstep;
            const char* a3 = a2 + kstep; const char* b3 = b2 + kstep;
            if (last && has_next) S.a_ready(nxt);
            if constexpr (SP2) {
            PG8_LDB(B0, 0, 0); PG8_LDB(B1, 0, 1); PG8_SCHED; PG8_LDA(At, 0, 0); PG8_STAGE(PG8_SA(1, 1), a1 + hstep, voffA);
            PG8_WAIT_V(8); PG8_WAIT_L(0); PG8_BAR; PG8_MMA(0, 0, At, B0); PG8_MMA(0, 1, At, B1); PG8_BAR; PG8_SCHED;
            PG8_LDA(At, 0, 1); PG8_STAGE(PG8_SB(0, 0), b2, voffB); PG8_STAGE(PG8_SB(0, 1), b2 + hstep, voffB); PG8_STAGE(PG8_SA(0, 0), a2, voffA);
            PG8_WAIT_V(8); PG8_WAIT_L(0); PG8_BAR; PG8_MMA(1, 0, At, B0); PG8_MMA(1, 1, At, B1); PG8_BAR; PG8_SCHED;
            PG8_LDB(B0, 1, 0); PG8_LDB(B1, 1, 1); PG8_SCHED; PG8_LDA(At, 1, 0); PG8_STAGE(PG8_SA(0, 1), a2 + hstep, voffA);
            PG8_WAIT_V(8); PG8_WAIT_L(0); PG8_BAR; PG8_MMA(0, 0, At, B0); PG8_MMA(0, 1, At, B1); PG8_BAR; PG8_SCHED;
            PG8_LDA(At, 1, 1); PG8_STAGE(PG8_SB(1, 0), b3, voffB); PG8_STAGE(PG8_SB(1, 1), b3 + hstep, voffB); PG8_STAGE(PG8_SA(1, 0), a3, voffA);
            PG8_WAIT_V(8); PG8_WAIT_L(0); PG8_BAR; PG8_MMA(1, 0, At, B0); PG8_MMA(1, 1, At, B1); PG8_BAR; PG8_SCHED;
            } else {
            PG8_LDB(B0, 0, 0); PG8_SCHED; PG8_LDA(At, 0, 0); PG8_STAGE(PG8_SA(1, 1), a1 + hstep, voffA);
            PG8_WAIT_L(8); PG8_BAR; PG8_WAIT_L(0); PG8_MMA(0, 0, At, B0); PG8_BAR; PG8_SCHED;
            PG8_LDB(B1, 0, 1); PG8_STAGE(PG8_SB(0, 0), b2, voffB);
            PG8_BAR; PG8_WAIT_L(0); PG8_MMA(0, 1, At, B1); PG8_BAR;
            PG8_LDA(At, 0, 1); PG8_STAGE(PG8_SA(0, 0), a2, voffA);
            PG8_BAR; PG8_WAIT_L(0); PG8_MMA(1, 0, At, B0); PG8_BAR; PG8_SCHED;
            PG8_STAGE(PG8_SB(0, 1), b2 + hstep, voffB);
            PG8_WAIT_V(6); PG8_BAR; PG8_MMA(1, 1, At, B1); PG8_BAR;
            PG8_LDB(B0, 1, 0); PG8_SCHED; PG8_LDA(At, 1, 0); PG8_STAGE(PG8_SA(0, 1), a2 + hstep, voffA);
            PG8_WAIT_L(8); PG8_BAR; PG8_WAIT_L(0); PG8_MMA(0, 0, At, B0); PG8_BAR; PG8_SCHED;
            PG8_LDB(B1, 1, 1); PG8_STAGE(PG8_SB(1, 0), b3, voffB);
            PG8_BAR; PG8_WAIT_L(0); PG8_MMA(0, 1, At, B1); PG8_BAR;
            PG8_LDA(At, 1, 1); PG8_STAGE(PG8_SA(1, 0), a3, voffA);
            PG8_BAR; PG8_WAIT_L(0); PG8_MMA(1, 0, At, B0); PG8_BAR; PG8_SCHED;
            PG8_STAGE(PG8_SB(1, 1), b3 + hstep, voffB);
            PG8_WAIT_V(6); PG8_BAR; PG8_MMA(1, 1, At, B1); PG8_BAR;
            }
        }
        if constexpr (ALIGN_EPI) { if (wr == 0) PG8_BAR; }
        if constexpr (!Epi::AFTER_DRAIN) { E(acc, cur, wr, wc, fr, fq); S.done(cur); }
        if (!has_next) break;
#pragma unroll
        for (int a = 0; a < 2; ++a)
#pragma unroll
            for (int b = 0; b < 2; ++b)
#pragma unroll
                for (int m = 0; m < 4; ++m)
#pragma unroll
                    for (int n = 0; n < 2; ++n) acc[a][b][m][n] = (f32x4){0.f, 0.f, 0.f, 0.f};
        cur = nxt; cA = nA; cB = nB; ++ui;
        if constexpr (ALIGN_EPI) { if (wr == 1) PG8_BAR; }
    }
    PG8_WAIT_V(0);
    if constexpr (!ALIGN_EPI) { if (wr == 0) PG8_BAR; }
    PG8_BAR;
    if constexpr (Epi::AFTER_DRAIN) { E.fused(acc, cur, wr, wc, fr, fq, lds, wid, lane); S.done(cur); }
#undef PG8_SA
#undef PG8_SB
#undef PG8_STAGE
#undef PG8_LDA
#undef PG8_LDB
#undef PG8_MMA
#undef PG8_WAIT_V
#undef PG8_WAIT_L
#undef PG8_BAR
#undef PG8_SCHED
}
typedef int i32x4 __attribute__((ext_vector_type(4)));
typedef int i32x8 __attribute__((ext_vector_type(8)));
template <class Epi, class Sched, bool ALIGN_EPI = false, bool SP2 = false>
__device__ __forceinline__ void gemm_phase8(PG8_LAS unsigned char* lds, const Gemm g, const Sched S, const Epi E) {
    const int tid = threadIdx.x, wid = __builtin_amdgcn_readfirstlane(tid >> 6), lane = tid & 63, wr = wid >> 2, wc = wid & 3, fr = lane & 15, fq = lane >> 4;
    const int K = g.K, nt = K / 128;
    unsigned voffA[2], voffB[2];
#pragma unroll
    for (int i = 0; i < 2; ++i) { int R, C; stage_rc(tid * 16 + i * 8192, R, C); const int Rb = Epi::PERM ? ((R & ~31) + perm32(R & 31)) : R;
        voffA[i] = (unsigned)(R * K + 2 * C); voffB[i] = (unsigned)(Rb * K + 2 * C); }
    const size_t kstep = (size_t)128;
    const size_t hstep = (size_t)HALF * K;
    const size_t tstep = 2 * hstep;
    const unsigned ldsw = (unsigned)wid * 1024u;
    const int aoff0_ = lds_byte(wr * 64 + fr, 16 * (fq & 1)) + (fq >> 1) * 1024, boff0_ = lds_byte(wc * 32 + fr, 16 * (fq & 1)) + (fq >> 1) * 1024;
    const int aoff = aoff0_ + 16 * (fq & 1), boff = boff0_ + 16 * (fq & 1);
#define PG8_SA(b, h) (((b) * 2 + (h)) * HTB)
#define PG8_SB(b, h) ((4 + (b) * 2 + (h)) * HTB)
#define PG8_STAGE(bufoff, gbase, voff) do { _Pragma("unroll") for (int _i = 0; _i < 2; ++_i) { unsigned vo_ = (voff)[_i]; asm volatile("" : "+v"(vo_)); \
        __builtin_amdgcn_global_load_lds((const unsigned*)((const char*)(gbase) + vo_), (PG8_LAS unsigned*)(lds + (bufoff) + ldsw + _i * 8192), 16, 0, 0); } } while (0)
#define PG8_LDA(dst, b, h) do { int a2_ = aoff ^ 16; asm volatile("" : "+v"(a2_)); _Pragma("unroll") for (int m = 0; m < 4; ++m) { const i32x4 lo_ = *(const PG8_LAS i32x4*)(lds + PG8_SA(b, h) + aoff + m * 2048), hi_ = *(const PG8_LAS i32x4*)(lds + PG8_SA(b, h) + a2_ + m * 2048); dst[m] = (i32x8){lo_[0], lo_[1], lo_[2], lo_[3], hi_[0], hi_[1], hi_[2], hi_[3]}; } } while (0)
#define PG8_LDB(dst, b, h) do { int b2_ = boff ^ 16; asm volatile("" : "+v"(b2_)); _Pragma("unroll") for (int n = 0; n < 2; ++n) { const i32x4 lo_ = *(const PG8_LAS i32x4*)(lds + PG8_SB(b, h) + boff + n * 2048), hi_ = *(const PG8_LAS i32x4*)(lds + PG8_SB(b, h) + b2_ + n * 2048); dst[n] = (i32x8){lo_[0], lo_[1], lo_[2], lo_[3], hi_[0], hi_[1], hi_[2], hi_[3]}; } } while (0)
#define PG8_MMA(ai, bj, At, Bt) do { __builtin_amdgcn_s_setprio(1); _Pragma("unroll") for (int m = 0; m < 4; ++m) _Pragma("unroll") for (int n = 0; n < 2; ++n) \
        asm volatile("v_mfma_scale_f32_16x16x128_f8f6f4 %0, %1, %2, %0, %3, %3 op_sel_hi:[0,0,0]" : "+v"(acc[ai][bj][m][n]) : "v"(Bt[n]), "v"(At[m]), "v"(sc8)); __builtin_amdgcn_s_setprio(0); } while (0)
#define PG8_WAIT_V(n) asm volatile("s_waitcnt vmcnt(" #n ")" ::: "memory")
#define PG8_WAIT_L(n) asm volatile("s_waitcnt lgkmcnt(" #n ")" ::: "memory")
#define PG8_BAR __builtin_amdgcn_s_barrier()
#define PG8_SCHED __builtin_amdgcn_sched_barrier(0)
    Unit cur, nxt; int ui = 0;
    if (!S.next(0, cur)) return;
    f32x4 acc[2][2][4][2];
#pragma unroll
    for (int a = 0; a < 2; ++a)
#pragma unroll
        for (int b = 0; b < 2; ++b)
#pragma unroll
            for (int m = 0; m < 4; ++m)
#pragma unroll
                for (int n = 0; n < 2; ++n) acc[a][b][m][n] = (f32x4){0.f, 0.f, 0.f, 0.f};
    i32x8 At[4], B0[2], B1[2]; int sc8 = 0x7f7f7f7f; asm volatile("" : "+v"(sc8));
    const char* cA = (const char*)g.A + (size_t)cur.pm * tstep; const char* cB = (const char*)g.Bt + (size_t)cur.pn * tstep;
    S.a_ready(cur);
    if constexpr (SP2) {
        PG8_STAGE(PG8_SB(0, 0), cB, voffB); PG8_STAGE(PG8_SB(0, 1), cB + hstep, voffB); PG8_STAGE(PG8_SA(0, 0), cA, voffA); PG8_STAGE(PG8_SA(0, 1), cA + hstep, voffA);
        if (wr == 1) PG8_BAR;
        PG8_WAIT_V(2); PG8_BAR;
        PG8_STAGE(PG8_SB(1, 0), cB + kstep, voffB); PG8_STAGE(PG8_SA(1, 0), cA + kstep, voffA); PG8_STAGE(PG8_SB(1, 1), cB + hstep + kstep, voffB);
        PG8_WAIT_V(6); PG8_BAR;
    } else {
        PG8_STAGE(PG8_SB(0, 0), cB, voffB); PG8_STAGE(PG8_SA(0, 0), cA, voffA); PG8_STAGE(PG8_SB(0, 1), cB + hstep, voffB); PG8_STAGE(PG8_SA(0, 1), cA + hstep, voffA);
        if (wr == 1) PG8_BAR;
        PG8_WAIT_V(4); PG8_BAR;
        PG8_STAGE(PG8_SB(1, 0), cB + kstep, voffB); PG8_STAGE(PG8_SA(1, 0), cA + kstep, voffA); PG8_STAGE(PG8_SB(1, 1), cB + hstep + kstep, voffB);
        PG8_WAIT_V(6); PG8_BAR;
    }
    for (;;) {
        const bool has_next = S.next(ui + 1, nxt);
        const char* nA = has_next ? (const char*)g.A + (size_t)nxt.pm * tstep : cA; const char* nB = has_next ? (const char*)g.Bt + (size_t)nxt.pn * tstep : cB;
#pragma nounroll
        for (int t = 0; t < nt; t += 2) {
            const bool last = (t == nt - 2);
            const char* a1 = cA + (size_t)(t + 1) * kstep;
            const char* a2 = last ? nA : cA + (size_t)(t + 2) * kstep; const char* b2 = last ? nB : cB + (size_t)(t + 2) * kstep;
            const char* a3 = a2 + kstep; const char* b3 = b2 + kstep;
            if (last && has_next) S.a_ready(nxt);
            if constexpr (SP2) {
            PG8_LDB(B0, 0, 0); PG8_LDB(B1, 0, 1); PG8_SCHED; PG8_LDA(At, 0, 0); PG8_STAGE(PG8_SA(1, 1), a1 + hstep, voffA);
            PG8_WAIT_V(8); PG8_WAIT_L(0); PG8_BAR; PG8_MMA(0, 0, At, B0); PG8_MMA(0, 1, At, B1); PG8_BAR; PG8_SCHED;
            PG8_LDA(At, 0, 1); PG8_STAGE(PG8_SB(0, 0), b2, voffB); PG8_STAGE(PG8_SB(0, 1), b2 + hstep, voffB); PG8_STAGE(PG8_SA(0, 0), a2, voffA);
            PG8_WAIT_V(8); PG8_WAIT_L(0); PG8_BAR; PG8_MMA(1, 0, At, B0); PG8_MMA(1, 1, At, B1); PG8_BAR; PG8_SCHED;
            PG8_LDB(B0, 1, 0); PG8_LDB(B1, 1, 1); PG8_SCHED; PG8_LDA(At, 1, 0); PG8_STAGE(PG8_SA(0, 1), a2 + hstep, voffA);
            PG8_WAIT_V(8); PG8_WAIT_L(0); PG8_BAR; PG8_MMA(0, 0, At, B0); PG8_MMA(0, 1, At, B1); PG8_BAR; PG8_SCHED;
            PG8_LDA(At, 1, 1); PG8_STAGE(PG8_SB(1, 0), b3, voffB); PG8_STAGE(PG8_SB(1, 1), b3 + hstep, voffB); PG8_STAGE(PG8_SA(1, 0), a3, voffA);
            PG8_WAIT_V(8); PG8_WAIT_L(0); PG8_BAR; PG8_MMA(1, 0, At, B0); PG8_MMA(1, 1, At, B1); PG8_BAR; PG8_SCHED;
            } else {
            PG8_LDB(B0, 0, 0); PG8_SCHED; PG8_LDA(At, 0, 0); PG8_STAGE(PG8_SA(1, 1), a1 + hstep, voffA);
            PG8_WAIT_L(8); PG8_BAR; PG8_WAIT_L(0); PG8_MMA(0, 0, At, B0); PG8_BAR; PG8_SCHED;
            PG8_LDB(B1, 0, 1); PG8_STAGE(PG8_SB(0, 0), b2, voffB);
            PG8_BAR; PG8_WAIT_L(0); PG8_MMA(0, 1, At, B1); PG8_BAR;
            PG8_LDA(At, 0, 1); PG8_STAGE(PG8_SA(0, 0), a2, voffA);
            PG8_BAR; PG8_WAIT_L(0); PG8_MMA(1, 0, At, B0); PG8_BAR; PG8_SCHED;
            PG8_STAGE(PG8_SB(0, 1), b2 + hstep, voffB);
            PG8_WAIT_V(6); PG8_BAR; PG8_MMA(1, 1, At, B1); PG8_BAR;
            PG8_LDB(B0, 1, 0); PG8_SCHED; PG8_LDA(At, 1, 0); PG8_STAGE(PG8_SA(0, 1), a2 + hstep, voffA);
            PG8_WAIT_L(8); PG8_BAR; PG8_WAIT_L(0); PG8_MMA(0, 0, At, B0); PG8_BAR; PG8_SCHED;
            PG8_LDB(B1, 1, 1); PG8_STAGE(PG8_SB(1, 0), b3, voffB);
            PG8_BAR; PG8_WAIT_L(0); PG8_MMA(0, 1, At, B1); PG8_BAR;
            PG8_LDA(At, 1, 1); PG8_STAGE(PG8_SA(1, 0), a3, voffA);
            PG8_BAR; PG8_WAIT_L(0); PG8_MMA(1, 0, At, B0); PG8_BAR; PG8_SCHED;
            PG8_STAGE(PG8_SB(1, 1), b3 + hstep, voffB);
            PG8_WAIT_V(6); PG8_BAR; PG8_MMA(1, 1, At, B1); PG8_BAR;
            }
        }
        if constexpr (ALIGN_EPI) { if (wr == 0) PG8_BAR; }
        asm volatile("s_nop 15\n\ts_nop 15" ::: "memory");
        if constexpr (!Epi::AFTER_DRAIN) { E(acc, cur, wr, wc, fr, fq); S.done(cur); }
        if (!has_next) break;
#pragma unroll
        for (int a = 0; a < 2; ++a)
#pragma unroll
            for (int b = 0; b < 2; ++b)
#pragma unroll
                for (int m = 0; m < 4; ++m)
#pragma unroll
                    for (int n = 0; n < 2; ++n) acc[a][b][m][n] = (f32x4){0.f, 0.f, 0.f, 0.f};
        cur = nxt; cA = nA; cB = nB; ++ui;
        if constexpr (ALIGN_EPI) { if (wr == 1) PG8_BAR; }
    }
    PG8_WAIT_V(0);
    if constexpr (!ALIGN_EPI) { if (wr == 0) PG8_BAR; }
    PG8_BAR;
    if constexpr (Epi::AFTER_DRAIN) { E.fused(acc, cur, wr, wc, fr, fq, lds, wid, lane); S.done(cur); }
#undef PG8_SA
#undef PG8_SB
#undef PG8_STAGE
#undef PG8_LDA
#undef PG8_LDB
#undef PG8_MMA
#undef PG8_WAIT_V
#undef PG8_WAIT_L
#undef PG8_BAR
#undef PG8_SCHED
}
}

#ifndef PG8_SP2
#define PG8_SP2 true
#endif
#ifndef PG8_ALIGN
#define PG8_ALIGN true
#endif
#include <hip/hip_bf16.h>
#include <cmath>
namespace attn_body {
using bf16=__hip_bfloat16;
using bf16x8=__attribute__((ext_vector_type(8)))short;
using s16x4=__attribute__((ext_vector_type(4)))short;
using f32x16=__attribute__((ext_vector_type(16)))float;
using u32x4=__attribute__((ext_vector_type(4)))unsigned;
constexpr int BATCH=8,NHEAD=8,SEQ=4096,D=64,DM=NHEAD*D,ODM=1024;
constexpr int NW=8,QBLK=32,QB=QBLK*NW,KVBLK=64,NQB=SEQ/QB;
constexpr int ATTN_PITCH=DM, ATTN_UNIT_ROWS=QB;
__device__ __forceinline__ int crow(int r,int hi){return (r&3)+8*(r>>2)+4*hi;}
#define SBAR() __builtin_amdgcn_sched_barrier(0)
__device__ __forceinline__ void cmask(f32x16&p0,f32x16&p1,int jb,int qrel,int hi){
  const float NEG=-INFINITY; int kb=64*jb+4*hi;
  #pragma unroll
  for(int r=0;r<16;++r){int kv=kb+(r&3)+8*(r>>2); if(kv>qrel)p0[r]=NEG; if(kv+32>qrel)p1[r]=NEG;}
}

constexpr int NSLOT=3, SLOTB=8192;
constexpr int LDS_K=0, LDS_V=NSLOT*SLOTB, LDS_WS=2*NSLOT*SLOTB, LDS_OST=LDS_WS+NW*64*4, LDS_BYTES=LDS_OST+NW*4096;
constexpr float C2=0.125f*1.4426950408889634f;
__device__ __forceinline__ void glds16(const void*gsrc,unsigned lds_dst){unsigned keep;
  asm volatile("s_mov_b32 %0, m0\n\ts_mov_b32 m0, %2\n\ts_nop 0\n\tglobal_load_lds_dwordx4 %1, off\n\ts_mov_b32 m0, %0":"=&s"(keep):"v"(gsrc),"s"(lds_dst):"memory");}
__device__ __forceinline__ float max3f(float a,float b,float c){float r;asm("v_max3_f32 %0, %1, %2, %3":"=v"(r):"v"(a),"v"(b),"v"(c));return r;}
__device__ __forceinline__ float max2f(float a,float b){float r;asm("v_max_f32_e32 %0, %1, %2":"=v"(r):"v"(a),"v"(b));return r;}
__device__ __forceinline__ float fadd_s(float a,float b){float r;asm("v_add_f32_e32 %0, %1, %2":"=v"(r):"v"(a),"v"(b));return r;}
__device__ __forceinline__ float fsub_s(float a,float b){float r;asm("v_sub_f32_e32 %0, %1, %2":"=v"(r):"v"(a),"v"(b));return r;}
typedef float f32x2_t __attribute__((ext_vector_type(2))); typedef __bf16 bf16x2_t __attribute__((ext_vector_type(2)));
__device__ __forceinline__ unsigned cvtpk_s(float lo,float hi){f32x2_t v={lo,hi};bf16x2_t b=__builtin_convertvector(v,bf16x2_t);return __builtin_bit_cast(unsigned,b);}
#define WAIT_BAR(N) asm volatile("s_waitcnt vmcnt(" #N ") lgkmcnt(0)\n\ts_barrier":::"memory")

__device__ __forceinline__ void qkt(f32x16&p0,f32x16&p1,const char*Kslot,const bf16x8*qr,const f32x16&negm,int r32,int hi){
  const char*kb=Kslot+hi*1024+r32*16;
  #pragma unroll
  for(int d0=0;d0<4;++d0){
    const bf16x8 b0=*reinterpret_cast<const bf16x8*>(kb+d0*2048);
    const bf16x8 b1=*reinterpret_cast<const bf16x8*>(kb+d0*2048+512);
    if(d0==0){p0=__builtin_amdgcn_mfma_f32_32x32x16_bf16(b0,qr[0],negm,0,0,0);p1=__builtin_amdgcn_mfma_f32_32x32x16_bf16(b1,qr[0],negm,0,0,0);}
    else{p0=__builtin_amdgcn_mfma_f32_32x32x16_bf16(b0,qr[d0],p0,0,0,0);p1=__builtin_amdgcn_mfma_f32_32x32x16_bf16(b1,qr[d0],p1,0,0,0);}}
}
typedef __attribute__((address_space(3))) const char* lds_cptr;
typedef short v4i16_t __attribute__((ext_vector_type(4)));
__device__ __forceinline__ void kload8(bf16x8*kf,lds_cptr kp){
  kf[0]=*(const __attribute__((address_space(3))) bf16x8*)(kp);      kf[1]=*(const __attribute__((address_space(3))) bf16x8*)(kp+512);
  kf[2]=*(const __attribute__((address_space(3))) bf16x8*)(kp+2048); kf[3]=*(const __attribute__((address_space(3))) bf16x8*)(kp+2560);
  kf[4]=*(const __attribute__((address_space(3))) bf16x8*)(kp+4096); kf[5]=*(const __attribute__((address_space(3))) bf16x8*)(kp+4608);
  kf[6]=*(const __attribute__((address_space(3))) bf16x8*)(kp+6144); kf[7]=*(const __attribute__((address_space(3))) bf16x8*)(kp+6656);
}
__device__ __forceinline__ void kload2(bf16x8*kf,lds_cptr kp,int j){ kf[2*j]=*(const __attribute__((address_space(3))) bf16x8*)(kp+j*2048); kf[2*j+1]=*(const __attribute__((address_space(3))) bf16x8*)(kp+j*2048+512); }
__device__ __forceinline__ s16x4 vtr(lds_cptr p){ return __builtin_bit_cast(s16x4,__builtin_amdgcn_ds_read_tr16_b64_v4i16((__attribute__((address_space(3))) v4i16_t*)p)); }
__device__ __forceinline__ float rowmax(const f32x16&p0,const f32x16&p1){
  float a=max3f(p0[0],p0[1],p1[0]),b=max3f(p0[2],p0[3],p1[1]);a=max3f(a,p1[2],p1[3]);
  #pragma unroll
  for(int r=4;r<16;r+=4){a=max3f(a,p0[r],p0[r+1]);b=max3f(b,p0[r+2],p0[r+3]);a=max3f(a,p1[r],p1[r+1]);b=max3f(b,p1[r+2],p1[r+3]);}
  const float m=max2f(a,b);
  auto rr=__builtin_amdgcn_permlane32_swap(__float_as_uint(m),__float_as_uint(m),false,false);
  return max2f(__uint_as_float(rr[0]),__uint_as_float(rr[1]));
}
__device__ __forceinline__ void pv(f32x16*o,int vb,bf16x8 pa0,bf16x8 pa1,bf16x8 pa2,bf16x8 pa3){
  #pragma unroll
  for(int d0=0;d0<2;++d0){s16x4 lo[4],hi[4];
    #pragma unroll
    for(int ks=0;ks<4;++ks){
      asm volatile("ds_read_b64_tr_b16 %0,%1 offset:%c2":"=&v"(lo[ks]):"v"(vb),"i"(d0*4096+ks*1024):"memory");
      asm volatile("ds_read_b64_tr_b16 %0,%1 offset:%c2":"=&v"(hi[ks]):"v"(vb),"i"(d0*4096+ks*1024+512):"memory");}
    asm volatile("s_waitcnt lgkmcnt(0)":::"memory");SBAR();
    #define PK(k) (bf16x8){lo[k][0],lo[k][1],lo[k][2],lo[k][3],hi[k][0],hi[k][1],hi[k][2],hi[k][3]}
    o[d0]=__builtin_amdgcn_mfma_f32_32x32x16_bf16(pa0,PK(0),o[d0],0,0,0);
    o[d0]=__builtin_amdgcn_mfma_f32_32x32x16_bf16(pa1,PK(1),o[d0],0,0,0);
    o[d0]=__builtin_amdgcn_mfma_f32_32x32x16_bf16(pa2,PK(2),o[d0],0,0,0);
    o[d0]=__builtin_amdgcn_mfma_f32_32x32x16_bf16(pa3,PK(3),o[d0],0,0,0);
    #undef PK
  }
}

#ifndef ATTN_STORE16
#define ATTN_STORE16(p,v) (*(u32x4*)(p)=(v))
#endif
template<int THRL> __device__ __forceinline__ void attn_unit(int b,int h,int qb,const bf16*Q,const bf16*__restrict__ K,const bf16*__restrict__ V,bf16*O,const unsigned short*SEL,char*shm){
  const int tid=threadIdx.x,lane=tid&63,r32=lane&31,hi=lane>>5; const int wid=__builtin_amdgcn_readfirstlane(tid>>6);
  const long rowbase=(long)b*SEQ; const int q0=qb*QB;
  const bf16*Qw=Q+(rowbase+q0+wid*QBLK)*DM+h*D;
  const bf16*Kh=K+rowbase*DM+h*D,*Vh=V+rowbase*DM+h*D;
  const unsigned lds0=(unsigned)(uintptr_t)shm;
  float*wsf=(float*)(shm+LDS_WS)+wid*64;
  const bf16*ksrc=Kh+(long)lane*DM+wid*8;
  const bf16*vsrc=Vh+(long)(16*(wid&3)+(lane>>2))*DM+(wid>>2)*32+(lane&3)*8;
  const unsigned kdst=lds0+LDS_K+wid*1024, vdst=lds0+LDS_V+wid*1024;
  #define DMA_K(t,slot) glds16(ksrc+(long)(t)*KVBLK*DM,(unsigned)__builtin_amdgcn_readfirstlane(kdst+(slot)))
  #define DMA_V(t,slot) glds16(vsrc+(long)(t)*KVBLK*DM,(unsigned)__builtin_amdgcn_readfirstlane(vdst+(slot)))
  const int vb0=(int)(lds0+LDS_V)+((lane>>4)&1)*32+(lane&3)*8+(4*hi+((lane&15)>>2))*64;
  const char*Kbase=shm+LDS_K; bf16x8 kf[8];
  const lds_cptr shm3=(lds_cptr)shm; const lds_cptr kp0=shm3+LDS_K+hi*1024+r32*16; const lds_cptr vp0=shm3+LDS_V+((lane>>4)&1)*32+(lane&3)*8+(4*hi+((lane&15)>>2))*64;
  const int NT=(q0+QB)/KVBLK;
  DMA_K(0,0);DMA_V(0,0);DMA_K(1,SLOTB);
  bf16x8 qr[4];
  #pragma unroll
  for(int d0=0;d0<4;++d0)qr[d0]=*reinterpret_cast<const bf16x8*>(&Qw[(long)r32*DM+d0*16+hi*8]);
  float mhat=0.f,l_reg=0.f;f32x16 o[2];o[0]=f32x16{};o[1]=f32x16{};f32x16 negm=f32x16{};asm volatile("":"+v"(negm));
  const int qrel=wid*QBLK+r32;
  const unsigned selm=(unsigned)SEL[((long)(b*NHEAD+h))*SEQ+q0+qrel]|(1u<<qb);
  #define SELNEGM(t) do{ const bool on_=((selm>>((t)>>2))&1u)!=0u; const float nv_=on_?-mhat:-INFINITY; _Pragma("unroll") for(int r=0;r<16;++r)negm[r]=nv_; asm volatile("s_nop 7":"+v"(negm)); }while(0)
  #define CMASK(P0,P1,t) do{int jb_=(t)-(NT-4); if(jb_>=0)cmask(P0,P1,jb_,qrel,hi);}while(0)
  bool resc=false;
  #define START(P0,P1) do{ const float rm=rowmax(P0,P1); resc=false; \
    { const float dl=(rm==-INFINITY)?0.f:rm; mhat=fadd_s(mhat,dl); \
      _Pragma("unroll") for(int r=0;r<16;++r){P0[r]=fsub_s(P0[r],dl);P1[r]=fsub_s(P1[r],dl);} \
      _Pragma("unroll") for(int r=0;r<16;++r)negm[r]=-mhat; asm volatile("":"+v"(negm)); } \
    _Pragma("unroll") for(int r=0;r<16;++r)P0[r]=__builtin_amdgcn_exp2f(P0[r]); }while(0)
  #define RESC() do{ if(resc){ asm volatile("s_waitcnt lgkmcnt(0)":::"memory"); \
      _Pragma("unroll") for(int d_=0;d_<2;++d_) _Pragma("unroll") for(int r=0;r<16;++r)o[d_][r]*=wsf[crow(r,hi)]; } }while(0)
  f32x16 pA0,pA1,pB0,pB1;
  int sl_prev=0,sl_cur=0,sl_next=SLOTB;
  #define ROT() do{sl_prev=sl_cur;sl_cur=sl_next;sl_next=(sl_next==(NSLOT-1)*SLOTB)?0:sl_next+SLOTB;}while(0)
  DMA_K(2,2*SLOTB);
  WAIT_BAR(3);
  SELNEGM(0);
  qkt(pA0,pA1,Kbase,qr,negm,r32,hi);asm volatile("s_nop 15\n\ts_nop 7":"+v"(pA0),"+v"(pA1));CMASK(pA0,pA1,0);
  START(pA0,pA1);
  _Pragma("unroll") for(int r=0;r<16;++r)pA1[r]=__builtin_amdgcn_exp2f(pA1[r]);
  WAIT_BAR(0);
  DMA_K(3,0);DMA_V(1,SLOTB);
  ROT();
  kload8(kf,kp0+sl_cur);
  WAIT_BAR(2);
  s16x4 vlo[8],vhi[8]; u32x4 pw0,pw1,pw2,pw3;
  #define PKW(P,B) cvtpk_s(P[B],P[B+1])
  #define PAF(k) __builtin_bit_cast(bf16x8,pw##k)
  #define VFR(i) (bf16x8){vlo[i][0],vlo[i][1],vlo[i][2],vlo[i][3],vhi[i][0],vhi[i][1],vhi[i][2],vhi[i][3]}
  #define PIN(x) asm volatile("":"+v"(x))
  #define MX3(a,b,c) __builtin_fmaxf(__builtin_fmaxf((a),(b)),(c))
  #define GAPA(MF,A0,A1,A2,A3,W0,W1,PW) do{ MF; sacc+=A0; sacc+=A1; sacc+=A2; sacc+=A3; PIN(sacc); W0; W1; PIN(PW); SBAR(); }while(0)
  #define EX(v) __builtin_amdgcn_exp2f(v)
  #define GAPB(MF,X,B) do{ MF; X[B]=EX(X[B]); X[B+1]=EX(X[B+1]); X[B+2]=EX(X[B+2]); X[B+3]=EX(X[B+3]); PIN(X); SBAR(); }while(0)
  #define VRD(i) do{ vlo[i]=vtr(vp_+(((i)>>2)*4096+((i)&3)*1024)); vhi[i]=vtr(vp_+(((i)>>2)*4096+((i)&3)*1024+512)); }while(0)
  #define KRD(G,j) do{ if(G){ kload2(kf,kp0+sl_next,j); SBAR(); } }while(0)
  #define STEP(C0,C1,P0,P1,t,GK,GV,GL) do{ SBAR(); SELNEGM(t); SBAR(); \
    const lds_cptr vp_=vp0+sl_prev; \
    VRD(0); SBAR(); float sacc=(P0[0]+P0[1]); \
    GAPA(C0=__builtin_amdgcn_mfma_f32_32x32x16_bf16(kf[0],qr[0],negm,0,0,0), P0[2],P0[3],P0[4],P0[5],     pw0[0]=PKW(P0,0), pw0[1]=PKW(P0,2), pw0); \
    VRD(4); SBAR(); GAPA(C1=__builtin_amdgcn_mfma_f32_32x32x16_bf16(kf[1],qr[0],negm,0,0,0), P0[6],P0[7],P0[8],P0[9],     pw0[2]=PKW(P0,4), pw0[3]=PKW(P0,6), pw0); \
    VRD(1); SBAR(); GAPA(C0=__builtin_amdgcn_mfma_f32_32x32x16_bf16(kf[2],qr[1],C0,0,0,0),   P0[10],P0[11],P0[12],P0[13], pw1[0]=PKW(P0,8), pw1[1]=PKW(P0,10), pw1); \
    VRD(5); SBAR(); GAPA(C1=__builtin_amdgcn_mfma_f32_32x32x16_bf16(kf[3],qr[1],C1,0,0,0),   P0[14],P0[15],P1[0],P1[1],   pw1[2]=PKW(P0,12),pw1[3]=PKW(P0,14), pw1); \
    VRD(2); SBAR(); GAPA(C0=__builtin_amdgcn_mfma_f32_32x32x16_bf16(kf[4],qr[2],C0,0,0,0),   P1[2],P1[3],P1[4],P1[5],     pw2[0]=PKW(P1,0), pw2[1]=PKW(P1,2), pw2); \
    VRD(6); SBAR(); GAPA(C1=__builtin_amdgcn_mfma_f32_32x32x16_bf16(kf[5],qr[2],C1,0,0,0),   P1[6],P1[7],P1[8],P1[9],     pw2[2]=PKW(P1,4), pw2[3]=PKW(P1,6), pw2); \
    VRD(3); SBAR(); GAPA(C0=__builtin_amdgcn_mfma_f32_32x32x16_bf16(kf[6],qr[3],C0,0,0,0),   P1[10],P1[11],P1[12],P1[13], pw3[0]=PKW(P1,8), pw3[1]=PKW(P1,10), pw3); \
    VRD(7); SBAR(); GAPA(C1=__builtin_amdgcn_mfma_f32_32x32x16_bf16(kf[7],qr[3],C1,0,0,0),   P1[14],P1[15],0.f,0.f,       pw3[2]=PKW(P1,12),pw3[3]=PKW(P1,14), pw3); \
    l_reg+=sacc; \
    if(GK){DMA_K((t)+3,sl_cur);} if(GV){DMA_V((t)+1,sl_next);} \
    CMASK(C0,C1,t); \
    { float a=MX3(C0[0],C0[1],C1[0]),b=MX3(C0[2],C0[3],C1[1]); a=MX3(a,C1[2],C1[3]); \
      _Pragma("unroll") for(int r=4;r<16;r+=4){a=MX3(a,C0[r],C0[r+1]);b=MX3(b,C0[r+2],C0[r+3]);a=MX3(a,C1[r],C1[r+1]);b=MX3(b,C1[r+2],C1[r+3]);} \
      float rm=__builtin_fmaxf(a,b); { auto rr=__builtin_amdgcn_permlane32_swap(__float_as_uint(rm),__float_as_uint(rm),false,false); rm=__builtin_fmaxf(__uint_as_float(rr[0]),__uint_as_float(rr[1])); } \
      resc=false; \
      if(__builtin_expect(__any(rm>(float)THRL),0)){ const float dl=__builtin_fmaxf(rm,0.f); mhat+=dl; \
        _Pragma("unroll") for(int r=0;r<16;++r){C0[r]-=dl;C1[r]-=dl;} \
        _Pragma("unroll") for(int r=0;r<16;++r)negm[r]=-mhat; asm volatile("":"+v"(negm)); \
        const float f=__builtin_amdgcn_exp2f(-dl); l_reg*=f; if(hi==0)wsf[r32]=f; resc=true; } } \
    SBAR(); \
    GAPB(o[0]=__builtin_amdgcn_mfma_f32_32x32x16_bf16(PAF(0),VFR(0),o[0],0,0,0), C0,0); \
    GAPB(o[1]=__builtin_amdgcn_mfma_f32_32x32x16_bf16(PAF(0),VFR(4),o[1],0,0,0), C0,4); \
    KRD(GL,0); GAPB(o[0]=__builtin_amdgcn_mfma_f32_32x32x16_bf16(PAF(1),VFR(1),o[0],0,0,0), C0,8); \
    KRD(GL,1); GAPB(o[1]=__builtin_amdgcn_mfma_f32_32x32x16_bf16(PAF(1),VFR(5),o[1],0,0,0), C0,12); \
    KRD(GL,2); GAPB(o[0]=__builtin_amdgcn_mfma_f32_32x32x16_bf16(PAF(2),VFR(2),o[0],0,0,0), C1,0); \
    KRD(GL,3); GAPB(o[1]=__builtin_amdgcn_mfma_f32_32x32x16_bf16(PAF(2),VFR(6),o[1],0,0,0), C1,4); \
    GAPB(o[0]=__builtin_amdgcn_mfma_f32_32x32x16_bf16(PAF(3),VFR(3),o[0],0,0,0), C1,8); \
    GAPB(o[1]=__builtin_amdgcn_mfma_f32_32x32x16_bf16(PAF(3),VFR(7),o[1],0,0,0), C1,12); \
    }while(0)
  int t=1;
  #undef CMASK
  #define CMASK(P0,P1,t) do{}while(0)
  for(;t+5<NT;t+=2){
    STEP(pB0,pB1,pA0,pA1,t,true,true,true);     WAIT_BAR(2); RESC(); ROT();
    STEP(pA0,pA1,pB0,pB1,t+1,true,true,true);   WAIT_BAR(2); RESC(); ROT();
  }
  #undef CMASK
  #define CMASK(P0,P1,t) do{int jb_=(t)-(NT-4); if(jb_>=0)cmask(P0,P1,jb_,qrel,hi);}while(0)
  #define ENDW(tt) do{ if((tt)+3<NT){WAIT_BAR(2);} else if((tt)+2<NT){WAIT_BAR(1);} else {WAIT_BAR(0);} }while(0)
  for(;t+1<NT;t+=2){
    STEP(pB0,pB1,pA0,pA1,t,(t+3<NT),(t+1<NT),(t+1<NT));       ENDW(t);   RESC(); ROT();
    STEP(pA0,pA1,pB0,pB1,t+1,(t+4<NT),(t+2<NT),(t+2<NT));     ENDW(t+1); RESC(); ROT();
  }
  STEP(pB0,pB1,pA0,pA1,NT-1,false,false,false); RESC();
  { float sacc=pB0[0]+pB0[1]; _Pragma("unroll") for(int r=2;r<16;++r)sacc+=pB0[r]; _Pragma("unroll") for(int r=0;r<16;++r)sacc+=pB1[r]; l_reg+=sacc;
    pw0=(u32x4){PKW(pB0,0),PKW(pB0,2),PKW(pB0,4),PKW(pB0,6)};pw1=(u32x4){PKW(pB0,8),PKW(pB0,10),PKW(pB0,12),PKW(pB0,14)};pw2=(u32x4){PKW(pB1,0),PKW(pB1,2),PKW(pB1,4),PKW(pB1,6)};pw3=(u32x4){PKW(pB1,8),PKW(pB1,10),PKW(pB1,12),PKW(pB1,14)};
    SBAR(); pv(o,vb0+sl_cur,PAF(0),PAF(1),PAF(2),PAF(3)); }
  #undef PKW
  #undef PAF
  #undef VFR
  #undef PIN
  #undef MX3
  #undef GAPA
  #undef GAPB
  #undef EX
  #undef VRD
  #undef KRD
  #undef STEP
  #undef ENDW
  {auto rr=__builtin_amdgcn_permlane32_swap(__float_as_uint(l_reg),__float_as_uint(l_reg),false,false);l_reg=__uint_as_float(rr[0])+__uint_as_float(rr[1]);}
  if(hi==0)wsf[32+r32]=l_reg;asm volatile("s_waitcnt lgkmcnt(0)":::"memory");
  float rli[16];
  #pragma unroll
  for(int r=0;r<16;++r)rli[r]=__builtin_amdgcn_rcpf(wsf[32+crow(r,hi)]);
  bf16*Ow=O+(rowbase+q0+wid*QBLK)*ODM+h*D;
  { bf16*stg=(bf16*)(shm+LDS_OST)+wid*2048;
    #pragma unroll
    for(int r=0;r<16;++r){const int orow=crow(r,hi);
      #pragma unroll
      for(int d0=0;d0<2;++d0)stg[orow*64+d0*32+r32]=__float2bfloat16(o[d0][r]*rli[r]);}
    asm volatile("s_waitcnt lgkmcnt(0)":::"memory");
    #pragma unroll
    for(int i=0;i<4;++i){const int row=i*8+(lane>>3),ch=lane&7; const u32x4 v=*(const u32x4*)(stg+row*64+ch*8); ATTN_STORE16(Ow+(long)row*ODM+ch*8,v);} }
  asm volatile("s_waitcnt lgkmcnt(0)\n\ts_barrier":::"memory");
  #undef DMA_K
  #undef DMA_V
  #undef CMASK
  #undef START
  #undef RESC
  #undef ROT
  #undef SELNEGM
}
constexpr int ATTN_LDS_BYTES=LDS_BYTES;
struct AttnTensors { const bf16* Q; const bf16* K; const bf16* V; bf16* O; const unsigned short* SEL; };
struct AttnUnit { int bh; int qb; };
struct StaticOrder {
  int vcu,G;
  __device__ __forceinline__ explicit StaticOrder(int grid,int block):vcu((grid%8==0)?(block%8)*(grid/8)+block/8:block),G(grid){}
  __device__ __forceinline__ bool next(int i,AttnUnit&u)const{ const int v=vcu+(i>>2)*G; if(v>=256)return false; const int s=v&3,k=i&3; u.bh=v>>2; u.qb=(k==0)?s:(k==1)?7-s:(k==2)?8+s:15-s; return true; }
  __device__ __forceinline__ void a_ready(const AttnUnit&)const{}
  __device__ __forceinline__ void done(const AttnUnit&)const{}
};
template<class Sched,int THRL=8> __device__ __forceinline__ void attn_phase(char*lds,const AttnTensors&T,const Sched&S){
  AttnUnit u;
  for(int i=0;S.next(i,u);++i){ S.a_ready(u); attn_unit<THRL>(u.bh/NHEAD,u.bh%NHEAD,u.qb,T.Q,T.K,T.V,T.O,T.SEL,lds); S.done(u); }
}
#undef SBAR
#undef WAIT_BAR
}
constexpr int NWAVES = 8;
constexpr int BATCH = 8, SEQ = 4096, D = 1024, M = BATCH * SEQ, FF = 2816, NGU = 2 * FF, NIN = 2560, AW = 512, MW = 512;
constexpr int MH = 4, MHD = 128, AHN = 8, NB = 16;
constexpr int SV = 144;
constexpr float EPS = 1e-6f;
constexpr size_t MiB = 1u << 20;
constexpr size_t WS_CTL = 0, CTL_ZERO_BYTES = 32768;
constexpr size_t WS_MOD = 1 * MiB;
constexpr size_t WS_WGU1 = 2 * MiB, WS_WD1 = 13 * MiB, WS_WGU2 = 19 * MiB, WS_WD2 = 30 * MiB, WS_WIN = 36 * MiB, WS_WOUT = 41 * MiB;
constexpr size_t WS_WQM = 43 * MiB, WS_WKM = WS_WQM + 131072, WS_WVM = WS_WKM + 131072, WS_WEC = WS_WVM + 131072, WS_WEM = WS_WEC + 16384;
constexpr size_t WS_KMEAN = 48 * MiB  , WS_SEL = 50 * MiB + 524288, WS_GP = 51 * MiB, WS_GSUP = 55 * MiB;
constexpr size_t WS_BW2 = 56 * MiB, WS_BW3 = 56 * MiB + 131072, WS_SSQ1 = 58 * MiB, WS_SSQ2 = 60 * MiB;
constexpr size_t WS_XN = 64 * MiB, WS_KMT = 64 * MiB, WS_VMT = 96 * MiB;
constexpr size_t WS_HB = 128 * MiB, WS_Q = 128 * MiB, WS_K = 160 * MiB, WS_V = 192 * MiB, WS_XM = 224 * MiB, WS_Z = 256 * MiB, WS_SST = 224 * MiB;
constexpr size_t WS_QM = 304 * MiB, WS_KM = 336 * MiB, WS_XC = 368 * MiB, WS_DST = 400 * MiB, WS_CAT = 448 * MiB, WS_END = 512 * MiB;
static_assert(WS_HB + (size_t)M * FF * 2 <= WS_QM && WS_DST + (size_t)512 * SV * 128 * 4 <= WS_CAT && WS_SST + (size_t)512 * SV * 128 * 2 <= WS_Z, "d_ws map");
constexpr int CW_TMO = 0, CW_CODE = 1, CW_BAR = 4096;
constexpr int RING_OFF = 0, RING_BYTES = 131072;
constexpr int LDSCTL_OFF = RING_BYTES, MISC_OFF = LDSCTL_OFF + 320;
constexpr int LDS_BYTES = 147456;
#define GAS __attribute__((address_space(1)))
#define LAS __attribute__((address_space(3)))
typedef unsigned short bf16;
typedef unsigned v4u __attribute__((ext_vector_type(4)));
typedef float f32x4 __attribute__((ext_vector_type(4)));
typedef short bf16x8 __attribute__((ext_vector_type(8)));
typedef GAS unsigned gu32;
typedef GAS unsigned long long gu64;
#define RLX_AGENT __ATOMIC_RELAXED, __HIP_MEMORY_SCOPE_AGENT
#define LDS_WAIT() asm volatile("s_waitcnt lgkmcnt(0)" ::: "memory")
#define VM_WAIT() asm volatile("s_waitcnt vmcnt(0)" ::: "memory")
__device__ __forceinline__ unsigned long long rt() { return __builtin_amdgcn_s_memrealtime(); }
__device__ __forceinline__ unsigned f2bf(float f) { unsigned u = __builtin_bit_cast(unsigned, f); return (u + 0x7fffu + ((u >> 16) & 1u)) >> 16; }
__device__ __forceinline__ unsigned pk2(float lo, float hi) { return f2bf(lo) | (f2bf(hi) << 16); }

#define XB_TMO      128
#define XB_XCNT(j)  (256  + 64 * (j))
#define XB_XSUB(j)  (1280 + 64 * (j))
#define XB_XGEN(j)  (2304 + 64 * (j))
#define XB_TOP      3328
#define XB_TOPGEN   3392
#define XCD_BAR_WORDS 3456
#define XB_SPIN_CAP (1u << 18)

__device__ __forceinline__ unsigned xb_ld(unsigned* p)              { return __hip_atomic_load(p, __ATOMIC_RELAXED, __HIP_MEMORY_SCOPE_AGENT); }
__device__ __forceinline__ unsigned xb_add(unsigned* p, unsigned v) { return __hip_atomic_fetch_add(p, v, __ATOMIC_RELAXED, __HIP_MEMORY_SCOPE_AGENT); }
__device__ __forceinline__ unsigned xb_xcc_id() { return (unsigned)__builtin_amdgcn_s_getreg((3 << 11) | 20) & 0xFu; }
#define XB_SPIN(cond, bar) do { unsigned _sp = 0; while (cond) { __builtin_amdgcn_s_sleep(1); \
    if ((++_sp & 255u) == 0u) { if (xb_ld(&(bar)[XB_TMO])) break; if (_sp > XB_SPIN_CAP) { atomicAdd(&(bar)[XB_TMO], 1u); break; } } } } while (0)

struct XcdBarrier {
    unsigned* bar; unsigned x;
    volatile LAS unsigned* st;
};

__device__ __forceinline__ XcdBarrier xcd_barrier_post(unsigned* bar, volatile LAS unsigned* st) {
    XcdBarrier b; b.bar = bar; b.x = xb_xcc_id(); b.st = st;
    if (threadIdx.x == 0) (void)xb_add(&bar[XB_XCNT(b.x)], 1u);
    return b;
}
__device__ __forceinline__ void xcd_barrier_complete(unsigned* bar, unsigned x, unsigned& nloc, unsigned& nx) {
    const unsigned G = gridDim.x * gridDim.y * gridDim.z;
    unsigned sum, cnt, mine, sp = 0u;
    for (;;) {
        sum = 0u; cnt = 0u; mine = 0u;
#pragma unroll
        for (unsigned j = 0; j < 16; ++j) { const unsigned c = xb_ld(&bar[XB_XCNT(j)]); sum += c; cnt += (c > 0u) ? 1u : 0u; mine = (j == x) ? c : mine; }
        if (sum == G) break;
        __builtin_amdgcn_s_sleep(1);
        if ((++sp & 255u) == 0u) { if (xb_ld(&bar[XB_TMO])) break; if (sp > XB_SPIN_CAP) { atomicAdd(&bar[XB_TMO], 1u); break; } }
    }
    nloc = mine > 0u ? mine : 1u; nx = cnt > 0u ? cnt : 1u;
}

__device__ __forceinline__ void xcd_barrier(const XcdBarrier& b) {
    asm volatile("s_waitcnt vmcnt(0)" ::: "memory");
    __syncthreads();
    if (threadIdx.x == 0) {
        unsigned* bar = b.bar;
        __builtin_amdgcn_s_waitcnt(0);
        unsigned nloc = b.st[0], nx = b.st[1];
        if (nloc == 0u) { xcd_barrier_complete(bar, b.x, nloc, nx); b.st[0] = nloc; b.st[1] = nx; }
        const unsigned old = xb_add(&bar[XB_XSUB(b.x)], 1u);
        const unsigned gen = old / nloc;
        if (old + 1u == (gen + 1u) * nloc) {
            __builtin_amdgcn_fence(__ATOMIC_RELEASE, "agent");
            asm volatile("s_waitcnt vmcnt(0)" ::: "memory");
            const unsigned og = xb_add(&bar[XB_TOP], 1u);
            const unsigned tg = og / nx;
            if (og + 1u == (tg + 1u) * nx) xb_add(&bar[XB_TOPGEN], 1u);
            else XB_SPIN(xb_ld(&bar[XB_TOPGEN]) == tg, bar);
            __builtin_amdgcn_fence(__ATOMIC_ACQUIRE, "agent");
            xb_add(&bar[XB_XGEN(b.x)], 1u);
            asm volatile("s_waitcnt vmcnt(0)" ::: "memory");
        } else {
            XB_SPIN(xb_ld(&bar[XB_XGEN(b.x)]) == gen, bar);
            __builtin_amdgcn_fence(__ATOMIC_ACQUIRE, "agent");
            asm volatile("s_waitcnt vmcnt(0)" ::: "memory");
        }
    }
    __syncthreads();
}

#define EV_SUB(e, x) (512 + 256 * (e) + 8 * (x))
#define EV_TOP(e)    (512 + 256 * (e) + 192)
__device__ __forceinline__ void ev_arrive(const XcdBarrier& b, unsigned* ctl, int e) {
    asm volatile("s_waitcnt vmcnt(0)" ::: "memory");
    __syncthreads();
    if (threadIdx.x == 0) {
        __builtin_amdgcn_s_waitcnt(0);
        unsigned nloc = b.st[0], nx = b.st[1];
        if (nloc == 0u) { xcd_barrier_complete(b.bar, b.x, nloc, nx); b.st[0] = nloc; b.st[1] = nx; }
        const unsigned old = xb_add(&ctl[EV_SUB(e, b.x)], 1u);
        if (old + 1u == nloc) {
            __builtin_amdgcn_fence(__ATOMIC_RELEASE, "agent");
            asm volatile("s_waitcnt vmcnt(0)" ::: "memory");
            xb_add(&ctl[EV_TOP(e)], 1u);
        }
    }
}
__device__ __forceinline__ void ev_wait(const XcdBarrier& b, unsigned* ctl, int e) {
    if (threadIdx.x == 0) {
        const unsigned nx = b.st[1];
        XB_SPIN(xb_ld(&ctl[EV_TOP(e)]) < nx, b.bar);
        __builtin_amdgcn_fence(__ATOMIC_ACQUIRE, "agent");
        asm volatile("s_waitcnt vmcnt(0)" ::: "memory");
    }
    __syncthreads();
}
#define DEVI __device__ __forceinline__
typedef unsigned u32x2 __attribute__((ext_vector_type(2)));
typedef float f32x2 __attribute__((ext_vector_type(2)));
DEVI float bf2f(unsigned short v) { return __builtin_bit_cast(float, (unsigned)v << 16); }
DEVI float bflo(unsigned w) { return __builtin_bit_cast(float, w << 16); }
DEVI float bfhi(unsigned w) { return __builtin_bit_cast(float, w & 0xffff0000u); }
DEVI float wave_sum(float v) {
#pragma unroll
    for (int o = 1; o < 64; o <<= 1) v += __shfl_xor(v, o);
    return v;
}
DEVI float silu_f(float x) { return x * __builtin_amdgcn_rcpf(1.0f + __builtin_amdgcn_exp2f(x * -1.4426950408889634f)); }
#define MMA16(p1, p2, acc) __builtin_amdgcn_mfma_f32_16x16x32_bf16(p1, p2, acc, 0, 0, 0)
DEVI bf16x8 ldfrag(const LAS unsigned char* img, int stride, int row0, int k0, int lane) {
    return *(const LAS bf16x8*)(img + (row0 + (lane & 15)) * stride + (k0 + 8 * (lane >> 4)) * 2);
}

DEVI void phase_mod(const float* c, const float* w_ada, const float* b_ada, const float* n1, const float* n2, const float* n3, float* MOD,
                    LAS unsigned char* lds, int vcu, int G, int tid) {
    LAS float* cb = (LAS float*)lds;
    LAS float* part = cb + 8192;
    { float tmpc[16];
#pragma unroll
      for (int j = 0; j < 16; ++j) tmpc[j] = c[tid + 512 * j];
#pragma unroll
      for (int j = 0; j < 16; ++j) { const int i = tid + 512 * j, b = i >> 10, k = i & 1023; cb[k * 8 + b] = tmpc[j]; } }
    __syncthreads();
    const int lane = tid & 63, wave = tid >> 6;
    constexpr int NC = 9 * D;
    int per = (NC + G - 1) / G; if (per > 64) per = 64;
    for (int base = vcu * per; base < NC; base += G * per) {
        const int j = base + lane; const bool act = lane < per && j < NC;
        float acc[8];
#pragma unroll
        for (int b = 0; b < 8; ++b) acc[b] = 0.f;
        if (act) {
            const float* wp = w_ada + (size_t)(wave * 128) * NC + j;
#pragma nounroll
            for (int kb = 0; kb < 128; kb += 32) { float wvv[32];
#pragma unroll
            for (int k = 0; k < 32; ++k) wvv[k] = wp[(size_t)(kb + k) * NC];
#pragma unroll
            for (int kk = 0; kk < 32; ++kk) { const int k = kb + kk;
                const float wv = wvv[kk];
                const LAS f32x4* cp = (const LAS f32x4*)(cb + (wave * 128 + k) * 8); const f32x4 c0 = cp[0], c1 = cp[1];
                acc[0] += c0.x * wv; acc[1] += c0.y * wv; acc[2] += c0.z * wv; acc[3] += c0.w * wv;
                acc[4] += c1.x * wv; acc[5] += c1.y * wv; acc[6] += c1.z * wv; acc[7] += c1.w * wv;
            } }
        }
#pragma unroll
        for (int b = 0; b < 8; ++b) part[(wave * 8 + b) * 64 + lane] = acc[b];
        __syncthreads();
        { const int b = tid >> 6;
          if (act) { float s = 0.f;
#pragma unroll
              for (int w = 0; w < 8; ++w) s += part[(w * 8 + b) * 64 + lane];
              s += b_ada[j];
              const int i = j >> 10, d = j & 1023, r3 = i % 3; float v;
              if (r3 == 0) v = s;
              else if (r3 == 1) { const float* nw = (i == 1) ? n1 : (i == 4) ? n2 : n3; v = nw[d] * (1.0f + s); }
              else v = ((i == 5) ? 1.0f : 0.5f) * (1.0f + s);
              MOD[(size_t)(i * 8 + b) * D + d] = v; } }
        __syncthreads();
    }
}

DEVI void transpose_item(const float* W, int K, int N, bf16* WT, int mode, float scale, LAS float* scr, int item, int lane) {
    const int nblk = N / 32, kb = item / nblk, nb = item % nblk, k0 = 64 * kb, n0 = 32 * nb;
    const int rb = (mode == 0) ? n0 : ((n0 >> 7) * 256 + (n0 & 127) + (mode == 2 ? 128 : 0));
#pragma unroll
    for (int i = 0; i < 32; ++i) { const int kk = 2 * i + (lane >> 5); scr[kk * 33 + (lane & 31)] = W[(size_t)(k0 + kk) * N + n0 + (lane & 31)] * scale; }
    LDS_WAIT(); asm volatile("" ::: "memory");
    const int c = lane & 7;
#pragma unroll
    for (int j = 0; j < 4; ++j) { const int n = (lane >> 3) + 8 * j; const LAS float* s = scr + (8 * c) * 33 + n;
        v4u o; o.x = pk2(s[0 * 33], s[1 * 33]); o.y = pk2(s[2 * 33], s[3 * 33]); o.z = pk2(s[4 * 33], s[5 * 33]); o.w = pk2(s[6 * 33], s[7 * 33]);
        *(GAS v4u*)(WT + (size_t)(rb + n) * K + k0 + 8 * c) = o; }
    LDS_WAIT(); asm volatile("" ::: "memory");
}
DEVI unsigned pk4_fp8(float a, float b, float c, float d) {
    a = fminf(fmaxf(a, -448.f), 448.f); b = fminf(fmaxf(b, -448.f), 448.f); c = fminf(fmaxf(c, -448.f), 448.f); d = fminf(fmaxf(d, -448.f), 448.f);
    int w = __builtin_amdgcn_cvt_pk_fp8_f32(a, b, 0, false); w = __builtin_amdgcn_cvt_pk_fp8_f32(c, d, w, true); return (unsigned)w;
}
constexpr float W8SCALE_UP = 32.f, W8SCALE_DN = 64.f;
DEVI void transpose_item8(const float* W, int K, int N, unsigned char* WT, int mode, float scale, LAS float* scr, int item, int lane) {
    const int nblk = N / 32, kb = item / nblk, nb = item % nblk, k0 = 64 * kb, n0 = 32 * nb;
    const int rb = (mode == 0) ? n0 : ((n0 >> 7) * 256 + (n0 & 127) + (mode == 2 ? 128 : 0));
#pragma unroll
    for (int i = 0; i < 32; ++i) { const int kk = 2 * i + (lane >> 5); scr[kk * 33 + (lane & 31)] = W[(size_t)(k0 + kk) * N + n0 + (lane & 31)] * scale; }
    LDS_WAIT(); asm volatile("" ::: "memory");
#pragma unroll
    for (int j = 0; j < 2; ++j) { const int idx = lane + 64 * j, n = idx >> 2, c = idx & 3; const LAS float* s = scr + (16 * c) * 33 + n;
        v4u o; o.x = pk4_fp8(s[0 * 33], s[1 * 33], s[2 * 33], s[3 * 33]); o.y = pk4_fp8(s[4 * 33], s[5 * 33], s[6 * 33], s[7 * 33]);
        o.z = pk4_fp8(s[8 * 33], s[9 * 33], s[10 * 33], s[11 * 33]); o.w = pk4_fp8(s[12 * 33], s[13 * 33], s[14 * 33], s[15 * 33]);
        *(GAS v4u*)(WT + (size_t)(rb + n) * K + k0 + 16 * c) = o; }
    LDS_WAIT(); asm volatile("" ::: "memory");
}
DEVI void modnorm_rows8(const float* X, const float* A, const float* Bv, unsigned char* XN8, int gw, int NGW, int lane) {
    constexpr int R = 2;
    const int RPW = (M + NGW - 1) / NGW, mbeg = gw * RPW, mend = (mbeg + RPW < M) ? mbeg + RPW : M;
    int bcur = -1; f32x4 av[4], bv[4];
    for (int m0 = mbeg; m0 < mend; m0 += R) {
        f32x4 v[R][4];
#pragma unroll
        for (int r = 0; r < R; ++r) { const int m = m0 + r; const GAS f32x4* xr = (const GAS f32x4*)(X + (size_t)(m < mend ? m : mbeg) * D) + lane;
#pragma unroll
            for (int j = 0; j < 4; ++j) v[r][j] = __builtin_nontemporal_load(xr + 64 * j); }
#pragma unroll
        for (int r = 0; r < R; ++r) { const int m = m0 + r; if (m >= mend) break; const int b = m / SEQ; float s = 0.f;
            if (b != bcur) { bcur = b; const f32x4* ap = (const f32x4*)(A + (size_t)b * D) + lane; const f32x4* bp = (const f32x4*)(Bv + (size_t)b * D) + lane;
#pragma unroll
                for (int j = 0; j < 4; ++j) { av[j] = ap[64 * j]; bv[j] = bp[64 * j]; } }
#pragma unroll
            for (int j = 0; j < 4; ++j) s += (v[r][j].x * v[r][j].x + v[r][j].y * v[r][j].y) + (v[r][j].z * v[r][j].z + v[r][j].w * v[r][j].w);
            const float rstd = 1.0f / sqrtf(wave_sum(s) * (1.f / D) + EPS);
            GAS unsigned* o4 = (GAS unsigned*)(XN8 + (size_t)m * D) + lane;
#pragma unroll
            for (int j = 0; j < 4; ++j) { const f32x4 o = v[r][j] * rstd * av[j] + bv[j]; o4[64 * j] = pk4_fp8(o.x, o.y, o.z, o.w); } }
    }
}
DEVI void modnorm_rows8b(const bf16* X, const float* A, const float* Bv, unsigned char* XN8, int gw, int NGW, int lane) {
    constexpr int R = 4;
    const int RPW = (M + NGW - 1) / NGW, mbeg = gw * RPW, mend = (mbeg + RPW < M) ? mbeg + RPW : M;
    int bcur = -1; f32x4 av[4], bv[4];
    for (int m0 = mbeg; m0 < mend; m0 += R) {
        u32x2 w[R][4];
#pragma unroll
        for (int r = 0; r < R; ++r) { const int m = m0 + r; const GAS u32x2* xr = (const GAS u32x2*)(X + (size_t)(m < mend ? m : mbeg) * D) + lane;
#pragma unroll
            for (int j = 0; j < 4; ++j) w[r][j] = xr[64 * j]; }
#pragma unroll
        for (int r = 0; r < R; ++r) { const int m = m0 + r; if (m >= mend) break; const int b = m / SEQ; f32x4 v[4]; float s = 0.f;
            if (b != bcur) { bcur = b; const f32x4* ap = (const f32x4*)(A + (size_t)b * D) + lane; const f32x4* bp = (const f32x4*)(Bv + (size_t)b * D) + lane;
#pragma unroll
                for (int j = 0; j < 4; ++j) { av[j] = ap[64 * j]; bv[j] = bp[64 * j]; } }
#pragma unroll
            for (int j = 0; j < 4; ++j) { v[j] = (f32x4){bflo(w[r][j].x), bfhi(w[r][j].x), bflo(w[r][j].y), bfhi(w[r][j].y)}; s += (v[j].x * v[j].x + v[j].y * v[j].y) + (v[j].z * v[j].z + v[j].w * v[j].w); }
            const float rstd = 1.0f / sqrtf(wave_sum(s) * (1.f / D) + EPS);
            GAS unsigned* o4 = (GAS unsigned*)(XN8 + (size_t)m * D) + lane;
#pragma unroll
            for (int j = 0; j < 4; ++j) { const f32x4 o = v[j] * rstd * av[j] + bv[j]; o4[64 * j] = pk4_fp8(o.x, o.y, o.z, o.w); } }
    }
}
struct WPtrs { const float *g1, *u1, *d1, *g2, *u2, *d2, *win, *wout, *wq, *wk, *wv, *wif; };
constexpr int WI_G1 = 0, WI_U1 = 1408, WI_G2 = 2816, WI_U2 = 4224, WI_D1 = 5632, WI_D2 = 7040, WI_IN = 8448, WI_OUT = 9728, WI_MH = 10240, WI_END = 10336;
DEVI void phase_weights(const WPtrs& P, unsigned char* ws, LAS unsigned char* lds, int gw, int NGW, int wave, int lane, int it_lo, int it_hi) {
    LAS float* scr = (LAS float*)(lds + wave * 16384);
    constexpr int I_GU = (D / 64) * (FF / 32), I_DN = (FF / 64) * (D / 32), I_IN = (D / 64) * (NIN / 32), I_OUT = (D / 64) * (D / 32), I_MH = 2 * 4;
    constexpr int NITEMS = 4 * I_GU + 2 * I_DN + I_IN + I_OUT + 12 * I_MH;
    static_assert(NITEMS == WI_END && 4 * I_GU == WI_D1 && 4 * I_GU + 2 * I_DN == WI_IN && WI_IN + I_IN == WI_OUT && WI_OUT + I_OUT == WI_MH, "item ranges");
    for (int it = it_lo + gw; it < it_hi; it += NGW) {
        int r = it;
        if (r < I_GU) { transpose_item8(P.g1, D, FF, ws + WS_WGU1, 1, W8SCALE_UP, scr, r, lane); continue; } r -= I_GU;
        if (r < I_GU) { transpose_item8(P.u1, D, FF, ws + WS_WGU1, 2, W8SCALE_UP, scr, r, lane); continue; } r -= I_GU;
        if (r < I_GU) { transpose_item8(P.g2, D, FF, ws + WS_WGU2, 1, W8SCALE_UP, scr, r, lane); continue; } r -= I_GU;
        if (r < I_GU) { transpose_item8(P.u2, D, FF, ws + WS_WGU2, 2, W8SCALE_UP, scr, r, lane); continue; } r -= I_GU;
        if (r < I_DN) { transpose_item8(P.d1, FF, D, ws + WS_WD1, 0, W8SCALE_DN, scr, r, lane); continue; } r -= I_DN;
        if (r < I_DN) { transpose_item8(P.d2, FF, D, ws + WS_WD2, 0, W8SCALE_DN, scr, r, lane); continue; } r -= I_DN;
        if (r < I_IN) { transpose_item(P.win, D, NIN, (bf16*)(ws + WS_WIN), 0, 1.f, scr, r, lane); continue; } r -= I_IN;
        if (r < I_OUT) { transpose_item(P.wout, D, D, (bf16*)(ws + WS_WOUT), 0, 1.f, scr, r, lane); continue; } r -= I_OUT;
        const int which = r / (4 * I_MH), hh = (r / I_MH) & 3, sub = r % I_MH; const size_t ho = (size_t)hh * MHD * MHD;
        if (which == 0) transpose_item(P.wq + ho, MHD, MHD, (bf16*)(ws + WS_WQM) + ho, 0, 1.f, scr, sub, lane);
        else if (which == 1) transpose_item(P.wk + ho, MHD, MHD, (bf16*)(ws + WS_WKM) + ho, 0, 0.08838834764831845f, scr, sub, lane);
        else transpose_item(P.wv + ho, MHD, MHD, (bf16*)(ws + WS_WVM) + ho, 0, 1.f, scr, sub, lane);
    }
}
DEVI void phase_weff(const WPtrs& P, unsigned char* ws, int gw, int NGW, int lane) {
    bf16* WEC = (bf16*)(ws + WS_WEC); bf16* WEM = (bf16*)(ws + WS_WEM);
    for (int o8 = gw; o8 < 2 * MH * 16 * MHD / 8; o8 += NGW) {
        const int o = o8 * 8, m = o / (MH * 16 * MHD), r = o % (MH * 16 * MHD), hh = r / (16 * MHD), g = (r / MHD) & 15, d0 = r % MHD;
        bf16* dst = (m == 0 ? WEC : WEM) + r;
        if (g >= 8) { if (lane < 8) dst[lane] = (bf16)0; continue; }
        float s[8];
        if (m == 0) { const float g0a = P.wif[(size_t)(hh * 384 + lane) * 8 + g], g0b = P.wif[(size_t)(hh * 384 + 64 + lane) * 8 + g], g1a = P.wif[(size_t)(hh * 384 + 128 + lane) * 8 + g], g1b = P.wif[(size_t)(hh * 384 + 192 + lane) * 8 + g];
            float qa[8], qb[8], ka[8], kb[8];
#pragma unroll
            for (int i = 0; i < 8; ++i) { const float* a = P.wq + ((size_t)hh * MHD + d0 + i) * MHD; const float* b2 = P.wk + ((size_t)hh * MHD + d0 + i) * MHD; qa[i] = a[lane]; qb[i] = a[64 + lane]; ka[i] = b2[lane]; kb[i] = b2[64 + lane]; }
#pragma unroll
            for (int i = 0; i < 8; ++i) s[i] = (qa[i] * g0a + qb[i] * g0b) + (ka[i] * g1a + kb[i] * g1b); }
        else { const float g2a = P.wif[(size_t)(hh * 384 + 256 + lane) * 8 + g], g2b = P.wif[(size_t)(hh * 384 + 320 + lane) * 8 + g];
            float va[8], vb[8];
#pragma unroll
            for (int i = 0; i < 8; ++i) { const float* a = P.wv + ((size_t)hh * MHD + d0 + i) * MHD; va[i] = a[lane]; vb[i] = a[64 + lane]; }
#pragma unroll
            for (int i = 0; i < 8; ++i) s[i] = va[i] * g2a + vb[i] * g2b; }
#pragma unroll
        for (int i = 0; i < 8; ++i) s[i] = wave_sum(s[i]);
        if (lane == 0) {
#pragma unroll
            for (int i = 0; i < 8; ++i) dst[i] = (bf16)f2bf(s[i]); }
    }
}
DEVI void phase_bw(const float* MOD, const float* win, float* BW2, LAS unsigned char* lds, int vcu, int G, int tid) {
    LAS float* cb = (LAS float*)lds;
    LAS float* part = cb + 8192;
    const int lane = tid & 63, wave = tid >> 6, cl = lane & 15, kq = lane >> 4;
    constexpr int NIT = NIN / 16;
    bool staged = false;
    for (int it = vcu; it < NIT; it += G) {
        if (!staged) { staged = true; __syncthreads(); const float* Bs = MOD + (size_t)3 * 8 * D;
            { float tmpc[16];
#pragma unroll
              for (int j = 0; j < 16; ++j) tmpc[j] = Bs[tid + 512 * j];
#pragma unroll
              for (int j = 0; j < 16; ++j) { const int i = tid + 512 * j, b = i >> 10, k = i & 1023; cb[k * 8 + b] = tmpc[j]; } }
            __syncthreads(); }
        float acc[8];
#pragma unroll
        for (int b = 0; b < 8; ++b) acc[b] = 0.f;
        const int kbase = wave * 128 + kq * 32; const float* wp = win + (size_t)kbase * NIN + it * 16 + cl;
#pragma nounroll
        for (int k0 = 0; k0 < 32; k0 += 16) { float wvv[16];
#pragma unroll
            for (int k = 0; k < 16; ++k) wvv[k] = wp[(size_t)(k0 + k) * NIN];
#pragma unroll
            for (int kk = 0; kk < 16; ++kk) { const float wv = wvv[kk]; const LAS f32x4* cp = (const LAS f32x4*)(cb + (kbase + k0 + kk) * 8); const f32x4 c0 = cp[0], c1 = cp[1];
                acc[0] += c0.x * wv; acc[1] += c0.y * wv; acc[2] += c0.z * wv; acc[3] += c0.w * wv; acc[4] += c1.x * wv; acc[5] += c1.y * wv; acc[6] += c1.z * wv; acc[7] += c1.w * wv; } }
#pragma unroll
        for (int b = 0; b < 8; ++b) { acc[b] += __shfl_xor(acc[b], 16); acc[b] += __shfl_xor(acc[b], 32); if (kq == 0) part[(wave * 8 + b) * 16 + cl] = acc[b]; }
        __syncthreads();
        if (tid < 128) { const int b = tid >> 4, c = tid & 15; float s = 0.f;
#pragma unroll
            for (int w = 0; w < 8; ++w) s += part[(w * 8 + b) * 16 + c];
            BW2[(size_t)b * NIN + it * 16 + c] = s; }
        __syncthreads();
    }
}
DEVI void modnorm_rows(const float* X, const float* A, const float* Bv, bf16* XN, int gw, int NGW, int lane) {
    for (int m = gw; m < M; m += NGW) {
        const GAS f32x4* xr = (const GAS f32x4*)(X + (size_t)m * D) + lane; const int b = m / SEQ;
        f32x4 v[4]; float s = 0.f;
#pragma unroll
        for (int j = 0; j < 4; ++j) { v[j] = xr[64 * j]; s += (v[j].x * v[j].x + v[j].y * v[j].y) + (v[j].z * v[j].z + v[j].w * v[j].w); }
        const float rstd = 1.0f / sqrtf(wave_sum(s) * (1.f / D) + EPS);
        const f32x4* ap = (const f32x4*)(A + (size_t)b * D) + lane; const f32x4* bp = (const f32x4*)(Bv + (size_t)b * D) + lane;
        GAS unsigned long long* o8 = (GAS unsigned long long*)(XN + (size_t)m * D) + lane;
#pragma unroll
        for (int j = 0; j < 4; ++j) { const f32x4 a = ap[64 * j], bb = bp[64 * j]; const f32x4 o = v[j] * rstd * a + bb;
            o8[64 * j] = (unsigned long long)pk2(o.x, o.y) | ((unsigned long long)pk2(o.z, o.w) << 32); }
    }
}
DEVI void final_rows(float* X, const float* w, int gw, int NGW, int lane) {
    for (int m = gw; m < M; m += NGW) {
        GAS f32x4* xr = (GAS f32x4*)(X + (size_t)m * D) + lane;
        f32x4 v[4]; float s = 0.f;
#pragma unroll
        for (int j = 0; j < 4; ++j) { v[j] = xr[64 * j]; s += (v[j].x * v[j].x + v[j].y * v[j].y) + (v[j].z * v[j].z + v[j].w * v[j].w); }
        const float rstd = 1.0f / sqrtf(wave_sum(s) * (1.f / D) + EPS);
        const f32x4* wp = (const f32x4*)w + lane;
#pragma unroll
        for (int j = 0; j < 4; ++j) xr[64 * j] = v[j] * rstd * wp[64 * j];
    }
}
DEVI void final_rows_b(const bf16* X, float* O, const float* w, int gw, int NGW, int lane) {
    constexpr int R = 4;
    f32x4 wv[4];
#pragma unroll
    for (int j = 0; j < 4; ++j) wv[j] = ((const f32x4*)w + lane)[64 * j];
    for (int m0 = gw; m0 < M; m0 += R * NGW) {
        u32x2 q[R][4];
#pragma unroll
        for (int r = 0; r < R; ++r) { const int m = m0 + r * NGW; const GAS u32x2* xr = (const GAS u32x2*)(X + (size_t)(m < M ? m : 0) * D) + lane;
#pragma unroll
            for (int j = 0; j < 4; ++j) q[r][j] = xr[64 * j]; }
#pragma unroll
        for (int r = 0; r < R; ++r) { const int m = m0 + r * NGW; if (m >= M) break; GAS f32x4* orow = (GAS f32x4*)(O + (size_t)m * D) + lane; f32x4 v[4]; float s = 0.f;
#pragma unroll
            for (int j = 0; j < 4; ++j) { v[j] = (f32x4){bflo(q[r][j].x), bfhi(q[r][j].x), bflo(q[r][j].y), bfhi(q[r][j].y)}; s += (v[j].x * v[j].x + v[j].y * v[j].y) + (v[j].z * v[j].z + v[j].w * v[j].w); }
            const float rstd = 1.0f / sqrtf(wave_sum(s) * (1.f / D) + EPS);
#pragma unroll
            for (int j = 0; j < 4; ++j) __builtin_nontemporal_store(v[j] * rstd * wv[j], orow + 64 * j); }
    }
}
DEVI void catnorm_rows(bf16* CAT, const float* w, int gw, int NGW, int lane) {
    constexpr int R = 8;
    const f32x4 w0 = ((const f32x4*)w)[2 * lane], w1 = ((const f32x4*)w)[2 * lane + 1];
    for (int m0 = gw; m0 < M; m0 += R * NGW) {
        v4u q[R];
#pragma unroll
        for (int r = 0; r < R; ++r) { const int m = m0 + r * NGW; q[r] = *((const GAS v4u*)(CAT + (size_t)(m < M ? m : 0) * D) + lane); }
#pragma unroll
        for (int r = 0; r < R; ++r) { const int m = m0 + r * NGW; if (m >= M) break;
            float f[8] = {bflo(q[r].x), bfhi(q[r].x), bflo(q[r].y), bfhi(q[r].y), bflo(q[r].z), bfhi(q[r].z), bflo(q[r].w), bfhi(q[r].w)};
            float s = 0.f;
#pragma unroll
            for (int j = 0; j < 8; ++j) s += f[j] * f[j];
            const float rstd = 1.0f / sqrtf(wave_sum(s) * (1.f / AW) + EPS);
            v4u o; o.x = pk2(f[0] * rstd * w0.x, f[1] * rstd * w0.y); o.y = pk2(f[2] * rstd * w0.z, f[3] * rstd * w0.w);
            o.z = pk2(f[4] * rstd * w1.x, f[5] * rstd * w1.y); o.w = pk2(f[6] * rstd * w1.z, f[7] * rstd * w1.w);
            *((GAS v4u*)(CAT + (size_t)m * D) + lane) = o; }
    }
}

DEVI void phase_kmean(const bf16* K, float* KMP, LAS unsigned char* lds, int vcu, int G, int tid) {
    LAS float* red = (LAS float*)lds;
    const int c4 = tid & 127, rl = tid >> 7;
    for (int u = vcu; u < BATCH * NB * 4; u += G) {
        const int part = u & 3, bn = u >> 2, b = bn / NB, n = bn % NB;
        const bf16* kp = K + ((size_t)b * SEQ + n * 256 + part * 64 + rl) * AW + 4 * c4;
        u32x2 w[16];
#pragma unroll
        for (int r = 0; r < 16; ++r) w[r] = *(const u32x2*)(kp + (size_t)(4 * r) * AW);
        f32x4 s = (f32x4){0.f, 0.f, 0.f, 0.f};
#pragma unroll
        for (int r = 0; r < 16; ++r) s += (f32x4){bflo(w[r].x), bfhi(w[r].x), bflo(w[r].y), bfhi(w[r].y)};
        __syncthreads();
        *(LAS f32x4*)(red + rl * 512 + 4 * c4) = s;
        __syncthreads();
        const float t = (red[tid] + red[512 + tid]) + (red[1024 + tid] + red[1536 + tid]);
        KMP[((((size_t)part * BATCH + b) * AHN + (tid >> 6)) * NB + n) * 64 + (tid & 63)] = t * (1.0f / 256.0f);
    }
    __syncthreads();
}
DEVI void phase_topk(const bf16* Q, const float* KMEAN, unsigned short* SEL, LAS unsigned char* lds, int vcu, int G, int tid) {
    LAS float* km = (LAS float*)lds;
    for (int u = vcu; u < BATCH * AHN * 4; u += G) {
        const int bh = u >> 2, qtr = u & 3, b = bh / AHN, h = bh % AHN;
        __syncthreads();
        for (int i = tid; i < NB * 64; i += 512) { const float* kq = KMEAN + (size_t)bh * NB * 64 + i; constexpr size_t PS = (size_t)BATCH * AHN * NB * 64; km[i] = (kq[0] + kq[PS]) + (kq[2 * PS] + kq[3 * PS]); }
        __syncthreads();
        for (int it = 0; it < 2; ++it) {
            const int s = qtr * 1024 + it * 512 + tid, bq = s >> 8;
            const v4u* qp = (const v4u*)(Q + ((size_t)b * SEQ + s) * AW + h * 64);
            float q[64];
#pragma unroll
            for (int c = 0; c < 8; ++c) { const v4u w = qp[c]; q[8 * c] = bflo(w.x); q[8 * c + 1] = bfhi(w.x); q[8 * c + 2] = bflo(w.y); q[8 * c + 3] = bfhi(w.y);
                q[8 * c + 4] = bflo(w.z); q[8 * c + 5] = bfhi(w.z); q[8 * c + 6] = bflo(w.w); q[8 * c + 7] = bfhi(w.w); }
            float v1 = -INFINITY, v2 = -INFINITY, v3 = -INFINITY; int i1 = -1, i2 = -1, i3 = -1;
            for (int n = 0; n < bq; ++n) {
                float g = 0.f;
#pragma unroll
                for (int d = 0; d < 64; ++d) g += q[d] * km[n * 64 + d];
                if (g > v1) { v3 = v2; i3 = i2; v2 = v1; i2 = i1; v1 = g; i1 = n; }
                else if (g > v2) { v3 = v2; i3 = i2; v2 = g; i2 = n; }
                else if (g > v3) { v3 = g; i3 = n; }
            }
            unsigned mk = 0u; if (i1 >= 0) mk |= 1u << i1; if (i2 >= 0) mk |= 1u << i2; if (i3 >= 0) mk |= 1u << i3;
            SEL[(size_t)bh * SEQ + s] = (unsigned short)mk;
        }
    }
}
DEVI unsigned pkbf(float lo, float hi) { return pk2(lo, hi); }
constexpr int ST128 = 272, ST64 = 144;
DEVI void mlstm_pre_phase(const bf16* XM, const float* conv_w, const float* conv_b, const bf16* WQ, const bf16* WK, const bf16* WV, const bf16* WEC, const bf16* WEM,
                          bf16* XC, bf16* QM, bf16* KM, bf16* KMT, bf16* VMT, float* GP, LAS unsigned char* lds, int vcu, int G, int tid) {
    const int lane = tid & 63, wave = __builtin_amdgcn_readfirstlane(tid >> 6), e0 = wave * 16, lr = lane & 15, lg = lane >> 4;
    LAS unsigned char* XmI = lds;
    LAS unsigned char* XcI = lds + 68 * ST128;
    LAS float* cw = (LAS float*)(lds + 132 * ST128);
    constexpr int NU = (M / 64) * MH;
    int u = vcu; if (u >= NU) return;
    v4u pf[3];
#define PRE_PF(uu) do { const int R0_ = ((uu) >> 2) * 64, h_ = (uu) & 3; const bool z_ = (R0_ % SEQ) == 0; _Pragma("unroll") for (int i = 0; i < 3; ++i) { const int ch = tid + 512 * i, ir = ch >> 4, cc = ch & 15; \
        pf[i] = (v4u){0u, 0u, 0u, 0u}; if (ch < 67 * 16 && (ir >= 3 || !z_)) pf[i] = *(const v4u*)(XM + (size_t)(R0_ - 3 + ir) * MW + h_ * MHD + cc * 8); } } while (0)
    PRE_PF(u);
    int hcur = -1; bf16x8 wq[4], wk[4], wv[4], wgc[4], wgm[4];
    for (; u < NU; u += G) {
        const int tt = u >> 2, h = u & 3, R0 = tt * 64, t0 = R0 % SEQ, b = R0 / SEQ;
        if (h != hcur) { hcur = h;
#pragma unroll
            for (int ks = 0; ks < 4; ++ks) { const size_t o = ((size_t)(h * MHD + e0 + lr)) * MHD + 32 * ks + 8 * lg; wq[ks] = *(const bf16x8*)(WQ + o); wk[ks] = *(const bf16x8*)(WK + o); wv[ks] = *(const bf16x8*)(WV + o); const size_t og = ((size_t)(h * 16 + lr)) * MHD + 32 * ks + 8 * lg; wgc[ks] = *(const bf16x8*)(WEC + og); wgm[ks] = *(const bf16x8*)(WEM + og); }
            for (int i = tid; i < 5 * 128; i += 512) cw[i] = (i < 512) ? conv_w[(i >> 7) * MW + h * MHD + (i & 127)] : conv_b[h * MHD + (i & 127)]; }
#pragma unroll
        for (int i = 0; i < 3; ++i) { const int ch = tid + 512 * i, ir = ch >> 4, cc = ch & 15; if (ch < 67 * 16) *(LAS v4u*)(XmI + ir * ST128 + cc * 16) = pf[i]; }
        __syncthreads();
        if (u + G < NU) PRE_PF(u + G);
        { const int t = tid >> 3, c0 = (tid & 7) * 8;
#pragma unroll
          for (int hf = 0; hf < 2; ++hf) { const int cb = c0 + 64 * hf; float a[8];
              { const f32x4 b0 = *(const LAS f32x4*)(cw + 512 + cb), b1 = *(const LAS f32x4*)(cw + 512 + cb + 4); a[0] = b0.x; a[1] = b0.y; a[2] = b0.z; a[3] = b0.w; a[4] = b1.x; a[5] = b1.y; a[6] = b1.z; a[7] = b1.w; }
#pragma unroll
              for (int j4 = 0; j4 < 4; ++j4) { const v4u xv = *(const LAS v4u*)(XmI + (t + j4) * ST128 + cb * 2); const f32x4 w0 = *(const LAS f32x4*)(cw + j4 * 128 + cb), w1 = *(const LAS f32x4*)(cw + j4 * 128 + cb + 4);
                  a[0] += w0.x * bflo(xv.x); a[1] += w0.y * bfhi(xv.x); a[2] += w0.z * bflo(xv.y); a[3] += w0.w * bfhi(xv.y);
                  a[4] += w1.x * bflo(xv.z); a[5] += w1.y * bfhi(xv.z); a[6] += w1.z * bflo(xv.w); a[7] += w1.w * bfhi(xv.w); }
#pragma unroll
              for (int j = 0; j < 8; ++j) a[j] = silu_f(a[j]);
              v4u o; o.x = pkbf(a[0], a[1]); o.y = pkbf(a[2], a[3]); o.z = pkbf(a[4], a[5]); o.w = pkbf(a[6], a[7]);
              *(LAS v4u*)(XcI + t * ST128 + cb * 2) = o; *(v4u*)(XC + (size_t)(R0 + t) * MW + h * MHD + cb) = o; } }
        __syncthreads();
        f32x4 aQ[4], aK[4], aKT[4], aVT[4];
#pragma unroll
        for (int i = 0; i < 4; ++i) { aQ[i] = (f32x4){0.f, 0.f, 0.f, 0.f}; aK[i] = aQ[i]; aKT[i] = aQ[i]; aVT[i] = aQ[i]; }
#pragma unroll
        for (int t4 = 0; t4 < 4; ++t4)
#pragma unroll
            for (int ks = 0; ks < 4; ++ks) { const bf16x8 xc = ldfrag(XcI, ST128, 16 * t4, 32 * ks, lane), xm = ldfrag(XmI, ST128, 16 * t4 + 3, 32 * ks, lane);
                aQ[t4] = MMA16(wq[ks], xc, aQ[t4]); aK[t4] = MMA16(wk[ks], xc, aK[t4]); aKT[t4] = MMA16(xc, wk[ks], aKT[t4]); aVT[t4] = MMA16(xm, wv[ks], aVT[t4]); }
        if (wave < 4) {
            f32x4 aG = (f32x4){0.f, 0.f, 0.f, 0.f};
#pragma unroll
            for (int ks = 0; ks < 4; ++ks) {
                const bf16x8 xc = ldfrag(XcI, ST128, 16 * wave, 32 * ks, lane), xm = ldfrag(XmI, ST128, 16 * wave + 3, 32 * ks, lane);
                aG = MMA16(wgc[ks], xc, aG); aG = MMA16(wgm[ks], xm, aG); }
            if (lg < 2) *(f32x4*)(GP + (size_t)(R0 + 16 * wave + lr) * 32 + h * 8 + 4 * lg) = aG;
        }
        LAS unsigned char* QS = lds + 40960; LAS unsigned char* KS = QS + 64 * ST128; LAS unsigned char* KTS = KS + 64 * ST128; LAS unsigned char* VTS = KTS + 128 * ST64;
#pragma unroll
        for (int t4 = 0; t4 < 4; ++t4) {
            { const int o = (16 * t4 + lr) * ST128 + (e0 + 4 * lg) * 2;
              *(LAS u32x2*)(QS + o) = (u32x2){pkbf(aQ[t4][0], aQ[t4][1]), pkbf(aQ[t4][2], aQ[t4][3])};
              *(LAS u32x2*)(KS + o) = (u32x2){pkbf(aK[t4][0], aK[t4][1]), pkbf(aK[t4][2], aK[t4][3])}; }
            { const int o = (e0 + lr) * ST64 + (16 * t4 + 4 * lg) * 2;
              *(LAS u32x2*)(KTS + o) = (u32x2){pkbf(aKT[t4][0], aKT[t4][1]), pkbf(aKT[t4][2], aKT[t4][3])};
              *(LAS u32x2*)(VTS + o) = (u32x2){pkbf(aVT[t4][0], aVT[t4][1]), pkbf(aVT[t4][2], aVT[t4][3])}; }
        }
        __syncthreads();
        const size_t cbase = ((size_t)((b * MH + h) * 64 + (t0 >> 6))) * (MHD * 64);
#pragma unroll
        for (int i = 0; i < 2; ++i) { const int ch = tid + 512 * i;
            { const int row = ch >> 4, cc = ch & 15; const size_t o = (size_t)(R0 + row) * MW + h * MHD + cc * 8;
              *(v4u*)(QM + o) = *(const LAS v4u*)(QS + row * ST128 + cc * 16); *(v4u*)(KM + o) = *(const LAS v4u*)(KS + row * ST128 + cc * 16); }
            { const int row = ch >> 3, cc = ch & 7; const size_t o = cbase + (size_t)row * 64 + cc * 8;
              *(v4u*)(KMT + o) = *(const LAS v4u*)(KTS + row * ST64 + cc * 16); *(v4u*)(VMT + o) = *(const LAS v4u*)(VTS + row * ST64 + cc * 16); } }
        __syncthreads();
    }
#undef PRE_PF
}
constexpr int L_QI = 0, L_KI = L_QI + 64 * ST128, L_KTW = L_KI + 64 * ST128, L_VTI = L_KTW + 128 * ST64, L_PI = L_VTI + SV * ST64, L_SI = L_PI + 64 * ST64, L_MISC = L_SI + SV * ST128;
constexpr int GJW = 264, MS_DEN = 4 * GJW, MS_LN1 = MS_DEN + 64, MS_LN2 = MS_LN1 + 128, MS_END = MS_LN2 + 128;
static_assert(L_MISC + MS_END * 4 <= RING_BYTES, "mLSTM LDS map");
DEVI void mlstm_gates4(const float* GP, const float* b_if, size_t row_sc, int h, LAS float* misc, int wave, int lane) {
    if (wave < 4) { const int t = lane; LAS float* gj = misc + wave * GJW; const float* gp = GP + (row_sc + wave * 64 + t) * 32; float ip = b_if[h], fp = b_if[4 + h]; float gvi[4], gvf[4];
#pragma unroll
        for (int hh = 0; hh < 4; ++hh) { gvi[hh] = gp[hh * 8 + h]; gvf[hh] = gp[hh * 8 + 4 + h]; }
        asm volatile("" : "+v"(gvi[0]), "+v"(gvi[1]), "+v"(gvi[2]), "+v"(gvi[3]), "+v"(gvf[0]), "+v"(gvf[1]), "+v"(gvf[2]), "+v"(gvf[3]));
#pragma unroll
        for (int hh = 0; hh < 4; ++hh) { ip += gvi[hh]; fp += gvf[hh]; }
        const float lf = fminf(fp, 0.f) - log1pf(expf(-fabsf(fp)));
        float F = lf;
#pragma unroll
        for (int o = 1; o < 64; o <<= 1) { const float v = __shfl_up(F, o); if (t >= o) F += v; }
        const float Fend = __shfl(F, 63);
        gj[t] = F; gj[64 + t] = ip - F; gj[128 + t] = expf(Fend - F + ip); gj[192 + t] = expf(F);
        if (t == 0) { gj[256] = expf(Fend); gj[257] = Fend; } }
}
DEVI void ones_rows(LAS unsigned char* VTi, int tid) {
    for (int ch = tid; ch < 16 * 8; ch += 512) { const int r = ch >> 3, cc = ch & 7; const unsigned w = (r == 0) ? 0x3f803f80u : 0u; *(LAS v4u*)(VTi + (128 + r) * ST64 + cc * 16) = (v4u){w, w, w, w}; }
}
#define T_LOAD(dst, src) do { _Pragma("unroll") for (int i_ = 0; i_ < 2; ++i_) { const int ch_ = tid + 512 * i_; dst[i_] = *(const v4u*)((src) + (size_t)(ch_ >> 3) * 64 + (ch_ & 7) * 8); } } while (0)
#define T_LOAD_NT(dst, src) do { _Pragma("unroll") for (int i_ = 0; i_ < 2; ++i_) { const int ch_ = tid + 512 * i_; dst[i_] = __builtin_nontemporal_load((const v4u*)((src) + (size_t)(ch_ >> 3) * 64 + (ch_ & 7) * 8)); } } while (0)
#define VPOS(v_) (((v_) & 64) | (((v_) & 12) << 2) | (((v_) >> 2) & 12) | ((v_) & 3))
#define T_STORE_P(img, regs) do { _Pragma("unroll") for (int i_ = 0; i_ < 2; ++i_) { const int ch_ = tid + 512 * i_; *(LAS v4u*)((img) + VPOS(ch_ >> 3) * ST64 + (ch_ & 7) * 16) = regs[i_]; } } while (0)
#define T_STORE(img, regs) do { _Pragma("unroll") for (int i_ = 0; i_ < 2; ++i_) { const int ch_ = tid + 512 * i_; *(LAS v4u*)((img) + (ch_ >> 3) * ST64 + (ch_ & 7) * 16) = regs[i_]; } } while (0)
#define T_STORE_SCALED(img, regs, wS) do { _Pragma("unroll") for (int i_ = 0; i_ < 2; ++i_) { const int ch_ = tid + 512 * i_; const LAS float* w_ = (wS) + (ch_ & 7) * 8; v4u v_ = regs[i_]; \
        v_.x = pkbf(bflo(v_.x) * w_[0], bfhi(v_.x) * w_[1]); v_.y = pkbf(bflo(v_.y) * w_[2], bfhi(v_.y) * w_[3]); v_.z = pkbf(bflo(v_.z) * w_[4], bfhi(v_.z) * w_[5]); v_.w = pkbf(bflo(v_.w) * w_[6], bfhi(v_.w) * w_[7]); \
        *(LAS v4u*)((img) + (ch_ >> 3) * ST64 + (ch_ & 7) * 16) = v_; } } while (0)
#define R_LOAD(dst, src) do { _Pragma("unroll") for (int i_ = 0; i_ < 2; ++i_) { const int ch_ = tid + 512 * i_; dst[i_] = *(const v4u*)((src) + (size_t)(ch_ >> 4) * MW + (ch_ & 15) * 8); } } while (0)
#define R_LOAD_NT(dst, src) do { _Pragma("unroll") for (int i_ = 0; i_ < 2; ++i_) { const int ch_ = tid + 512 * i_; dst[i_] = __builtin_nontemporal_load((const v4u*)((src) + (size_t)(ch_ >> 4) * MW + (ch_ & 15) * 8)); } } while (0)
#define R_STORE(img, regs) do { _Pragma("unroll") for (int i_ = 0; i_ < 2; ++i_) { const int ch_ = tid + 512 * i_; *(LAS v4u*)((img) + (ch_ >> 4) * ST128 + (ch_ & 15) * 16) = regs[i_]; } } while (0)
DEVI void state_update(f32x4 (&accS)[9], const LAS unsigned char* lds, float g, int wave, int lane) {
    const bf16x8 k0 = ldfrag(lds + L_KTW, ST64, 16 * wave, 0, lane), k1 = ldfrag(lds + L_KTW, ST64, 16 * wave, 32, lane);
    bf16x8 f[2][6];
#pragma unroll
    for (int q = 0; q < 3; ++q) { f[0][2 * q] = ldfrag(lds + L_VTI, ST64, 16 * q, 0, lane); f[0][2 * q + 1] = ldfrag(lds + L_VTI, ST64, 16 * q, 32, lane); }
#pragma unroll
    for (int vt = 0; vt < 9; ++vt) accS[vt] = accS[vt] * g;
    __builtin_amdgcn_sched_barrier(0);
    asm volatile("s_nop 15\n\ts_nop 15" : "+v"(accS[0]), "+v"(accS[1]), "+v"(accS[2]), "+v"(accS[3]), "+v"(accS[4]), "+v"(accS[5]), "+v"(accS[6]), "+v"(accS[7]), "+v"(accS[8]));
    __builtin_amdgcn_sched_barrier(0);
#pragma unroll
    for (int grp = 0; grp < 3; ++grp) {
        if (grp < 2) {
#pragma unroll
            for (int q = 0; q < 3; ++q) { const int vt = 3 * (grp + 1) + q; f[(grp + 1) & 1][2 * q] = ldfrag(lds + L_VTI, ST64, 16 * vt, 0, lane); f[(grp + 1) & 1][2 * q + 1] = ldfrag(lds + L_VTI, ST64, 16 * vt, 32, lane); } }
#pragma unroll
        for (int q = 0; q < 3; ++q) { const int vt = 3 * grp + q; accS[vt] = MMA16(k0, f[grp & 1][2 * q], accS[vt]); accS[vt] = MMA16(k1, f[grp & 1][2 * q + 1], accS[vt]); }
    }
}
DEVI void mlstm_chunkstate_phase(const bf16* KMT, const bf16* VMT, const float* GP, const float* b_if, float* DST, float* GSUP, LAS unsigned char* lds, int vcu, int G, int tid) {
    const int lane = tid & 63, wave = __builtin_amdgcn_readfirstlane(tid >> 6);
    LAS float* misc = (LAS float*)(lds + L_MISC);
    constexpr int NU = BATCH * MH * 16;
    int u = vcu; if (u >= NU) return;
    v4u kt[2], vt[2];
    { const size_t cb0 = ((size_t)((u >> 4) * 64 + (u & 15) * 4)) * (MHD * 64); T_LOAD(kt, KMT + cb0); T_LOAD(vt, VMT + cb0); }
    for (; u < NU; u += G) {
        const int bh = u >> 4, sc = u & 15, b = bh / MH, h = bh % MH;
        f32x4 accS[9];
#pragma unroll
        for (int i = 0; i < 9; ++i) accS[i] = (f32x4){0.f, 0.f, 0.f, 0.f};
        ones_rows(lds + L_VTI, tid);
        mlstm_gates4(GP, b_if, (size_t)b * SEQ + (size_t)sc * 256, h, misc, wave, lane);
        __syncthreads();
        float Ftot = 0.f;
        for (int j = 0; j < 4; ++j) {
            const LAS float* gj = misc + j * GJW;
            T_STORE_SCALED(lds + L_KTW, kt, gj + 128); T_STORE_P(lds + L_VTI, vt);
            __syncthreads();
            { int un = u, jn = j + 1; if (jn == 4) { jn = 0; un = u + G; }
              if (un < NU) { const size_t cbn = ((size_t)((un >> 4) * 64 + (un & 15) * 4 + jn)) * (MHD * 64); T_LOAD(kt, KMT + cbn); T_LOAD(vt, VMT + cbn); } }
            state_update(accS, lds, gj[256], wave, lane); Ftot += gj[257];
            __syncthreads();
        }
        const size_t ub = ((size_t)(bh * 16 + sc)) * (SV * MHD);
#pragma unroll
        for (int vt2 = 0; vt2 < 9; ++vt2) *(f32x4*)(DST + ub + (size_t)(16 * vt2 + (lane & 15)) * MHD + 16 * wave + 4 * (lane >> 4)) = accS[vt2];
        if (tid == 0) GSUP[bh * 16 + sc] = expf(Ftot);
    }
}
DEVI void phase_scan(const float* DST, const float* GSUP, bf16* SST, int gtid, int NT_) {
    constexpr int E = SV * MHD;
    for (int e2 = gtid; e2 < BATCH * MH * E / 2; e2 += NT_) { const int bh = (2 * e2) / E, idx = (2 * e2) % E;
        f32x2 d[15]; float g[15];
#pragma unroll
        for (int c = 0; c < 15; ++c) { d[c] = *(const f32x2*)(DST + ((size_t)(bh * 16 + c)) * E + idx); g[c] = GSUP[bh * 16 + c]; }
        f32x2 s = (f32x2){0.f, 0.f};
#pragma unroll
        for (int c = 0; c < 16; ++c) { *(unsigned*)(SST + ((size_t)(bh * 16 + c)) * E + idx) = pk2(s.x, s.y); if (c < 15) s = s * g[c] + d[c]; } }
}
DEVI void mlstm_out_phase(const bf16* QM, const bf16* KM, const bf16* KMT, const bf16* VMT, const float* GP, const float* b_if, const bf16* SST,
                          const bf16* XC, const bf16* Z, const float* normw, const float* skipw, bf16* CAT, LAS unsigned char* lds, int vcu, int G, int tid) {
    const int lane = tid & 63, wave = __builtin_amdgcn_readfirstlane(tid >> 6), lr = lane & 15, lg = lane >> 4;
    LAS float* misc = (LAS float*)(lds + L_MISC);
    constexpr int NU = BATCH * MH * 16;
    int u = vcu; if (u >= NU) return;
    v4u qr[2], kr[2], kt[2], vt[2];
#define OUT_PF(uu, jj) do { const int bh_ = (uu) >> 4, ck_ = ((uu) & 15) * 4 + (jj); const size_t row_ = (size_t)(bh_ / MH) * SEQ + (size_t)ck_ * 64, cb_ = ((size_t)(bh_ * 64 + ck_)) * (MHD * 64); \
        R_LOAD_NT(qr, QM + row_ * MW + (bh_ % MH) * MHD); R_LOAD_NT(kr, KM + row_ * MW + (bh_ % MH) * MHD); T_LOAD_NT(kt, KMT + cb_); T_LOAD_NT(vt, VMT + cb_); } while (0)
    OUT_PF(u, 0);
    for (; u < NU; u += G) {
        const int bh = u >> 4, sc = u & 15, b = bh / MH, h = bh % MH;
        const size_t ub = ((size_t)(bh * 16 + sc)) * (SV * MHD);
        f32x4 accS[9];
#pragma unroll
        for (int vt2 = 0; vt2 < 9; ++vt2) { const u32x2 w = *(const u32x2*)(SST + ub + (size_t)(16 * vt2 + lr) * MHD + 16 * wave + 4 * lg); accS[vt2] = (f32x4){bflo(w.x), bfhi(w.x), bflo(w.y), bfhi(w.y)}; }
        { v4u sfill[5];
#pragma unroll
          for (int i = 0; i < 5; ++i) { const int ch = tid + 512 * i; sfill[i] = (v4u){0u, 0u, 0u, 0u}; if (ch < SV * 16) sfill[i] = *(const v4u*)(SST + ub + (size_t)(ch >> 4) * MHD + (ch & 15) * 8); }
          asm volatile("" : "+v"(sfill[0]), "+v"(sfill[1]), "+v"(sfill[2]), "+v"(sfill[3]), "+v"(sfill[4]));
#pragma unroll
          for (int i = 0; i < 5; ++i) { const int ch = tid + 512 * i; if (ch < SV * 16) *(LAS v4u*)(lds + L_SI + (ch >> 4) * ST128 + (ch & 15) * 16) = sfill[i]; } }
        ones_rows(lds + L_VTI, tid);
        mlstm_gates4(GP, b_if, (size_t)b * SEQ + (size_t)sc * 256, h, misc, wave, lane);
        __syncthreads();
        for (int j = 0; j < 4; ++j) {
            const int ck = sc * 4 + j; const size_t row0 = (size_t)b * SEQ + (size_t)ck * 64; const LAS float* gj = misc + j * GJW;
            R_STORE(lds + L_QI, qr); R_STORE(lds + L_KI, kr); T_STORE_P(lds + L_VTI, vt); T_STORE_SCALED(lds + L_KTW, kt, gj + 128);
            __syncthreads();
            asm volatile("s_waitcnt vmcnt(0)" ::: "memory");
            u32x2 xcw[4], zw[4];
            { const int tt_ = wave & 3, hf_ = wave >> 2; const size_t ro = row0 + 16 * tt_ + lr; const int col = h * MHD + 64 * hf_ + 16 * lg;
              const v4u x0 = *(const v4u*)(XC + ro * MW + col), x1 = *(const v4u*)(XC + ro * MW + col + 8);
              const v4u z0 = *(const v4u*)(Z + ro * MW + col), z1 = *(const v4u*)(Z + ro * MW + col + 8);
              xcw[0] = (u32x2){x0.x, x0.y}; xcw[1] = (u32x2){x0.z, x0.w}; xcw[2] = (u32x2){x1.x, x1.y}; xcw[3] = (u32x2){x1.z, x1.w};
              zw[0] = (u32x2){z0.x, z0.y}; zw[1] = (u32x2){z0.z, z0.w}; zw[2] = (u32x2){z1.x, z1.y}; zw[3] = (u32x2){z1.z, z1.w}; }
            { int un = u, jn = j + 1; if (jn == 4) { jn = 0; un = u + G; } if (un < NU) OUT_PF(un, jn); }
            { const int tt = wave >> 1, t = 16 * tt + lr; const float Ft = gj[t];
#pragma unroll
              for (int q2 = 0; q2 < 2; ++q2) { const int st = 2 * (wave & 1) + q2; f32x4 a = (f32x4){0.f, 0.f, 0.f, 0.f};
                  if (st <= tt) {
#pragma unroll
                      for (int ks = 0; ks < 4; ++ks) a = MMA16(ldfrag(lds + L_KI, ST128, 16 * st, 32 * ks, lane), ldfrag(lds + L_QI, ST128, 16 * tt, 32 * ks, lane), a);
#pragma unroll
                      for (int r = 0; r < 4; ++r) { const int s = 16 * st + 4 * lg + r; a[r] = (s <= t) ? a[r] * __builtin_amdgcn_exp2f((Ft + gj[64 + s]) * 1.4426950408889634f) : 0.f; } }
                  *(LAS u32x2*)(lds + L_PI + t * ST64 + (16 * st + 4 * lg) * 2) = (u32x2){pkbf(a[0], a[1]), pkbf(a[2], a[3])}; } }
            __syncthreads();
            const int tt = wave & 3, hf = wave >> 2, t = 16 * tt + lr; const float aT = gj[192 + t];
            f32x4 num[5];
            { bf16x8 pfr[2], qfr[4];
#pragma unroll
              for (int ks = 0; ks < 2; ++ks) pfr[ks] = ldfrag(lds + L_PI, ST64, 16 * tt, 32 * ks, lane);
#pragma unroll
              for (int ks = 0; ks < 4; ++ks) qfr[ks] = ldfrag(lds + L_QI, ST128, 16 * tt, 32 * ks, lane);
#pragma unroll
              for (int i = 0; i < 5; ++i) { const int vt2 = (i < 4) ? (4 * hf + i) : 8; f32x4 aI = (f32x4){0.f, 0.f, 0.f, 0.f}, aX = aI;
                if (i < 4 || hf == 0) { bf16x8 f[6];
#pragma unroll
                    for (int ks = 0; ks < 2; ++ks) f[ks] = ldfrag(lds + L_VTI, ST64, 16 * vt2, 32 * ks, lane);
#pragma unroll
                    for (int ks = 0; ks < 4; ++ks) f[2 + ks] = ldfrag(lds + L_SI, ST128, 16 * vt2, 32 * ks, lane);
#pragma unroll
                    for (int ks = 0; ks < 2; ++ks) aI = MMA16(f[ks], pfr[ks], aI);
#pragma unroll
                    for (int ks = 0; ks < 4; ++ks) aX = MMA16(f[2 + ks], qfr[ks], aX); }
                num[i] = aI + aX * aT; } }
            state_update(accS, lds, gj[256], wave, lane);
            if (hf == 0 && lg == 0) misc[MS_DEN + t] = num[4][0];
            __syncthreads();
            { const float dinv = 1.0f / fmaxf(fabsf(misc[MS_DEN + t]), 1.0f); float s1 = 0.f, s2 = 0.f;
#pragma unroll
              for (int i = 0; i < 4; ++i) { num[i] = num[i] * dinv; s1 += (num[i][0] + num[i][1]) + (num[i][2] + num[i][3]); s2 += (num[i][0] * num[i][0] + num[i][1] * num[i][1]) + (num[i][2] * num[i][2] + num[i][3] * num[i][3]); }
              s1 += __shfl_xor(s1, 16); s1 += __shfl_xor(s1, 32); s2 += __shfl_xor(s2, 16); s2 += __shfl_xor(s2, 32);
              if (lg == 0) { misc[MS_LN1 + hf * 64 + t] = s1; misc[MS_LN2 + hf * 64 + t] = s2; } }
            __syncthreads();
            { const float mean = (misc[MS_LN1 + t] + misc[MS_LN1 + 64 + t]) * (1.0f / MHD), var = (misc[MS_LN2 + t] + misc[MS_LN2 + 64 + t]) * (1.0f / MHD) - mean * mean, rstd = 1.0f / sqrtf(fmaxf(var, 0.f) + EPS);
              u32x2 opk[4]; const size_t ro = row0 + t;
#pragma unroll
              for (int i = 0; i < 4; ++i) { const int v = 64 * hf + 16 * lg + 4 * i, col = h * MHD + v;
                  const f32x4 nw = *(const f32x4*)(normw + col), sw = *(const f32x4*)(skipw + col);
                  const float xc[4] = {bflo(xcw[i].x), bfhi(xcw[i].x), bflo(xcw[i].y), bfhi(xcw[i].y)}, zz[4] = {bflo(zw[i].x), bfhi(zw[i].x), bflo(zw[i].y), bfhi(zw[i].y)}; float o[4];
#pragma unroll
                  for (int r = 0; r < 4; ++r) { const float hn = (num[i][r] - mean) * rstd * nw[r]; o[r] = (hn + sw[r] * xc[r]) * silu_f(zz[r]); }
                  opk[i] = (u32x2){pkbf(o[0], o[1]), pkbf(o[2], o[3])}; }
              { bf16* cp = CAT + ro * D + AW + h * MHD + 64 * hf + 16 * lg; *(v4u*)cp = (v4u){opk[0].x, opk[0].y, opk[1].x, opk[1].y}; *(v4u*)(cp + 8) = (v4u){opk[2].x, opk[2].y, opk[3].x, opk[3].y}; } }
            if (j < 3) {

#pragma unroll
                for (int vt2 = 0; vt2 < 9; ++vt2) *(LAS u32x2*)(lds + L_SI + (16 * vt2 + lr) * ST128 + (16 * wave + 4 * lg) * 2) = (u32x2){pkbf(accS[vt2][0], accS[vt2][1]), pkbf(accS[vt2][2], accS[vt2][3])};
            }
        }
        __syncthreads();
    }
#undef OUT_PF
}
#ifndef DUP_MLSTM
#define DUP_MLSTM 0
#endif
#ifndef DUP_ATTN
#define DUP_ATTN 0
#endif
#ifndef MK_PER_PHASE
#define MK_PER_PHASE 0
#endif
#ifndef EV_ON
#define EV_ON (!MK_PER_PHASE)
#endif
constexpr int NPHASE = 14;
struct Args { const float* in[26]; float* out; unsigned char* ws; int ph_lo, ph_hi; };
typedef const __attribute__((address_space(4))) Args* KArgs;
DEVI KArgs ka_fresh() { KArgs p = (KArgs)__builtin_amdgcn_kernarg_segment_ptr(); asm volatile("" : "+s"(p)); return p; }
DEVI int tid_fresh() { int t = threadIdx.x; asm volatile("" : "+v"(t)); return t; }
#define WSP(off) (A_->ws + (off))
__global__ void __launch_bounds__(NWAVES * 64, 2) mk_fwd(Args args) {
    extern __shared__ __attribute__((aligned(16))) unsigned char lds_raw[];
    LAS unsigned char* lds = (LAS unsigned char*)lds_raw;
    volatile LAS unsigned* MISC = (volatile LAS unsigned*)(lds + MISC_OFF);
    const int G = gridDim.x; const int bx = blockIdx.x; const int vcu = (G % 8 == 0) ? (bx % 8) * (G / 8) + bx / 8 : bx;
    { const int tid = threadIdx.x; for (int u = tid; u < (LDS_BYTES - LDSCTL_OFF) / 4; u += NWAVES * 64) ((LAS unsigned*)(lds + LDSCTL_OFF))[u] = 0u; }
    __syncthreads();
    XcdBarrier bar; { gu32* ctl = (gu32*)(args.ws + WS_CTL); bar.bar = (unsigned*)(ctl + CW_BAR); bar.x = 0; bar.st = nullptr;
        if (!MK_PER_PHASE) bar = xcd_barrier_post((unsigned*)(ctl + CW_BAR), MISC + 8); }
    const int lo = args.ph_lo, hi = args.ph_hi;
#ifndef DBG_SKIP_LO
#define DBG_SKIP_LO 99
#define DBG_SKIP_HI 99
#endif
#define IN(k) (lo <= (k) && (k) < hi && !((k) >= DBG_SKIP_LO && (k) < DBG_SKIP_HI))
#define SEAM(k) do { if (IN(k) && IN((k) + 1)) xcd_barrier(bar); } while (0)
#define PHASE_VARS const KArgs A_ = ka_fresh(); const int tid = tid_fresh(), lane = tid & 63, wave = __builtin_amdgcn_readfirstlane(tid >> 6); \
    const int gw = vcu * NWAVES + wave, NGW = G * NWAVES, gtid = vcu * (NWAVES * 64) + tid, NTH = G * NWAVES * 64; (void)lane; (void)gw; (void)NGW; (void)gtid; (void)NTH; (void)A_

    const bool EVF = EV_ON && lo == 0 && hi == NPHASE;
#define WFILL(lo_, hi_) do { WPtrs P_{A_->in[5], A_->in[6], A_->in[7], A_->in[22], A_->in[23], A_->in[24], A_->in[9], A_->in[20], A_->in[12], A_->in[13], A_->in[14], A_->in[15]}; phase_weights(P_, A_->ws, lds, gw, NGW, wave, lane, lo_, hi_); } while (0)
#define EVA(e) do { if (EVF) ev_arrive(bar, (unsigned*)WSP(WS_CTL), e); else __syncthreads(); } while (0)
#define EVW(e) do { if (EVF) ev_wait(bar, (unsigned*)WSP(WS_CTL), e); } while (0)
    if (IN(0)) { PHASE_VARS; phase_mod(A_->in[1], A_->in[2], A_->in[3], A_->in[4], A_->in[8], A_->in[21], (float*)WSP(WS_MOD), lds, vcu, G, tid); __syncthreads(); if (EV_ON && IN(1)) ev_arrive(bar, (unsigned*)WSP(WS_CTL), 0); }
    if (!EV_ON) SEAM(0);
    if (IN(1)) { PHASE_VARS;
        WPtrs P{A_->in[5], A_->in[6], A_->in[7], A_->in[22], A_->in[23], A_->in[24], A_->in[9], A_->in[20], A_->in[12], A_->in[13], A_->in[14], A_->in[15]};
        phase_weights(P, A_->ws, lds, gw, NGW, wave, lane, WI_G1, WI_G2);
        if (EV_ON && IN(0)) ev_wait(bar, (unsigned*)WSP(WS_CTL), 0);
        const float* MOD = (const float*)WSP(WS_MOD);
        modnorm_rows8(A_->in[0], MOD + 1 * 8 * D, MOD + 0 * 8 * D, WSP(WS_XN), gw, NGW, lane);
        EVA(7); WFILL(WI_D1, WI_D2);
    }
    if (!EVF) SEAM(1);
    if (IN(2)) { PHASE_VARS; EVW(7); pg8::Gemm g{(const bf16*)WSP(WS_XN), (const bf16*)WSP(WS_WGU1), M, NGU, D}; pg8::StaticOrder S; S.init(M, NGU, G, bx);
        pg8::EpiSwiGLU<true> E{A_->ws, (unsigned)WS_HB, 0u, 0u, FF, 1.0f / W8SCALE_UP, 0, SEQ / 256}; pg8::gemm_phase8<pg8::EpiSwiGLU<true>, pg8::StaticOrder, PG8_ALIGN, true>(lds + RING_OFF, g, S, E);
        EVA(8); WFILL(WI_IN, WI_OUT); phase_bw((const float*)WSP(WS_MOD), A_->in[9], (float*)WSP(WS_BW2), lds, vcu, G, tid); }
    if (!EVF) SEAM(2);
    if (IN(3)) { PHASE_VARS; EVW(8); pg8::bf16_t* XB1_ = (pg8::bf16_t*)A_->out; pg8::Gemm g{(const bf16*)WSP(WS_HB), (const bf16*)WSP(WS_WD1), M, D, FF}; pg8::StaticOrder S; S.init(M, D, G, bx);
        pg8::EpiResidY<false> E{A_->in[0], XB1_, (const float*)WSP(WS_MOD) + 2 * 8 * D, (const float*)WSP(WS_MOD) + 4 * 8 * D, (void*)WSP(WS_XN), (float*)WSP(WS_SSQ1), D, SEQ / 256, 1.0f / W8SCALE_DN, 0};
        pg8::gemm_phase8<pg8::EpiResidY<false>, pg8::StaticOrder, PG8_ALIGN, true>(lds + RING_OFF, g, S, E);
        EVA(9); WFILL(WI_MH, WI_END); { WPtrs P_{A_->in[5], A_->in[6], A_->in[7], A_->in[22], A_->in[23], A_->in[24], A_->in[9], A_->in[20], A_->in[12], A_->in[13], A_->in[14], A_->in[15]}; phase_weff(P_, A_->ws, gw, NGW, lane); } }
    if (!EVF) SEAM(3);
    if (IN(4)) { PHASE_VARS; EVW(9); pg8::Gemm g{(const bf16*)WSP(WS_XN), (const bf16*)WSP(WS_WIN), M, NIN, D}; pg8::StaticOrder S; S.init(M, NIN, G, bx);
        pg8::EpiBf16N E{(bf16*)WSP(WS_Q), (const float*)WSP(WS_BW2), (const float*)WSP(WS_SSQ1), (size_t)(WS_K - WS_Q) / 2, AW, NIN, AW, SEQ / 256, attn_body::C2, 0};
        pg8::gemm_phase<pg8::EpiBf16N, pg8::StaticOrder, PG8_ALIGN, PG8_SP2>(lds + RING_OFF, g, S, E);
        EVA(10); WFILL(WI_OUT, WI_MH); }
    if (!EVF) SEAM(4);
    const bool EVR = EV_ON && lo <= 5 && hi >= 9;
    enum { EV_MOD = 0, EV_K = 1, EV_P = 2, EV_S = 3, EV_D = 4, EV_A = 5, EV_T = 6 };
    if (IN(5)) { PHASE_VARS; EVW(10);
        phase_kmean((const bf16*)WSP(WS_K), (float*)WSP(WS_KMEAN), lds, vcu, G, tid);
        if (EVR) ev_arrive(bar, (unsigned*)WSP(WS_CTL), EV_K);
        mlstm_pre_phase((const bf16*)WSP(WS_XM), A_->in[10], A_->in[11], (const bf16*)WSP(WS_WQM), (const bf16*)WSP(WS_WKM), (const bf16*)WSP(WS_WVM), (const bf16*)WSP(WS_WEC), (const bf16*)WSP(WS_WEM),
                        (bf16*)WSP(WS_XC), (bf16*)WSP(WS_QM), (bf16*)WSP(WS_KM), (bf16*)WSP(WS_KMT), (bf16*)WSP(WS_VMT), (float*)WSP(WS_GP), lds, vcu, G, tid);
        if (EVR) ev_arrive(bar, (unsigned*)WSP(WS_CTL), EV_P);
    }
    if (!EVR) SEAM(5);
    if (IN(6)) { PHASE_VARS;
        if (EVR) ev_wait(bar, (unsigned*)WSP(WS_CTL), EV_K);
        phase_topk((const bf16*)WSP(WS_Q), (const float*)WSP(WS_KMEAN), (unsigned short*)WSP(WS_SEL), lds, vcu, G, tid);
        __syncthreads();
        if (EVR) { ev_arrive(bar, (unsigned*)WSP(WS_CTL), EV_S); ev_wait(bar, (unsigned*)WSP(WS_CTL), EV_P); }
        mlstm_chunkstate_phase((const bf16*)WSP(WS_KMT), (const bf16*)WSP(WS_VMT), (const float*)WSP(WS_GP), A_->in[16], (float*)WSP(WS_DST), (float*)WSP(WS_GSUP), lds, vcu, G, tid);
        if (EVR) ev_arrive(bar, (unsigned*)WSP(WS_CTL), EV_D);
    }
    if (!EVR) SEAM(6);
    if (IN(7)) { PHASE_VARS;
        if (!EVR) phase_scan((const float*)WSP(WS_DST), (const float*)WSP(WS_GSUP), (bf16*)WSP(WS_SST), gtid, NTH);
        else ev_wait(bar, (unsigned*)WSP(WS_CTL), EV_S);
        const attn_body::AttnTensors AT{(const attn_body::bf16*)WSP(WS_Q), (const attn_body::bf16*)WSP(WS_K), (const attn_body::bf16*)WSP(WS_V), (attn_body::bf16*)WSP(WS_CAT), (const unsigned short*)WSP(WS_SEL)};
        const attn_body::StaticOrder S(G, bx);
        for (int rep_ = 0; rep_ < 1 + DUP_ATTN; ++rep_) attn_body::attn_phase<attn_body::StaticOrder>((char*)lds_raw + RING_OFF, AT, S);
        if (EVR) { ev_arrive(bar, (unsigned*)WSP(WS_CTL), EV_A); ev_wait(bar, (unsigned*)WSP(WS_CTL), EV_D);
            phase_scan((const float*)WSP(WS_DST), (const float*)WSP(WS_GSUP), (bf16*)WSP(WS_SST), gtid, NTH);
            ev_arrive(bar, (unsigned*)WSP(WS_CTL), EV_T); }
    }
    if (!EVR) SEAM(7);
    if (IN(8)) { PHASE_VARS;
        if (EVR) { ev_wait(bar, (unsigned*)WSP(WS_CTL), EV_A); catnorm_rows((bf16*)WSP(WS_CAT), A_->in[19], gw, NGW, lane); ev_wait(bar, (unsigned*)WSP(WS_CTL), EV_T); }
        mlstm_out_phase((const bf16*)WSP(WS_QM), (const bf16*)WSP(WS_KM), (const bf16*)WSP(WS_KMT), (const bf16*)WSP(WS_VMT), (const float*)WSP(WS_GP), A_->in[16],
                        (const bf16*)WSP(WS_SST), (const bf16*)WSP(WS_XC), (const bf16*)WSP(WS_Z), A_->in[17], A_->in[18], (bf16*)WSP(WS_CAT), lds, vcu, G, tid);
        if (!EVR) catnorm_rows((bf16*)WSP(WS_CAT), A_->in[19], gw, NGW, lane);
        EVA(11); WFILL(WI_G2, WI_U2);
    }
    if (!EVF) SEAM(8);
    if (IN(9)) { PHASE_VARS; EVW(11); pg8::Gemm g{(const bf16*)WSP(WS_CAT), (const bf16*)WSP(WS_WOUT), M, D, D}; pg8::StaticOrder S; S.init(M, D, G, bx);
        pg8::EpiResidB E{(const pg8::bf16_t*)A_->out, (pg8::bf16_t*)A_->out + (size_t)M * D, (const float*)WSP(WS_MOD) + 5 * 8 * D, D, SEQ / 256, 1.0f, 0}; pg8::gemm_phase<pg8::EpiResidB, pg8::StaticOrder, PG8_ALIGN, PG8_SP2>(lds + RING_OFF, g, S, E);
        EVA(12); WFILL(WI_U2, WI_D1); }
    if (!EVF) SEAM(9);
    if (IN(10)) { PHASE_VARS; EVW(12); const float* MOD = (const float*)WSP(WS_MOD); modnorm_rows8b((const bf16*)A_->out + (size_t)M * D, MOD + 7 * 8 * D, MOD + 6 * 8 * D, WSP(WS_XN), gw, NGW, lane);
        EVA(13); WFILL(WI_D2, WI_IN); }
    if (!EVF) SEAM(10);
    if (IN(11)) { PHASE_VARS; EVW(13); pg8::Gemm g{(const bf16*)WSP(WS_XN), (const bf16*)WSP(WS_WGU2), M, NGU, D}; pg8::StaticOrder S; S.init(M, NGU, G, bx);
        pg8::EpiSwiGLU<true> E{A_->ws, (unsigned)WS_HB, 0u, 0u, FF, 1.0f / W8SCALE_UP, 0, SEQ / 256}; pg8::gemm_phase8<pg8::EpiSwiGLU<true>, pg8::StaticOrder, PG8_ALIGN, true>(lds + RING_OFF, g, S, E); }
    SEAM(11);
    if (IN(12)) { PHASE_VARS; pg8::Gemm g{(const bf16*)WSP(WS_HB), (const bf16*)WSP(WS_WD2), M, D, FF}; pg8::StaticOrder S; S.init(M, D, G, bx);
        pg8::EpiResidB E{(const pg8::bf16_t*)A_->out + (size_t)M * D, (pg8::bf16_t*)WSP(WS_XN), (const float*)WSP(WS_MOD) + 8 * 8 * D, D, SEQ / 256, 1.0f / W8SCALE_DN, 0}; pg8::gemm_phase8<pg8::EpiResidB, pg8::StaticOrder, PG8_ALIGN, true>(lds + RING_OFF, g, S, E); }
    SEAM(12);
    if (IN(13)) { PHASE_VARS; final_rows_b((const bf16*)WSP(WS_XN), A_->out, A_->in[25], gw, NGW, lane); }
#undef IN
#undef SEAM
}

extern "C" void kernel_launch(void* const* d_in, const int* in_sizes, int n_in, void* d_out, int out_size, void* d_ws, size_t ws_size, hipStream_t stream) {
    static int grid = 0;
    if (grid == 0) {
        if (n_in != 26 || in_sizes[0] != M * D || out_size != M * D || ws_size < WS_END) { fprintf(stderr, "kernel_launch: unexpected shapes (n_in %d, in0 %d, out %d, ws %zu); nothing launched\n", n_in, n_in > 0 ? in_sizes[0] : -1, out_size, ws_size); grid = -1; return; }
        int dev = 0, cus = 0, per_cu = 0;
        if (hipGetDevice(&dev) != hipSuccess || hipDeviceGetAttribute(&cus, hipDeviceAttributeMultiprocessorCount, dev) != hipSuccess) { grid = -1; return; }
        if (hipFuncSetAttribute((const void*)mk_fwd, hipFuncAttributeMaxDynamicSharedMemorySize, LDS_BYTES) != hipSuccess) { fprintf(stderr, "kernel_launch: hipFuncSetAttribute failed\n"); grid = -1; return; }
        if (hipOccupancyMaxActiveBlocksPerMultiprocessor(&per_cu, (const void*)mk_fwd, NWAVES * 64, LDS_BYTES) != hipSuccess || per_cu < 1) { fprintf(stderr, "kernel_launch: occupancy query says %d blocks per CU\n", per_cu); per_cu = 1; }
        (void)hipGetLastError();
        grid = cus;
        if (grid > 256) grid = 256;
    }
    if (grid < 0) return;
    if (hipMemsetAsync((char*)d_ws + WS_CTL, 0, CTL_ZERO_BYTES, stream) != hipSuccess) return;
    Args a{};
    for (int i = 0; i < 26; ++i) a.in[i] = (const float*)d_in[i];
    a.out = (float*)d_out; a.ws = (unsigned char*)d_ws;
#if MK_PER_PHASE
    for (int p = 0; p < NPHASE; ++p) { a.ph_lo = p; a.ph_hi = p + 1; hipLaunchKernelGGL(mk_fwd, dim3(grid), dim3(NWAVES * 64), LDS_BYTES, stream, a); }
#else
    a.ph_lo = 0; a.ph_hi = NPHASE;
    void* kargs[] = {&a};
    hipError_t e = hipLaunchCooperativeKernel((const void*)mk_fwd, dim3(grid), dim3(NWAVES * 64), kargs, LDS_BYTES, stream);
    if (e != hipSuccess) fprintf(stderr, "kernel_launch: cooperative launch failed: %s (grid %d)\n", hipGetErrorString(e), grid);
#endif
#ifdef PROBE_PH
    { Args b2 = a; b2.ph_lo = PROBE_PH; b2.ph_hi = PROBE_PH + 1; for (int r = 0; r < 2; ++r) hipLaunchKernelGGL(mk_fwd, dim3(grid), dim3(NWAVES * 64), LDS_BYTES, stream, b2); }
#endif
}
```

```cpp
#include <hip/hip_runtime.h>
#include <cstdio>
#include <cstdint>
namespace pg8 {
#define PG8_LAS __attribute__((address_space(3)))
typedef unsigned short bf16_t;
typedef short bf16x8 __attribute__((ext_vector_type(8)));
typedef float f32x4 __attribute__((ext_vector_type(4)));
typedef unsigned u32x4 __attribute__((ext_vector_type(4)));
constexpr int BM = 256, BK = 64, HALF = 128, HTB = HALF * BK * 2  , STAGE_BYTES = 8 * HTB, NXCD = 8, WGM = 8;

__host__ __device__ __forceinline__ int lds_byte(int r, int c) { const int st = (r >> 4) * 2 + (c >> 5), rr = r & 15, cc = c & 31, ob = rr * 64 + cc * 2; return st * 1024 + (ob ^ (((ob >> 9) & 1) << 5)); }
__host__ __device__ __forceinline__ void stage_rc(int b, int& R, int& C) { const int st = b / 1024, sb = b % 1024, swz = sb ^ (((sb >> 9) & 1) << 5); R = (st >> 1) * 16 + swz / 64; C = (st & 1) * 32 + (swz % 64) / 2; }
__host__ __device__ __forceinline__ int perm32(int rho) { const int n = rho >> 4, i = rho & 15; return 8 * (i >> 2) + 4 * n + (i & 3); }

struct Unit { int pm, pn; };
struct Gemm { const bf16_t* A; const bf16_t* Bt; int M, N, K; };

struct StaticOrder {
    int nM, nN, nwg, G, c;
    __host__ __device__ void init(int M, int N, int G_, int c_) { nM = M / BM; nN = N / BM; nwg = nM * nN; G = G_; c = c_; }
    __host__ __device__ bool next(int i, Unit& u) const {
        const long L = (long)i * G + c; if (L >= nwg) return false;
        int wgid = (int)L; { const int q = nwg / NXCD, r = nwg % NXCD, xcd = wgid % NXCD, off = wgid / NXCD; wgid = (xcd < r ? xcd * (q + 1) : r * (q + 1) + (xcd - r) * q) + off; }
        const int nig = WGM * nN, gid = wgid / nig, fm = gid * WGM, gsz = (nM - fm) < WGM ? (nM - fm) : WGM;
        u.pm = fm + ((wgid % nig) % gsz); u.pn = (wgid % nig) / gsz; return true;
    }
    __device__ __forceinline__ void a_ready(const Unit&) const {}
    __device__ __forceinline__ void done(const Unit&) const {}
};

__device__ __forceinline__ unsigned cvt_pk_bf16(float lo, float hi) { unsigned r; asm volatile("v_cvt_pk_bf16_f32 %0, %1, %2" : "=v"(r) : "v"(lo), "v"(hi)); return r; }
typedef float f32x2 __attribute__((ext_vector_type(2)));
__device__ __forceinline__ f32x2 gelu_pk(f32x2 v) {
    const f32x2 av = __builtin_elementwise_abs(v), d = av * 0.2316418882f + 1.0f;
    f32x2 t; t.x = __builtin_amdgcn_rcpf(d.x); t.y = __builtin_amdgcn_rcpf(d.y);
    f32x2 q = t * 0.5307027145f + (-0.7265760135f); q = q * t + 0.7107068705f; q = q * t + (-0.142248368f); q = q * t + 0.127414796f; q = q * t;
    const f32x2 s = (v * v) * (-0.72134752044f);
    f32x2 e; e.x = __builtin_amdgcn_exp2f(s.x); e.y = __builtin_amdgcn_exp2f(s.y);
    const f32x2 m = v * (q * e), r = v - m;
    f32x2 o; o.x = v.x < 0.f ? m.x : r.x; o.y = v.y < 0.f ? m.y : r.y; return o;
}

template <int ACT  > struct EpiBf16 {
    static constexpr bool PERM = true, AFTER_DRAIN = false; static_assert(ACT == 0 || ACT == 1, "EpiBf16: ACT is 0 (none) or 1 (gelu_pk)");
    bf16_t* O; int ldc; const float* bias; int split_cols; size_t split_stride; float scale0;
    __device__ __forceinline__ void operator()(const f32x4 (&acc)[2][2][4][2], const Unit& u, int wr, int wc, int fr, int fq) const {
        const int row0 = u.pm * BM + wr * 64 + fr; int colt = u.pn * BM; bf16_t* base = O;
        float sc = 1.f; if (split_cols) { const int t = colt / split_cols; base += (size_t)t * split_stride; colt -= t * split_cols; if (t == 0) sc = scale0; }
        const int col0 = colt + wc * 32 + 8 * fq, bcol0 = u.pn * BM + wc * 32 + 8 * fq;
        f32x4 bv[2][2];
#pragma unroll
        for (int bj = 0; bj < 2; ++bj)
#pragma unroll
            for (int n = 0; n < 2; ++n) bv[bj][n] = bias ? *(const f32x4*)(bias + bcol0 + bj * HALF + 4 * n) : (f32x4){0.f, 0.f, 0.f, 0.f};
#pragma unroll
        for (int ai = 0; ai < 2; ++ai)
#pragma unroll
            for (int m = 0; m < 4; ++m) { bf16_t* rowp = base + (size_t)(row0 + ai * HALF + m * 16) * ldc + col0;
#pragma unroll
                for (int bj = 0; bj < 2; ++bj) { f32x4 v0 = acc[ai][bj][m][0] + bv[bj][0], v1 = acc[ai][bj][m][1] + bv[bj][1];
                    if (ACT == 1) { f32x2 a = gelu_pk((f32x2){v0[0], v0[1]}), b = gelu_pk((f32x2){v0[2], v0[3]}), c = gelu_pk((f32x2){v1[0], v1[1]}), d = gelu_pk((f32x2){v1[2], v1[3]});
                        v0 = (f32x4){a.x, a.y, b.x, b.y}; v1 = (f32x4){c.x, c.y, d.x, d.y}; }
                    v0 = v0 * sc; v1 = v1 * sc; u32x4 w; w.x = cvt_pk_bf16(v0[0], v0[1]); w.y = cvt_pk_bf16(v0[2], v0[3]); w.z = cvt_pk_bf16(v1[0], v1[1]); w.w = cvt_pk_bf16(v1[2], v1[3]);
                    *(u32x4*)(rowp + bj * HALF) = w; }
                asm volatile("s_waitcnt vmcnt(32)" ::: "memory");     }
    }
};
__device__ __forceinline__ float row_rstd(const float* SSQ, int row, int fq) {
    const f32x4 q = *(const f32x4*)(SSQ + (size_t)row * 16 + 4 * fq); float s = (q[0] + q[1]) + (q[2] + q[3]);
    s += __shfl_xor(s, 16); s += __shfl_xor(s, 32); return 1.0f / sqrtf(s * (1.0f / 1024.0f) + 1e-6f);
}
__device__ __forceinline__ unsigned pk4_fp8_(float a, float b, float c, float d) {
    a = __builtin_amdgcn_fmed3f(a, -448.f, 448.f); b = __builtin_amdgcn_fmed3f(b, -448.f, 448.f); c = __builtin_amdgcn_fmed3f(c, -448.f, 448.f); d = __builtin_amdgcn_fmed3f(d, -448.f, 448.f);
    int w = __builtin_amdgcn_cvt_pk_fp8_f32(a, b, 0, false); w = __builtin_amdgcn_cvt_pk_fp8_f32(c, d, w, true); return (unsigned)w; }
template <bool OUT8> struct EpiSwiGLU {
    static constexpr bool PERM = true, AFTER_DRAIN = false;
    unsigned char* wsb; unsigned oO, oSSQ, oBW; int ldc; float dsc; int nbw; int tiles_per_batch;
    __device__ __forceinline__ void operator()(const f32x4 (&acc)[2][2][4][2], const Unit& u, int wr, int wc, int fr, int fq) const {
        const int row0 = u.pm * BM + wr * 64 + fr, col0 = u.pn * HALF + wc * 32 + 8 * fq;
        bf16_t* const O = (bf16_t*)(wsb + oO); const float* const SSQ = oSSQ ? (const float*)(wsb + oSSQ) : nullptr; const float* const BW = (const float*)(wsb + oBW);
        const float* const bwq = BW + (size_t)(u.pm / tiles_per_batch) * nbw + u.pn * BM + wc * 32 + 8 * fq;
#pragma unroll
        for (int ai = 0; ai < 2; ++ai)
#pragma unroll
            for (int m = 0; m < 4; ++m) { bf16_t* rowp = O + (size_t)(row0 + ai * HALF + m * 16) * ldc + col0;
                const float rs = SSQ ? row_rstd(SSQ, row0 + ai * HALF + m * 16, fq) * dsc : dsc;
                float hv[8];
                if (!SSQ) {
#pragma unroll
                    for (int n = 0; n < 2; ++n) { const f32x4 G = acc[ai][0][m][n] * rs, GE = acc[ai][0][m][n] * (rs * -1.4426950408889634f); f32x4 R;
                        R[0] = __builtin_amdgcn_rcpf(1.0f + __builtin_amdgcn_exp2f(GE[0])); R[1] = __builtin_amdgcn_rcpf(1.0f + __builtin_amdgcn_exp2f(GE[1]));
                        R[2] = __builtin_amdgcn_rcpf(1.0f + __builtin_amdgcn_exp2f(GE[2])); R[3] = __builtin_amdgcn_rcpf(1.0f + __builtin_amdgcn_exp2f(GE[3]));
                        const f32x4 H = (G * R) * (acc[ai][1][m][n] * rs);
#pragma unroll
                        for (int j = 0; j < 4; ++j) hv[4 * n + j] = H[j]; }
                } else
#pragma unroll
                for (int n = 0; n < 2; ++n) { const f32x4 bg4 = SSQ ? *(const f32x4*)(bwq + 4 * n) : (f32x4){0.f, 0.f, 0.f, 0.f}, bu4 = SSQ ? *(const f32x4*)(bwq + HALF + 4 * n) : (f32x4){0.f, 0.f, 0.f, 0.f};
#pragma unroll
                    for (int j = 0; j < 4; ++j) {
                        const float g = acc[ai][0][m][n][j] * rs + bg4[j], up = acc[ai][1][m][n][j] * rs + bu4[j];
                        const float e = __builtin_amdgcn_exp2f(g * -1.4426950408889634f); hv[4 * n + j] = g * __builtin_amdgcn_rcpf(1.0f + e) * up; } }
                if (OUT8) { unsigned char* p8 = (unsigned char*)O + (size_t)(row0 + ai * HALF + m * 16) * ldc + col0;
                    typedef unsigned u32x2_ __attribute__((ext_vector_type(2)));
                    *(u32x2_*)p8 = (u32x2_){pk4_fp8_(hv[0], hv[1], hv[2], hv[3]), pk4_fp8_(hv[4], hv[5], hv[6], hv[7])}; }
                else { u32x4 w; w.x = cvt_pk_bf16(hv[0], hv[1]); w.y = cvt_pk_bf16(hv[2], hv[3]); w.z = cvt_pk_bf16(hv[4], hv[5]); w.w = cvt_pk_bf16(hv[6], hv[7]);
                    *(u32x4*)rowp = w; }
                asm volatile("s_waitcnt vmcnt(32)" ::: "memory");     }
    }
};
struct EpiResid {
    static constexpr bool PERM = false, AFTER_DRAIN = false;
    const float* base; float* out; int ldc; const float* gate; int tiles_per_batch; float dsc;
    __device__ __forceinline__ void operator()(const f32x4 (&acc)[2][2][4][2], const Unit& u, int wr, int wc, int fr, int fq) const {
        const int row0 = u.pm * BM + wr * 64 + fr, col0 = u.pn * BM + wc * 32 + 4 * fq;
        const float* gp = gate + (size_t)(u.pm / tiles_per_batch) * ldc + col0;
        f32x4 gv[2][2];
#pragma unroll
        for (int bj = 0; bj < 2; ++bj)
#pragma unroll
            for (int n = 0; n < 2; ++n) gv[bj][n] = *(const f32x4*)(gp + bj * HALF + n * 16);
#pragma unroll
        for (int ai = 0; ai < 2; ++ai)
#pragma unroll
            for (int m = 0; m < 4; ++m) { const size_t off = (size_t)(row0 + ai * HALF + m * 16) * ldc + col0;
#pragma unroll
                for (int bj = 0; bj < 2; ++bj)
#pragma unroll
                    for (int n = 0; n < 2; ++n) { const f32x4 bs = *(const f32x4*)(base + off + bj * HALF + n * 16);
                        *(f32x4*)(out + off + bj * HALF + n * 16) = bs + gv[bj][n] * (acc[ai][bj][m][n] * dsc); }
                asm volatile("s_waitcnt vmcnt(32)" ::: "memory");     }
    }
};

struct EpiResidB {
    static constexpr bool PERM = true, AFTER_DRAIN = false;
    const bf16_t* base; bf16_t* out; const float* gate; int ldc; int tiles_per_batch; float dsc; int pad_;
    __device__ __forceinline__ void operator()(const f32x4 (&acc)[2][2][4][2], const Unit& u, int wr, int wc, int fr, int fq) const {
        const int row0 = u.pm * BM + wr * 64 + fr, col0 = u.pn * BM + wc * 32 + 8 * fq; const size_t bo = (size_t)(u.pm / tiles_per_batch) * ldc + col0;
        f32x4 gv[2][2];
#pragma unroll
        for (int bj = 0; bj < 2; ++bj)
#pragma unroll
            for (int n = 0; n < 2; ++n) gv[bj][n] = *(const f32x4*)(gate + bo + bj * HALF + 4 * n) * dsc;
        u32x4 nb[2];
#pragma unroll
        for (int bj = 0; bj < 2; ++bj) nb[bj] = *(const u32x4*)(base + (size_t)row0 * ldc + col0 + bj * HALF);
#pragma unroll
        for (int g = 0; g < 8; ++g) { const int ai = g >> 2, m = g & 3; const size_t off = (size_t)(row0 + ai * HALF + m * 16) * ldc + col0;
            u32x4 cb[2]; cb[0] = nb[0]; cb[1] = nb[1];
            if (g < 7) { const int ai2 = (g + 1) >> 2, m2 = (g + 1) & 3; const size_t off2 = (size_t)(row0 + ai2 * HALF + m2 * 16) * ldc + col0;
#pragma unroll
                for (int bj = 0; bj < 2; ++bj) nb[bj] = *(const u32x4*)(base + off2 + bj * HALF); }
#pragma unroll
            for (int bj = 0; bj < 2; ++bj) { const u32x4 b = cb[bj];
                const f32x4 x0 = (f32x4){__builtin_bit_cast(float, b.x << 16), __builtin_bit_cast(float, b.x & 0xffff0000u), __builtin_bit_cast(float, b.y << 16), __builtin_bit_cast(float, b.y & 0xffff0000u)} + gv[bj][0] * acc[ai][bj][m][0];
                const f32x4 x1 = (f32x4){__builtin_bit_cast(float, b.z << 16), __builtin_bit_cast(float, b.z & 0xffff0000u), __builtin_bit_cast(float, b.w << 16), __builtin_bit_cast(float, b.w & 0xffff0000u)} + gv[bj][1] * acc[ai][bj][m][1];
                u32x4 w; w.x = cvt_pk_bf16(x0[0], x0[1]); w.y = cvt_pk_bf16(x0[2], x0[3]); w.z = cvt_pk_bf16(x1[0], x1[1]); w.w = cvt_pk_bf16(x1[2], x1[3]);
                *(u32x4*)(out + off + bj * HALF) = w; }
            asm volatile("s_waitcnt vmcnt(32)" ::: "memory");     }
    }
};

template <bool Y8> struct EpiResidY {
    static constexpr bool PERM = true, AFTER_DRAIN = false;
    const float* base; bf16_t* out; const float* gate; const float* Amod; void* Y; float* SSQ; int ldc; int tiles_per_batch; float dsc; int pad_;
    __device__ __forceinline__ void operator()(const f32x4 (&acc)[2][2][4][2], const Unit& u, int wr, int wc, int fr, int fq) const {
        const int row0 = u.pm * BM + wr * 64 + fr, col0 = u.pn * BM + wc * 32 + 8 * fq; const size_t bo = (size_t)(u.pm / tiles_per_batch) * ldc + col0;
        f32x4 gv[2][2], av[2][2];
#pragma unroll
        for (int bj = 0; bj < 2; ++bj)
#pragma unroll
            for (int n = 0; n < 2; ++n) { gv[bj][n] = *(const f32x4*)(gate + bo + bj * HALF + 4 * n) * dsc; av[bj][n] = *(const f32x4*)(Amod + bo + bj * HALF + 4 * n); }
        f32x4 nx[2];
#pragma unroll
        for (int n = 0; n < 2; ++n) nx[n] = __builtin_nontemporal_load((const f32x4*)(base + (size_t)row0 * ldc + col0 + 4 * n));
#pragma unroll
        for (int ai = 0; ai < 2; ++ai)
#pragma unroll
            for (int m = 0; m < 4; ++m) { const int row = row0 + ai * HALF + m * 16; const size_t off = (size_t)row * ldc + col0; float ss = 0.f;
#pragma unroll
                for (int bj = 0; bj < 2; ++bj) { f32x4 xn[2], xr[2], cx[2]; cx[0] = nx[0]; cx[1] = nx[1];
                    { const int st2 = (ai * 4 + m) * 2 + bj + 1;
                      if (st2 < 16) { const int g2 = st2 >> 1, bj2 = st2 & 1; const size_t off2 = (size_t)(row0 + (g2 >> 2) * HALF + (g2 & 3) * 16) * ldc + col0 + bj2 * HALF;
#pragma unroll
                          for (int n = 0; n < 2; ++n) nx[n] = __builtin_nontemporal_load((const f32x4*)(base + off2 + 4 * n)); } }
#pragma unroll
                    for (int n = 0; n < 2; ++n) { xn[n] = cx[n] + gv[bj][n] * acc[ai][bj][m][n];
                        ss += (xn[n][0] * xn[n][0] + xn[n][1] * xn[n][1]) + (xn[n][2] * xn[n][2] + xn[n][3] * xn[n][3]); xr[n] = xn[n]; xn[n] = xn[n] * av[bj][n]; }
                    { u32x4 w; w.x = cvt_pk_bf16(xr[0][0], xr[0][1]); w.y = cvt_pk_bf16(xr[0][2], xr[0][3]); w.z = cvt_pk_bf16(xr[1][0], xr[1][1]); w.w = cvt_pk_bf16(xr[1][2], xr[1][3]); *(u32x4*)(out + off + bj * HALF) = w; }
                    if (Y8) { typedef unsigned u32x2_ __attribute__((ext_vector_type(2)));
                        *(u32x2_*)((unsigned char*)Y + off + bj * HALF) = (u32x2_){pk4_fp8_(xn[0][0], xn[0][1], xn[0][2], xn[0][3]), pk4_fp8_(xn[1][0], xn[1][1], xn[1][2], xn[1][3])}; }
                    else { u32x4 w; w.x = cvt_pk_bf16(xn[0][0], xn[0][1]); w.y = cvt_pk_bf16(xn[0][2], xn[0][3]); w.z = cvt_pk_bf16(xn[1][0], xn[1][1]); w.w = cvt_pk_bf16(xn[1][2], xn[1][3]);
                        *(u32x4*)((bf16_t*)Y + off + bj * HALF) = w; } }
                ss += __shfl_xor(ss, 16); ss += __shfl_xor(ss, 32);
                if (fq == 0) SSQ[(size_t)row * 16 + 4 * u.pn + wc] = ss;
                asm volatile("s_waitcnt vmcnt(32)" ::: "memory");     }
    }
};
struct EpiBf16N {
    static constexpr bool PERM = true, AFTER_DRAIN = false;
    bf16_t* O; const float* BW; const float* SSQ; size_t split_stride; int ldc; int nbw; int split_cols; int tiles_per_batch; float scale0; int pad_;
    __device__ __forceinline__ void operator()(const f32x4 (&acc)[2][2][4][2], const Unit& u, int wr, int wc, int fr, int fq) const {
        const int row0 = u.pm * BM + wr * 64 + fr; int colt = u.pn * BM; bf16_t* obase = O;
        float sc = 1.f; { const int t = colt / split_cols; obase += (size_t)t * split_stride; colt -= t * split_cols; if (t == 0) sc = scale0; }
        const int col0 = colt + wc * 32 + 8 * fq, bcol0 = u.pn * BM + wc * 32 + 8 * fq; const float* bwp = BW + (size_t)(u.pm / tiles_per_batch) * nbw + bcol0;
        f32x4 bv[2][2];
#pragma unroll
        for (int bj = 0; bj < 2; ++bj)
#pragma unroll
            for (int n = 0; n < 2; ++n) bv[bj][n] = *(const f32x4*)(bwp + bj * HALF + 4 * n);
        f32x4 nq = *(const f32x4*)(SSQ + (size_t)row0 * 16 + 4 * fq);
#pragma unroll
        for (int ai = 0; ai < 2; ++ai)
#pragma unroll
            for (int m = 0; m < 4; ++m) { const int row = row0 + ai * HALF + m * 16; const f32x4 q = nq;
                if (ai * 4 + m < 7) { const int g2 = ai * 4 + m + 1; nq = *(const f32x4*)(SSQ + (size_t)(row0 + (g2 >> 2) * HALF + (g2 & 3) * 16) * 16 + 4 * fq); }
                float s_ = (q[0] + q[1]) + (q[2] + q[3]); s_ += __shfl_xor(s_, 16); s_ += __shfl_xor(s_, 32); const float rs = 1.0f / sqrtf(s_ * (1.0f / 1024.0f) + 1e-6f);
                bf16_t* rowp = obase + (size_t)row * ldc + col0;
#pragma unroll
                for (int bj = 0; bj < 2; ++bj) { const f32x4 v0 = (acc[ai][bj][m][0] * rs + bv[bj][0]) * sc, v1 = (acc[ai][bj][m][1] * rs + bv[bj][1]) * sc;
                    u32x4 w; w.x = cvt_pk_bf16(v0[0], v0[1]); w.y = cvt_pk_bf16(v0[2], v0[3]); w.z = cvt_pk_bf16(v1[0], v1[1]); w.w = cvt_pk_bf16(v1[2], v1[3]);
                    *(u32x4*)(rowp + bj * HALF) = w; }
                asm volatile("s_waitcnt vmcnt(32)" ::: "memory");     }
    }
};
template <class Epi, class Sched, bool ALIGN_EPI = false, bool SP2 = false>
__device__ __forceinline__ void gemm_phase(PG8_LAS unsigned char* lds, const Gemm g, const Sched S, const Epi E) {
    const int tid = threadIdx.x, wid = __builtin_amdgcn_readfirstlane(tid >> 6), lane = tid & 63, wr = wid >> 2, wc = wid & 3, fr = lane & 15, fq = lane >> 4;
    const int K = g.K, nt = K / BK;
    unsigned voffA[2], voffB[2];
#pragma unroll
    for (int i = 0; i < 2; ++i) { int R, C; stage_rc(tid * 16 + i * 8192, R, C); const int Rb = Epi::PERM ? ((R & ~31) + perm32(R & 31)) : R;
        voffA[i] = (unsigned)(R * K + C) * 2u; voffB[i] = (unsigned)(Rb * K + C) * 2u; }
    const size_t kstep = (size_t)(BK * 2);
    const size_t hstep = (size_t)HALF * K * 2;
    const size_t tstep = 2 * hstep;
    const unsigned ldsw = (unsigned)wid * 1024u;
    const int aoff = lds_byte(wr * 64 + fr, fq * 8), boff = lds_byte(wc * 32 + fr, fq * 8);
#define PG8_SA(b, h) (((b) * 2 + (h)) * HTB)
#define PG8_SB(b, h) ((4 + (b) * 2 + (h)) * HTB)
#define PG8_STAGE(bufoff, gbase, voff) do { _Pragma("unroll") for (int _i = 0; _i < 2; ++_i) \
        __builtin_amdgcn_global_load_lds((const unsigned*)((const char*)(gbase) + (voff)[_i]), (PG8_LAS unsigned*)(lds + (bufoff) + ldsw + _i * 8192), 16, 0, 0); } while (0)
#define PG8_LDA(dst, b, h) do { _Pragma("unroll") for (int m = 0; m < 4; ++m) _Pragma("unroll") for (int k = 0; k < 2; ++k) dst[m][k] = *(const PG8_LAS bf16x8*)(lds + PG8_SA(b, h) + aoff + m * 2048 + k * 1024); } while (0)
#define PG8_LDB(dst, b, h) do { _Pragma("unroll") for (int n = 0; n < 2; ++n) _Pragma("unroll") for (int k = 0; k < 2; ++k) dst[n][k] = *(const PG8_LAS bf16x8*)(lds + PG8_SB(b, h) + boff + n * 2048 + k * 1024); } while (0)
#define PG8_MMA(ai, bj, At, Bt) do { __builtin_amdgcn_s_setprio(1); _Pragma("unroll") for (int m = 0; m < 4; ++m) _Pragma("unroll") for (int n = 0; n < 2; ++n) _Pragma("unroll") for (int k = 0; k < 2; ++k) \
        acc[ai][bj][m][n] = __builtin_amdgcn_mfma_f32_16x16x32_bf16(Bt[n][k], At[m][k], acc[ai][bj][m][n], 0, 0, 0); __builtin_amdgcn_s_setprio(0); } while (0)
#define PG8_WAIT_V(n) asm volatile("s_waitcnt vmcnt(" #n ")" ::: "memory")
#define PG8_WAIT_L(n) asm volatile("s_waitcnt lgkmcnt(" #n ")" ::: "memory")
#define PG8_BAR __builtin_amdgcn_s_barrier()
#define PG8_SCHED __builtin_amdgcn_sched_barrier(0)
    Unit cur, nxt; int ui = 0;
    if (!S.next(0, cur)) return;
    f32x4 acc[2][2][4][2];
#pragma unroll
    for (int a = 0; a < 2; ++a)
#pragma unroll
        for (int b = 0; b < 2; ++b)
#pragma unroll
            for (int m = 0; m < 4; ++m)
#pragma unroll
                for (int n = 0; n < 2; ++n) acc[a][b][m][n] = (f32x4){0.f, 0.f, 0.f, 0.f};
    bf16x8 At[4][2], B0[2][2], B1[2][2];
    const char* cA = (const char*)g.A + (size_t)cur.pm * tstep; const char* cB = (const char*)g.Bt + (size_t)cur.pn * tstep;
    S.a_ready(cur);
    if constexpr (SP2) {
        PG8_STAGE(PG8_SB(0, 0), cB, voffB); PG8_STAGE(PG8_SB(0, 1), cB + hstep, voffB); PG8_STAGE(PG8_SA(0, 0), cA, voffA); PG8_STAGE(PG8_SA(0, 1), cA + hstep, voffA);
        if (wr == 1) PG8_BAR;
        PG8_WAIT_V(2); PG8_BAR;
        PG8_STAGE(PG8_SB(1, 0), cB + kstep, voffB); PG8_STAGE(PG8_SA(1, 0), cA + kstep, voffA); PG8_STAGE(PG8_SB(1, 1), cB + hstep + kstep, voffB);
        PG8_WAIT_V(6); PG8_BAR;
    } else {
        PG8_STAGE(PG8_SB(0, 0), cB, voffB); PG8_STAGE(PG8_SA(0, 0), cA, voffA); PG8_STAGE(PG8_SB(0, 1), cB + hstep, voffB); PG8_STAGE(PG8_SA(0, 1), cA + hstep, voffA);
        if (wr == 1) PG8_BAR;
        PG8_WAIT_V(4); PG8_BAR;
        PG8_STAGE(PG8_SB(1, 0), cB + kstep, voffB); PG8_STAGE(PG8_SA(1, 0), cA + kstep, voffA); PG8_STAGE(PG8_SB(1, 1), cB + hstep + kstep, voffB);
        PG8_WAIT_V(6); PG8_BAR;
    }
    for (;;) {
        const bool has_next = S.next(ui + 1, nxt);
        const char* nA = has_next ? (const char*)g.A + (size_t)nxt.pm * tstep : cA; const char* nB = has_next ? (const char*)g.Bt + (size_t)nxt.pn * tstep : cB;
        for (int t = 0; t < nt; t += 2) {
            const bool last = (t == nt - 2);
            const char* a1 = cA + (size_t)(t + 1) * kstep;
            const char* a2 = last ? nA : cA + (size_t)(t + 2) * kstep; const char* b2 = last ? nB : cB + (size_t)(t + 2) * kstep;
            const char* a3 = a2 + kstep; const char* b3 = b2 + kstep;
            if (last && has_next) S.a_ready(nxt);
            if constexpr (SP2) {
            PG8_LDB(B0, 0, 0); PG8_LDB(B1, 0, 1); PG8_SCHED; PG8_LDA(At, 0, 0); PG8_STAGE(PG8_SA(1, 1), a1 + hstep, voffA);
            PG8_WAIT_V(8); PG8_WAIT_L(0); PG8_BAR; PG8_MMA(0, 0, At, B0); PG8_MMA(0, 1, At, B1); PG8_BAR; PG8_SCHED;
            PG8_LDA(At, 0, 1); PG8_STAGE(PG8_SB(0, 0), b2, voffB); PG8_STAGE(PG8_SB(0, 1), b2 + hstep, voffB); PG8_STAGE(PG8_SA(0, 0), a2, voffA);
            PG8_WAIT_V(8); PG8_WAIT_L(0); PG8_BAR; PG8_MMA(1, 0, At, B0); PG8_MMA(1, 1, At, B1); PG8_BAR; PG8_SCHED;
            PG8_LDB(B0, 1, 0); PG8_LDB(B1, 1, 1); PG8_SCHED; PG8_LDA(At, 1, 0); PG8_STAGE(PG8_SA(0, 1), a2 + hstep, voffA);
            PG8_WAIT_V(8); PG8_WAIT_L(0); PG8_BAR; PG8_MMA(0, 0, At, B0); PG8_MMA(0, 1, At, B1); PG8_BAR; PG8_SCHED;
            PG8_LDA(At, 1, 1); PG8_STAGE(PG8_SB(1, 0), b3, voffB); PG8_STAGE(PG8_SB(1, 1), b3 + hstep, voffB); PG8_STAGE(PG8_SA(1, 0), a3, voffA);
            PG8_WAIT_V(8); PG8_WAIT_L(0); PG8_BAR; PG8_MMA(1, 0, At, B0); PG8_MMA(1, 1, At, B1); PG8_BAR; PG8_SCHED;
            } else {
            PG8_LDB(B0, 0, 0); PG8_SCHED; PG8_LDA(At, 0, 0); PG8_STAGE(PG8_SA(1, 1), a1 + hstep, voffA);
            PG8_WAIT_L(8); PG8_BAR; PG8_WAIT_L(0); PG8_MMA(0, 0, At, B0); PG8_BAR; PG8_SCHED;
            PG8_LDB(B1, 0, 1); PG8_STAGE(PG8_SB(0, 0), b2, voffB);
            PG8_BAR; PG8_WAIT_L(0); PG8_MMA(0, 1, At, B1); PG8_BAR;
            PG8_LDA(At, 0, 1); PG8_STAGE(PG8_SA(0, 0), a2, voffA);
            PG8_BAR; PG8_WAIT_L(0); PG8_MMA(1, 0, At, B0); PG8_BAR; PG8_SCHED;
            PG8_STAGE(PG8_SB(0, 1), b2 + hstep, voffB);
            PG8_WAIT_V(6); PG8_BAR; PG8_MMA(1, 1, At, B1); PG8_BAR;
            PG8_LDB(B0, 1, 0); PG8_SCHED; PG8_LDA(At, 1, 0); PG8_STAGE(PG8_SA(0, 1), a2 + hstep, voffA);
            PG8_WAIT_L(8); PG8_BAR; PG8_WAIT_L(0); PG8_MMA(0, 0, At, B0); PG8_BAR; PG8_SCHED;
            PG8_LDB(B1, 1, 1); PG8_STAGE(PG8_SB(1, 0), b3, voffB);
            PG8_BAR; PG8_WAIT_L(0); PG8_MMA(0, 1, At, B1); PG8_BAR;
            PG8_LDA(At, 1, 1); PG8_STAGE(PG8_SA(1, 0), a3, voffA);
            PG8_BAR; PG8_WAIT_L(0); PG8_MMA(1, 0, At, B0); PG8_BAR; PG8_SCHED;
            PG8_STAGE(PG8_SB(1, 1), b3 + hstep, voffB);
            PG8_WAIT_V(6); PG8_BAR; PG8_MMA(1, 1, At, B1); PG8_BAR;
            }
        }
        if constexpr (ALIGN_EPI) { if (wr == 0) PG8_BAR; }
        if constexpr (!Epi::AFTER_DRAIN) { E(acc, cur, wr, wc, fr, fq); S.done(cur); }
        if (!has_next) break;
#pragma unroll
        for (int a = 0; a < 2; ++a)
#pragma unroll
            for (int b = 0; b < 2; ++b)
#pragma unroll
                for (int m = 0; m < 4; ++m)
#pragma unroll
                    for (int n = 0; n < 2; ++n) acc[a][b][m][n] = (f32x4){0.f, 0.f, 0.f, 0.f};
        cur = nxt; cA = nA; cB = nB; ++ui;
        if constexpr (ALIGN_EPI) { if (wr == 1) PG8_BAR; }
    }
    PG8_WAIT_V(0);
    if constexpr (!ALIGN_EPI) { if (wr == 0) PG8_BAR; }
    PG8_BAR;
    if constexpr (Epi::AFTER_DRAIN) { E.fused(acc, cur, wr, wc, fr, fq, lds, wid, lane); S.done(cur); }
#undef PG8_SA
#undef PG8_SB
#undef PG8_STAGE
#undef PG8_LDA
#undef PG8_LDB
#undef PG8_MMA
#undef PG8_WAIT_V
#undef PG8_WAIT_L
#undef PG8_BAR
#undef PG8_SCHED
}
typedef int i32x4 __attribute__((ext_vector_type(4)));
typedef int i32x8 __attribute__((ext_vector_type(8)));
template <class Epi, class Sched, bool ALIGN_EPI = false, bool SP2 = false>
__device__ __forceinline__ void gemm_phase8(PG8_LAS unsigned char* lds, const Gemm g, const Sched S, const Epi E) {
    const int tid = threadIdx.x, wid = __builtin_amdgcn_readfirstlane(tid >> 6), lane = tid & 63, wr = wid >> 2, wc = wid & 3, fr = lane & 15, fq = lane >> 4;
    const int K = g.K, nt = K / 128;
    unsigned voffA[2], voffB[2];
#pragma unroll
    for (int i = 0; i < 2; ++i) { int R, C; stage_rc(tid * 16 + i * 8192, R, C); const int Rb = Epi::PERM ? ((R & ~31) + perm32(R & 31)) : R;
        voffA[i] = (unsigned)(R * K + 2 * C); voffB[i] = (unsigned)(Rb * K + 2 * C); }
    const size_t kstep = (size_t)128;
    const size_t hstep = (size_t)HALF * K;
    const size_t tstep = 2 * hstep;
    const unsigned ldsw = (unsigned)wid * 1024u;
    const int aoff0_ = lds_byte(wr * 64 + fr, 16 * (fq & 1)) + (fq >> 1) * 1024, boff0_ = lds_byte(wc * 32 + fr, 16 * (fq & 1)) + (fq >> 1) * 1024;
    const int aoff = aoff0_ + 16 * (fq & 1), boff = boff0_ + 16 * (fq & 1);
#define PG8_SA(b, h) (((b) * 2 + (h)) * HTB)
#define PG8_SB(b, h) ((4 + (b) * 2 + (h)) * HTB)
#define PG8_STAGE(bufoff, gbase, voff) do { _Pragma("unroll") for (int _i = 0; _i < 2; ++_i) { unsigned vo_ = (voff)[_i]; asm volatile("" : "+v"(vo_)); \
        __builtin_amdgcn_global_load_lds((const unsigned*)((const char*)(gbase) + vo_), (PG8_LAS unsigned*)(lds + (bufoff) + ldsw + _i * 8192), 16, 0, 0); } } while (0)
#define PG8_LDA(dst, b, h) do { int a2_ = aoff ^ 16; asm volatile("" : "+v"(a2_)); _Pragma("unroll") for (int m = 0; m < 4; ++m) { const i32x4 lo_ = *(const PG8_LAS i32x4*)(lds + PG8_SA(b, h) + aoff + m * 2048), hi_ = *(const PG8_LAS i32x4*)(lds + PG8_SA(b, h) + a2_ + m * 2048); dst[m] = (i32x8){lo_[0], lo_[1], lo_[2], lo_[3], hi_[0], hi_[1], hi_[2], hi_[3]}; } } while (0)
#define PG8_LDB(dst, b, h) do { int b2_ = boff ^ 16; asm volatile("" : "+v"(b2_)); _Pragma("unroll") for (int n = 0; n < 2; ++n) { const i32x4 lo_ = *(const PG8_LAS i32x4*)(lds + PG8_SB(b, h) + boff + n * 2048), hi_ = *(const PG8_LAS i32x4*)(lds + PG8_SB(b, h) + b2_ + n * 2048); dst[n] = (i32x8){lo_[0], lo_[1], lo_[2], lo_[3], hi_[0], hi_[1], hi_[2], hi_[3]}; } } while (0)
#define PG8_MMA(ai, bj, At, Bt) do { __builtin_amdgcn_s_setprio(1); _Pragma("unroll") for (int m = 0; m < 4; ++m) _Pragma("unroll") for (int n = 0; n < 2; ++n) \
        asm volatile("v_mfma_scale_f32_16x16x128_f8f6f4 %0, %1, %2, %0, %3, %3 op_sel_hi:[0,0,0]" : "+v"(acc[ai][bj][m][n]) : "v"(Bt[n]), "v"(At[m]), "v"(sc8)); __builtin_amdgcn_s_setprio(0); } while (0)
#define PG8_WAIT_V(n) asm volatile("s_waitcnt vmcnt(" #n ")" ::: "memory")
#define PG8_WAIT_L(n) asm volatile("s_waitcnt lgkmcnt(" #n ")" ::: "memory")
#define PG8_BAR __builtin_amdgcn_s_barrier()
#define PG8_SCHED __builtin_amdgcn_sched_barrier(0)
    Unit cur, nxt; int ui = 0;
    if (!S.next(0, cur)) return;
    f32x4 acc[2][2][4][2];
#pragma unroll
    for (int a = 0; a < 2; ++a)
#pragma unroll
        for (int b = 0; b < 2; ++b)
#pragma unroll
            for (int m = 0; m < 4; ++m)
#pragma unroll
                for (int n = 0; n < 2; ++n) acc[a][b][m][n] = (f32x4){0.f, 0.f, 0.f, 0.f};
    i32x8 At[4], B0[2], B1[2]; int sc8 = 0x7f7f7f7f; asm volatile("" : "+v"(sc8));
    const char* cA = (const char*)g.A + (size_t)cur.pm * tstep; const char* cB = (const char*)g.Bt + (size_t)cur.pn * tstep;
    S.a_ready(cur);
    if constexpr (SP2) {
        PG8_STAGE(PG8_SB(0, 0), cB, voffB); PG8_STAGE(PG8_SB(0, 1), cB + hstep, voffB); PG8_STAGE(PG8_SA(0, 0), cA, voffA); PG8_STAGE(PG8_SA(0, 1), cA + hstep, voffA);
        if (wr == 1) PG8_BAR;
        PG8_WAIT_V(2); PG8_BAR;
        PG8_STAGE(PG8_SB(1, 0), cB + kstep, voffB); PG8_STAGE(PG8_SA(1, 0), cA + kstep, voffA); PG8_STAGE(PG8_SB(1, 1), cB + hstep + kstep, voffB);
        PG8_WAIT_V(6); PG8_BAR;
    } else {
        PG8_STAGE(PG8_SB(0, 0), cB, voffB); PG8_STAGE(PG8_SA(0, 0), cA, voffA); PG8_STAGE(PG8_SB(0, 1), cB + hstep, voffB); PG8_STAGE(PG8_SA(0, 1), cA + hstep, voffA);
        if (wr == 1) PG8_BAR;
        PG8_WAIT_V(4); PG8_BAR;
        PG8_STAGE(PG8_SB(1, 0), cB + kstep, voffB); PG8_STAGE(PG8_SA(1, 0), cA + kstep, voffA); PG8_STAGE(PG8_SB(1, 1), cB + hstep + kstep, voffB);
        PG8_WAIT_V(6); PG8_BAR;
    }
    for (;;) {
        const bool has_next = S.next(ui + 1, nxt);
        const char* nA = has_next ? (const char*)g.A + (size_t)nxt.pm * tstep : cA; const char* nB = has_next ? (const char*)g.Bt + (size_t)nxt.pn * tstep : cB;
#pragma nounroll
        for (int t = 0; t < nt; t += 2) {
            const bool last = (t == nt - 2);
            const char* a1 = cA + (size_t)(t + 1) * kstep;
            const char* a2 = last ? nA : cA + (size_t)(t + 2) * kstep; const char* b2 = last ? nB : cB + (size_t)(t + 2) * kstep;
            const char* a3 = a2 + kstep; const char* b3 = b2 + kstep;
            if (last && has_next) S.a_ready(nxt);
            if constexpr (SP2) {
            PG8_LDB(B0, 0, 0); PG8_LDB(B1, 0, 1); PG8_SCHED; PG8_LDA(At, 0, 0); PG8_STAGE(PG8_SA(1, 1), a1 + hstep, voffA);
            PG8_WAIT_V(8); PG8_WAIT_L(0); PG8_BAR; PG8_MMA(0, 0, At, B0); PG8_MMA(0, 1, At, B1); PG8_BAR; PG8_SCHED;
            PG8_LDA(At, 0, 1); PG8_STAGE(PG8_SB(0, 0), b2, voffB); PG8_STAGE(PG8_SB(0, 1), b2 + hstep, voffB); PG8_STAGE(PG8_SA(0, 0), a2, voffA);
            PG8_WAIT_V(8); PG8_WAIT_L(0); PG8_BAR; PG8_MMA(1, 0, At, B0); PG8_MMA(1, 1, At, B1); PG8_BAR; PG8_SCHED;
            PG8_LDB(B0, 1, 0); PG8_LDB(B1, 1, 1); PG8_SCHED; PG8_LDA(At, 1, 0); PG8_STAGE(PG8_SA(0, 1), a2 + hstep, voffA);
            PG8_WAIT_V(8); PG8_WAIT_L(0); PG8_BAR; PG8_MMA(0, 0, At, B0); PG8_MMA(0, 1, At, B1); PG8_BAR; PG8_SCHED;
            PG8_LDA(At, 1, 1); PG8_STAGE(PG8_SB(1, 0), b3, voffB); PG8_STAGE(PG8_SB(1, 1), b3 + hstep, voffB); PG8_STAGE(PG8_SA(1, 0), a3, voffA);
            PG8_WAIT_V(8); PG8_WAIT_L(0); PG8_BAR; PG8_MMA(1, 0, At, B0); PG8_MMA(1, 1, At, B1); PG8_BAR; PG8_SCHED;
            } else {
            PG8_LDB(B0, 0, 0); PG8_SCHED; PG8_LDA(At, 0, 0); PG8_STAGE(PG8_SA(1, 1), a1 + hstep, voffA);
            PG8_WAIT_L(8); PG8_BAR; PG8_WAIT_L(0); PG8_MMA(0, 0, At, B0); PG8_BAR; PG8_SCHED;
            PG8_LDB(B1, 0, 1); PG8_STAGE(PG8_SB(0, 0), b2, voffB);
            PG8_BAR; PG8_WAIT_L(0); PG8_MMA(0, 1, At, B1); PG8_BAR;
            PG8_LDA(At, 0, 1); PG8_STAGE(PG8_SA(0, 0), a2, voffA);
            PG8_BAR; PG8_WAIT_L(0); PG8_MMA(1, 0, At, B0); PG8_BAR; PG8_SCHED;
            PG8_STAGE(PG8_SB(0, 1), b2 + hstep, voffB);
            PG8_WAIT_V(6); PG8_BAR; PG8_MMA(1, 1, At, B1); PG8_BAR;
            PG8_LDB(B0, 1, 0); PG8_SCHED; PG8_LDA(At, 1, 0); PG8_STAGE(PG8_SA(0, 1), a2 + hstep, voffA);
            PG8_WAIT_L(8); PG8_BAR; PG8_WAIT_L(0); PG8_MMA(0, 0, At, B0); PG8_BAR; PG8_SCHED;
            PG8_LDB(B1, 1, 1); PG8_STAGE(PG8_SB(1, 0), b3, voffB);
            PG8_BAR; PG8_WAIT_L(0); PG8_MMA(0, 1, At, B1); PG8_BAR;
            PG8_LDA(At, 1, 1); PG8_STAGE(PG8_SA(1, 0), a3, voffA);
            PG8_BAR; PG8_WAIT_L(0); PG8_MMA(1, 0, At, B0); PG8_BAR; PG8_SCHED;
            PG8_STAGE(PG8_SB(1, 1), b3 + hstep, voffB);
            PG8_WAIT_V(6); PG8_BAR; PG8_MMA(1, 1, At, B1); PG8_BAR;
            }
        }
        if constexpr (ALIGN_EPI) { if (wr == 0) PG8_BAR; }
        asm volatile("s_nop 15\n\ts_nop 15" ::: "memory");
        if constexpr (!Epi::AFTER_DRAIN) { E(acc, cur, wr, wc, fr, fq); S.done(cur); }
        if (!has_next) break;
#pragma unroll
        for (int a = 0; a < 2; ++a)
#pragma unroll
            for (int b = 0; b < 2; ++b)
#pragma unroll
                for (int m = 0; m < 4; ++m)
#pragma unroll
                    for (int n = 0; n < 2; ++n) acc[a][b][m][n] = (f32x4){0.f, 0.f, 0.f, 0.f};
        cur = nxt; cA = nA; cB = nB; ++ui;
        if constexpr (ALIGN_EPI) { if (wr == 1) PG8_BAR; }
    }
    PG8_WAIT_V(0);
    if constexpr (!ALIGN_EPI) { if (wr == 0) PG8_BAR; }
    PG8_BAR;
    if constexpr (Epi::AFTER_DRAIN) { E.fused(acc, cur, wr, wc, fr, fq, lds, wid, lane); S.done(cur); }
#undef PG8_SA
#undef PG8_SB
#undef PG8_STAGE
#undef PG8_LDA
#undef PG8_LDB
#undef PG8_MMA
#undef PG8_WAIT_V
#undef PG8_WAIT_L
#undef PG8_BAR
#undef PG8_SCHED
}
}

#ifndef PG8_SP2
#define PG8_SP2 true
#endif
#ifndef PG8_ALIGN
#define PG8_ALIGN true
#endif
#include <hip/hip_bf16.h>
#include <cmath>
namespace attn_body {
using bf16=__hip_bfloat16;
using bf16x8=__attribute__((ext_vector_type(8)))short;
using s16x4=__attribute__((ext_vector_type(4)))short;
using f32x16=__attribute__((ext_vector_type(16)))float;
using u32x4=__attribute__((ext_vector_type(4)))unsigned;
constexpr int BATCH=8,NHEAD=8,SEQ=4096,D=64,DM=NHEAD*D,ODM=1024;
constexpr int NW=8,QBLK=32,QB=QBLK*NW,KVBLK=64,NQB=SEQ/QB;
constexpr int ATTN_PITCH=DM, ATTN_UNIT_ROWS=QB;
__device__ __forceinline__ int crow(int r,int hi){return (r&3)+8*(r>>2)+4*hi;}
#define SBAR() __builtin_amdgcn_sched_barrier(0)
__device__ __forceinline__ void cmask(f32x16&p0,f32x16&p1,int jb,int qrel,int hi){
  const float NEG=-INFINITY; int kb=64*jb+4*hi;
  #pragma unroll
  for(int r=0;r<16;++r){int kv=kb+(r&3)+8*(r>>2); if(kv>qrel)p0[r]=NEG; if(kv+32>qrel)p1[r]=NEG;}
}

constexpr int NSLOT=3, SLOTB=8192;
constexpr int LDS_K=0, LDS_V=NSLOT*SLOTB, LDS_WS=2*NSLOT*SLOTB, LDS_OST=LDS_WS+NW*64*4, LDS_BYTES=LDS_OST+NW*4096;
constexpr float C2=0.125f*1.4426950408889634f;
__device__ __forceinline__ void glds16(const void*gsrc,unsigned lds_dst){unsigned keep;
  asm volatile("s_mov_b32 %0, m0\n\ts_mov_b32 m0, %2\n\ts_nop 0\n\tglobal_load_lds_dwordx4 %1, off\n\ts_mov_b32 m0, %0":"=&s"(keep):"v"(gsrc),"s"(lds_dst):"memory");}
__device__ __forceinline__ float max3f(float a,float b,float c){float r;asm("v_max3_f32 %0, %1, %2, %3":"=v"(r):"v"(a),"v"(b),"v"(c));return r;}
__device__ __forceinline__ float max2f(float a,float b){float r;asm("v_max_f32_e32 %0, %1, %2":"=v"(r):"v"(a),"v"(b));return r;}
__device__ __forceinline__ float fadd_s(float a,float b){float r;asm("v_add_f32_e32 %0, %1, %2":"=v"(r):"v"(a),"v"(b));return r;}
__device__ __forceinline__ float fsub_s(float a,float b){float r;asm("v_sub_f32_e32 %0, %1, %2":"=v"(r):"v"(a),"v"(b));return r;}
typedef float f32x2_t __attribute__((ext_vector_type(2))); typedef __bf16 bf16x2_t __attribute__((ext_vector_type(2)));
__device__ __forceinline__ unsigned cvtpk_s(float lo,float hi){f32x2_t v={lo,hi};bf16x2_t b=__builtin_convertvector(v,bf16x2_t);return __builtin_bit_cast(unsigned,b);}
#define WAIT_BAR(N) asm volatile("s_waitcnt vmcnt(" #N ") lgkmcnt(0)\n\ts_barrier":::"memory")

__device__ __forceinline__ void qkt(f32x16&p0,f32x16&p1,const char*Kslot,const bf16x8*qr,const f32x16&negm,int r32,int hi){
  const char*kb=Kslot+hi*1024+r32*16;
  #pragma unroll
  for(int d0=0;d0<4;++d0){
    const bf16x8 b0=*reinterpret_cast<const bf16x8*>(kb+d0*2048);
    const bf16x8 b1=*reinterpret_cast<const bf16x8*>(kb+d0*2048+512);
    if(d0==0){p0=__builtin_amdgcn_mfma_f32_32x32x16_bf16(b0,qr[0],negm,0,0,0);p1=__builtin_amdgcn_mfma_f32_32x32x16_bf16(b1,qr[0],negm,0,0,0);}
    else{p0=__builtin_amdgcn_mfma_f32_32x32x16_bf16(b0,qr[d0],p0,0,0,0);p1=__builtin_amdgcn_mfma_f32_32x32x16_bf16(b1,qr[d0],p1,0,0,0);}}
}
typedef __attribute__((address_space(3))) const char* lds_cptr;
typedef short v4i16_t __attribute__((ext_vector_type(4)));
__device__ __forceinline__ void kload8(bf16x8*kf,lds_cptr kp){
  kf[0]=*(const __attribute__((address_space(3))) bf16x8*)(kp);      kf[1]=*(const __attribute__((address_space(3))) bf16x8*)(kp+512);
  kf[2]=*(const __attribute__((address_space(3))) bf16x8*)(kp+2048); kf[3]=*(const __attribute__((address_space(3))) bf16x8*)(kp+2560);
  kf[4]=*(const __attribute__((address_space(3))) bf16x8*)(kp+4096); kf[5]=*(const __attribute__((address_space(3))) bf16x8*)(kp+4608);
  kf[6]=*(const __attribute__((address_space(3))) bf16x8*)(kp+6144); kf[7]=*(const __attribute__((address_space(3))) bf16x8*)(kp+6656);
}
__device__ __forceinline__ void kload2(bf16x8*kf,lds_cptr kp,int j){ kf[2*j]=*(const __attribute__((address_space(3))) bf16x8*)(kp+j*2048); kf[2*j+1]=*(const __attribute__((address_space(3))) bf16x8*)(kp+j*2048+512); }
__device__ __forceinline__ s16x4 vtr(lds_cptr p){ return __builtin_bit_cast(s16x4,__builtin_amdgcn_ds_read_tr16_b64_v4i16((__attribute__((address_space(3))) v4i16_t*)p)); }
__device__ __forceinline__ float rowmax(const f32x16&p0,const f32x16&p1){
  float a=max3f(p0[0],p0[1],p1[0]),b=max3f(p0[2],p0[3],p1[1]);a=max3f(a,p1[2],p1[3]);
  #pragma unroll
  for(int r=4;r<16;r+=4){a=max3f(a,p0[r],p0[r+1]);b=max3f(b,p0[r+2],p0[r+3]);a=max3f(a,p1[r],p1[r+1]);b=max3f(b,p1[r+2],p1[r+3]);}
  const float m=max2f(a,b);
  auto rr=__builtin_amdgcn_permlane32_swap(__float_as_uint(m),__float_as_uint(m),false,false);
  return max2f(__uint_as_float(rr[0]),__uint_as_float(rr[1]));
}
__device__ __forceinline__ void pv(f32x16*o,int vb,bf16x8 pa0,bf16x8 pa1,bf16x8 pa2,bf16x8 pa3){
  #pragma unroll
  for(int d0=0;d0<2;++d0){s16x4 lo[4],hi[4];
    #pragma unroll
    for(int ks=0;ks<4;++ks){
      asm volatile("ds_read_b64_tr_b16 %0,%1 offset:%c2":"=&v"(lo[ks]):"v"(vb),"i"(d0*4096+ks*1024):"memory");
      asm volatile("ds_read_b64_tr_b16 %0,%1 offset:%c2":"=&v"(hi[ks]):"v"(vb),"i"(d0*4096+ks*1024+512):"memory");}
    asm volatile("s_waitcnt lgkmcnt(0)":::"memory");SBAR();
    #define PK(k) (bf16x8){lo[k][0],lo[k][1],lo[k][2],lo[k][3],hi[k][0],hi[k][1],hi[k][2],hi[k][3]}
    o[d0]=__builtin_amdgcn_mfma_f32_32x32x16_bf16(pa0,PK(0),o[d0],0,0,0);
    o[d0]=__builtin_amdgcn_mfma_f32_32x32x16_bf16(pa1,PK(1),o[d0],0,0,0);
    o[d0]=__builtin_amdgcn_mfma_f32_32x32x16_bf16(pa2,PK(2),o[d0],0,0,0);
    o[d0]=__builtin_amdgcn_mfma_f32_32x32x16_bf16(pa3,PK(3),o[d0],0,0,0);
    #undef PK
  }
}

#ifndef ATTN_STORE16
#define ATTN_STORE16(p,v) (*(u32x4*)(p)=(v))
#endif
template<int THRL> __device__ __forceinline__ void attn_unit(int b,int h,int qb,const bf16*Q,const bf16*__restrict__ K,const bf16*__restrict__ V,bf16*O,const unsigned short*SEL,char*shm){
  const int tid=threadIdx.x,lane=tid&63,r32=lane&31,hi=lane>>5; const int wid=__builtin_amdgcn_readfirstlane(tid>>6);
  const long rowbase=(long)b*SEQ; const int q0=qb*QB;
  const bf16*Qw=Q+(rowbase+q0+wid*QBLK)*DM+h*D;
  const bf16*Kh=K+rowbase*DM+h*D,*Vh=V+rowbase*DM+h*D;
  const unsigned lds0=(unsigned)(uintptr_t)shm;
  float*wsf=(float*)(shm+LDS_WS)+wid*64;
  const bf16*ksrc=Kh+(long)lane*DM+wid*8;
  const bf16*vsrc=Vh+(long)(16*(wid&3)+(lane>>2))*DM+(wid>>2)*32+(lane&3)*8;
  const unsigned kdst=lds0+LDS_K+wid*1024, vdst=lds0+LDS_V+wid*1024;
  #define DMA_K(t,slot) glds16(ksrc+(long)(t)*KVBLK*DM,(unsigned)__builtin_amdgcn_readfirstlane(kdst+(slot)))
  #define DMA_V(t,slot) glds16(vsrc+(long)(t)*KVBLK*DM,(unsigned)__builtin_amdgcn_readfirstlane(vdst+(slot)))
  const int vb0=(int)(lds0+LDS_V)+((lane>>4)&1)*32+(lane&3)*8+(4*hi+((lane&15)>>2))*64;
  const char*Kbase=shm+LDS_K; bf16x8 kf[8];
  const lds_cptr shm3=(lds_cptr)shm; const lds_cptr kp0=shm3+LDS_K+hi*1024+r32*16; const lds_cptr vp0=shm3+LDS_V+((lane>>4)&1)*32+(lane&3)*8+(4*hi+((lane&15)>>2))*64;
  const int NT=(q0+QB)/KVBLK;
  DMA_K(0,0);DMA_V(0,0);DMA_K(1,SLOTB);
  bf16x8 qr[4];
  #pragma unroll
  for(int d0=0;d0<4;++d0)qr[d0]=*reinterpret_cast<const bf16x8*>(&Qw[(long)r32*DM+d0*16+hi*8]);
  float mhat=0.f,l_reg=0.f;f32x16 o[2];o[0]=f32x16{};o[1]=f32x16{};f32x16 negm=f32x16{};asm volatile("":"+v"(negm));
  const int qrel=wid*QBLK+r32;
  const unsigned selm=(unsigned)SEL[((long)(b*NHEAD+h))*SEQ+q0+qrel]|(1u<<qb);
  #define SELNEGM(t) do{ const bool on_=((selm>>((t)>>2))&1u)!=0u; const float nv_=on_?-mhat:-INFINITY; _Pragma("unroll") for(int r=0;r<16;++r)negm[r]=nv_; asm volatile("s_nop 7":"+v"(negm)); }while(0)
  #define CMASK(P0,P1,t) do{int jb_=(t)-(NT-4); if(jb_>=0)cmask(P0,P1,jb_,qrel,hi);}while(0)
  bool resc=false;
  #define START(P0,P1) do{ const float rm=rowmax(P0,P1); resc=false; \
    { const float dl=(rm==-INFINITY)?0.f:rm; mhat=fadd_s(mhat,dl); \
      _Pragma("unroll") for(int r=0;r<16;++r){P0[r]=fsub_s(P0[r],dl);P1[r]=fsub_s(P1[r],dl);} \
      _Pragma("unroll") for(int r=0;r<16;++r)negm[r]=-mhat; asm volatile("":"+v"(negm)); } \
    _Pragma("unroll") for(int r=0;r<16;++r)P0[r]=__builtin_amdgcn_exp2f(P0[r]); }while(0)
  #define RESC() do{ if(resc){ asm volatile("s_waitcnt lgkmcnt(0)":::"memory"); \
      _Pragma("unroll") for(int d_=0;d_<2;++d_) _Pragma("unroll") for(int r=0;r<16;++r)o[d_][r]*=wsf[crow(r,hi)]; } }while(0)
  f32x16 pA0,pA1,pB0,pB1;
  int sl_prev=0,sl_cur=0,sl_next=SLOTB;
  #define ROT() do{sl_prev=sl_cur;sl_cur=sl_next;sl_next=(sl_next==(NSLOT-1)*SLOTB)?0:sl_next+SLOTB;}while(0)
  DMA_K(2,2*SLOTB);
  WAIT_BAR(3);
  SELNEGM(0);
  qkt(pA0,pA1,Kbase,qr,negm,r32,hi);asm volatile("s_nop 15\n\ts_nop 7":"+v"(pA0),"+v"(pA1));CMASK(pA0,pA1,0);
  START(pA0,pA1);
  _Pragma("unroll") for(int r=0;r<16;++r)pA1[r]=__builtin_amdgcn_exp2f(pA1[r]);
  WAIT_BAR(0);
  DMA_K(3,0);DMA_V(1,SLOTB);
  ROT();
  kload8(kf,kp0+sl_cur);
  WAIT_BAR(2);
  s16x4 vlo[8],vhi[8]; u32x4 pw0,pw1,pw2,pw3;
  #define PKW(P,B) cvtpk_s(P[B],P[B+1])
  #define PAF(k) __builtin_bit_cast(bf16x8,pw##k)
  #define VFR(i) (bf16x8){vlo[i][0],vlo[i][1],vlo[i][2],vlo[i][3],vhi[i][0],vhi[i][1],vhi[i][2],vhi[i][3]}
  #define PIN(x) asm volatile("":"+v"(x))
  #define MX3(a,b,c) __builtin_fmaxf(__builtin_fmaxf((a),(b)),(c))
  #define GAPA(MF,A0,A1,A2,A3,W0,W1,PW) do{ MF; sacc+=A0; sacc+=A1; sacc+=A2; sacc+=A3; PIN(sacc); W0; W1; PIN(PW); SBAR(); }while(0)
  #define EX(v) __builtin_amdgcn_exp2f(v)
  #define GAPB(MF,X,B) do{ MF; X[B]=EX(X[B]); X[B+1]=EX(X[B+1]); X[B+2]=EX(X[B+2]); X[B+3]=EX(X[B+3]); PIN(X); SBAR(); }while(0)
  #define VRD(i) do{ vlo[i]=vtr(vp_+(((i)>>2)*4096+((i)&3)*1024)); vhi[i]=vtr(vp_+(((i)>>2)*4096+((i)&3)*1024+512)); }while(0)
  #define KRD(G,j) do{ if(G){ kload2(kf,kp0+sl_next,j); SBAR(); } }while(0)
  #define STEP(C0,C1,P0,P1,t,GK,GV,GL) do{ SBAR(); SELNEGM(t); SBAR(); \
    const lds_cptr vp_=vp0+sl_prev; \
    VRD(0); SBAR(); float sacc=(P0[0]+P0[1]); \
    GAPA(C0=__builtin_amdgcn_mfma_f32_32x32x16_bf16(kf[0],qr[0],negm,0,0,0), P0[2],P0[3],P0[4],P0[5],     pw0[0]=PKW(P0,0), pw0[1]=PKW(P0,2), pw0); \
    VRD(4); SBAR(); GAPA(C1=__builtin_amdgcn_mfma_f32_32x32x16_bf16(kf[1],qr[0],negm,0,0,0), P0[6],P0[7],P0[8],P0[9],     pw0[2]=PKW(P0,4), pw0[3]=PKW(P0,6), pw0); \
    VRD(1); SBAR(); GAPA(C0=__builtin_amdgcn_mfma_f32_32x32x16_bf16(kf[2],qr[1],C0,0,0,0),   P0[10],P0[11],P0[12],P0[13], pw1[0]=PKW(P0,8), pw1[1]=PKW(P0,10), pw1); \
    VRD(5); SBAR(); GAPA(C1=__builtin_amdgcn_mfma_f32_32x32x16_bf16(kf[3],qr[1],C1,0,0,0),   P0[14],P0[15],P1[0],P1[1],   pw1[2]=PKW(P0,12),pw1[3]=PKW(P0,14), pw1); \
    VRD(2); SBAR(); GAPA(C0=__builtin_amdgcn_mfma_f32_32x32x16_bf16(kf[4],qr[2],C0,0,0,0),   P1[2],P1[3],P1[4],P1[5],     pw2[0]=PKW(P1,0), pw2[1]=PKW(P1,2), pw2); \
    VRD(6); SBAR(); GAPA(C1=__builtin_amdgcn_mfma_f32_32x32x16_bf16(kf[5],qr[2],C1,0,0,0),   P1[6],P1[7],P1[8],P1[9],     pw2[2]=PKW(P1,4), pw2[3]=PKW(P1,6), pw2); \
    VRD(3); SBAR(); GAPA(C0=__builtin_amdgcn_mfma_f32_32x32x16_bf16(kf[6],qr[3],C0,0,0,0),   P1[10],P1[11],P1[12],P1[13], pw3[0]=PKW(P1,8), pw3[1]=PKW(P1,10), pw3); \
    VRD(7); SBAR(); GAPA(C1=__builtin_amdgcn_mfma_f32_32x32x16_bf16(kf[7],qr[3],C1,0,0,0),   P1[14],P1[15],0.f,0.f,       pw3[2]=PKW(P1,12),pw3[3]=PKW(P1,14), pw3); \
    l_reg+=sacc; \
    if(GK){DMA_K((t)+3,sl_cur);} if(GV){DMA_V((t)+1,sl_next);} \
    CMASK(C0,C1,t); \
    { float a=MX3(C0[0],C0[1],C1[0]),b=MX3(C0[2],C0[3],C1[1]); a=MX3(a,C1[2],C1[3]); \
      _Pragma("unroll") for(int r=4;r<16;r+=4){a=MX3(a,C0[r],C0[r+1]);b=MX3(b,C0[r+2],C0[r+3]);a=MX3(a,C1[r],C1[r+1]);b=MX3(b,C1[r+2],C1[r+3]);} \
      float rm=__builtin_fmaxf(a,b); { auto rr=__builtin_amdgcn_permlane32_swap(__float_as_uint(rm),__float_as_uint(rm),false,false); rm=__builtin_fmaxf(__uint_as_float(rr[0]),__uint_as_float(rr[1])); } \
      resc=false; \
      if(__builtin_expect(__any(rm>(float)THRL),0)){ const float dl=__builtin_fmaxf(rm,0.f); mhat+=dl; \
        _Pragma("unroll") for(int r=0;r<16;++r){C0[r]-=dl;C1[r]-=dl;} \
        _Pragma("unroll") for(int r=0;r<16;++r)negm[r]=-mhat; asm volatile("":"+v"(negm)); \
        const float f=__builtin_amdgcn_exp2f(-dl); l_reg*=f; if(hi==0)wsf[r32]=f; resc=true; } } \
    SBAR(); \
    GAPB(o[0]=__builtin_amdgcn_mfma_f32_32x32x16_bf16(PAF(0),VFR(0),o[0],0,0,0), C0,0); \
    GAPB(o[1]=__builtin_amdgcn_mfma_f32_32x32x16_bf16(PAF(0),VFR(4),o[1],0,0,0), C0,4); \
    KRD(GL,0); GAPB(o[0]=__builtin_amdgcn_mfma_f32_32x32x16_bf16(PAF(1),VFR(1),o[0],0,0,0), C0,8); \
    KRD(GL,1); GAPB(o[1]=__builtin_amdgcn_mfma_f32_32x32x16_bf16(PAF(1),VFR(5),o[1],0,0,0), C0,12); \
    KRD(GL,2); GAPB(o[0]=__builtin_amdgcn_mfma_f32_32x32x16_bf16(PAF(2),VFR(2),o[0],0,0,0), C1,0); \
    KRD(GL,3); GAPB(o[1]=__builtin_amdgcn_mfma_f32_32x32x16_bf16(PAF(2),VFR(6),o[1],0,0,0), C1,4); \
    GAPB(o[0]=__builtin_amdgcn_mfma_f32_32x32x16_bf16(PAF(3),VFR(3),o[0],0,0,0), C1,8); \
    GAPB(o[1]=__builtin_amdgcn_mfma_f32_32x32x16_bf16(PAF(3),VFR(7),o[1],0,0,0), C1,12); \
    }while(0)
  int t=1;
  #undef CMASK
  #define CMASK(P0,P1,t) do{}while(0)
  for(;t+5<NT;t+=2){
    STEP(pB0,pB1,pA0,pA1,t,true,true,true);     WAIT_BAR(2); RESC(); ROT();
    STEP(pA0,pA1,pB0,pB1,t+1,true,true,true);   WAIT_BAR(2); RESC(); ROT();
  }
  #undef CMASK
  #define CMASK(P0,P1,t) do{int jb_=(t)-(NT-4); if(jb_>=0)cmask(P0,P1,jb_,qrel,hi);}while(0)
  #define ENDW(tt) do{ if((tt)+3<NT){WAIT_BAR(2);} else if((tt)+2<NT){WAIT_BAR(1);} else {WAIT_BAR(0);} }while(0)
  for(;t+1<NT;t+=2){
    STEP(pB0,pB1,pA0,pA1,t,(t+3<NT),(t+1<NT),(t+1<NT));       ENDW(t);   RESC(); ROT();
    STEP(pA0,pA1,pB0,pB1,t+1,(t+4<NT),(t+2<NT),(t+2<NT));     ENDW(t+1); RESC(); ROT();
  }
  STEP(pB0,pB1,pA0,pA1,NT-1,false,false,false); RESC();
  { float sacc=pB0[0]+pB0[1]; _Pragma("unroll") for(int r=2;r<16;++r)sacc+=pB0[r]; _Pragma("unroll") for(int r=0;r<16;++r)sacc+=pB1[r]; l_reg+=sacc;
    pw0=(u32x4){PKW(pB0,0),PKW(pB0,2),PKW(pB0,4),PKW(pB0,6)};pw1=(u32x4){PKW(pB0,8),PKW(pB0,10),PKW(pB0,12),PKW(pB0,14)};pw2=(u32x4){PKW(pB1,0),PKW(pB1,2),PKW(pB1,4),PKW(pB1,6)};pw3=(u32x4){PKW(pB1,8),PKW(pB1,10),PKW(pB1,12),PKW(pB1,14)};
    SBAR(); pv(o,vb0+sl_cur,PAF(0),PAF(1),PAF(2),PAF(3)); }
  #undef PKW
  #undef PAF
  #undef VFR
  #undef PIN
  #undef MX3
  #undef GAPA
  #undef GAPB
  #undef EX
  #undef VRD
  #undef KRD
  #undef STEP
  #undef ENDW
  {auto rr=__builtin_amdgcn_permlane32_swap(__float_as_uint(l_reg),__float_as_uint(l_reg),false,false);l_reg=__uint_as_float(rr[0])+__uint_as_float(rr[1]);}
  if(hi==0)wsf[32+r32]=l_reg;asm volatile("s_waitcnt lgkmcnt(0)":::"memory");
  float rli[16];
  #pragma unroll
  for(int r=0;r<16;++r)rli[r]=__builtin_amdgcn_rcpf(wsf[32+crow(r,hi)]);
  bf16*Ow=O+(rowbase+q0+wid*QBLK)*ODM+h*D;
  { bf16*stg=(bf16*)(shm+LDS_OST)+wid*2048;
    #pragma unroll
    for(int r=0;r<16;++r){const int orow=crow(r,hi);
      #pragma unroll
      for(int d0=0;d0<2;++d0)stg[orow*64+d0*32+r32]=__float2bfloat16(o[d0][r]*rli[r]);}
    asm volatile("s_waitcnt lgkmcnt(0)":::"memory");
    #pragma unroll
    for(int i=0;i<4;++i){const int row=i*8+(lane>>3),ch=lane&7; const u32x4 v=*(const u32x4*)(stg+row*64+ch*8); ATTN_STORE16(Ow+(long)row*ODM+ch*8,v);} }
  asm volatile("s_waitcnt lgkmcnt(0)\n\ts_barrier":::"memory");
  #undef DMA_K
  #undef DMA_V
  #undef CMASK
  #undef START
  #undef RESC
  #undef ROT
  #undef SELNEGM
}
constexpr int ATTN_LDS_BYTES=LDS_BYTES;
struct AttnTensors { const bf16* Q; const bf16* K; const bf16* V; bf16* O; const unsigned short* SEL; };
struct AttnUnit { int bh; int qb; };
struct StaticOrder {
  int vcu,G;
  __device__ __forceinline__ explicit StaticOrder(int grid,int block):vcu((grid%8==0)?(block%8)*(grid/8)+block/8:block),G(grid){}
  __device__ __forceinline__ bool next(int i,AttnUnit&u)const{ const int v=vcu+(i>>2)*G; if(v>=256)return false; const int s=v&3,k=i&3; u.bh=v>>2; u.qb=(k==0)?s:(k==1)?7-s:(k==2)?8+s:15-s; return true; }
  __device__ __forceinline__ void a_ready(const AttnUnit&)const{}
  __device__ __forceinline__ void done(const AttnUnit&)const{}
};
template<class Sched,int THRL=8> __device__ __forceinline__ void attn_phase(char*lds,const AttnTensors&T,const Sched&S){
  AttnUnit u;
  for(int i=0;S.next(i,u);++i){ S.a_ready(u); attn_unit<THRL>(u.bh/NHEAD,u.bh%NHEAD,u.qb,T.Q,T.K,T.V,T.O,T.SEL,lds); S.done(u); }
}
#undef SBAR
#undef WAIT_BAR
}
constexpr int NWAVES = 8;
constexpr int BATCH = 8, SEQ = 4096, D = 1024, M = BATCH * SEQ, FF = 2816, NGU = 2 * FF, NIN = 2560, AW = 512, MW = 512;
constexpr int MH = 4, MHD = 128, AHN = 8, NB = 16;
constexpr int SV = 144;
constexpr float EPS = 1e-6f;
constexpr size_t MiB = 1u << 20;
constexpr size_t WS_CTL = 0, CTL_ZERO_BYTES = 32768;
constexpr size_t WS_MOD = 1 * MiB;
constexpr size_t WS_WGU1 = 2 * MiB, WS_WD1 = 13 * MiB, WS_WGU2 = 19 * MiB, WS_WD2 = 30 * MiB, WS_WIN = 36 * MiB, WS_WOUT = 41 * MiB;
constexpr size_t WS_WQM = 43 * MiB, WS_WKM = WS_WQM + 131072, WS_WVM = WS_WKM + 131072, WS_WEC = WS_WVM + 131072, WS_WEM = WS_WEC + 16384;
constexpr size_t WS_KMEAN = 48 * MiB  , WS_SEL = 50 * MiB + 524288, WS_GP = 51 * MiB, WS_GSUP = 55 * MiB;
constexpr size_t WS_BW2 = 56 * MiB, WS_BW3 = 56 * MiB + 131072, WS_SSQ1 = 58 * MiB, WS_SSQ2 = 60 * MiB;
constexpr size_t WS_XN = 64 * MiB, WS_KMT = 64 * MiB, WS_VMT = 96 * MiB;
constexpr size_t WS_HB = 128 * MiB, WS_Q = 128 * MiB, WS_K = 160 * MiB, WS_V = 192 * MiB, WS_XM = 224 * MiB, WS_Z = 256 * MiB, WS_SST = 224 * MiB;
constexpr size_t WS_QM = 304 * MiB, WS_KM = 336 * MiB, WS_XC = 368 * MiB, WS_DST = 400 * MiB, WS_CAT = 448 * MiB, WS_END = 512 * MiB;
static_assert(WS_HB + (size_t)M * FF * 2 <= WS_QM && WS_DST + (size_t)512 * SV * 128 * 4 <= WS_CAT && WS_SST + (size_t)512 * SV * 128 * 2 <= WS_Z, "d_ws map");
constexpr int CW_TMO = 0, CW_CODE = 1, CW_BAR = 4096;
constexpr int RING_OFF = 0, RING_BYTES = 131072;
constexpr int LDSCTL_OFF = RING_BYTES, MISC_OFF = LDSCTL_OFF + 320;
constexpr int LDS_BYTES = 147456;
#define GAS __attribute__((address_space(1)))
#define LAS __attribute__((address_space(3)))
typedef unsigned short bf16;
typedef unsigned v4u __attribute__((ext_vector_type(4)));
typedef float f32x4 __attribute__((ext_vector_type(4)));
typedef short bf16x8 __attribute__((ext_vector_type(8)));
typedef GAS unsigned gu32;
typedef GAS unsigned long long gu64;
#define RLX_AGENT __ATOMIC_RELAXED, __HIP_MEMORY_SCOPE_AGENT
#define LDS_WAIT() asm volatile("s_waitcnt lgkmcnt(0)" ::: "memory")
#define VM_WAIT() asm volatile("s_waitcnt vmcnt(0)" ::: "memory")
__device__ __forceinline__ unsigned long long rt() { return __builtin_amdgcn_s_memrealtime(); }
__device__ __forceinline__ unsigned f2bf(float f) { unsigned u = __builtin_bit_cast(unsigned, f); return (u + 0x7fffu + ((u >> 16) & 1u)) >> 16; }
__device__ __forceinline__ unsigned pk2(float lo, float hi) { return f2bf(lo) | (f2bf(hi) << 16); }

#define XB_TMO      128
#define XB_XCNT(j)  (256  + 64 * (j))
#define XB_XSUB(j)  (1280 + 64 * (j))
#define XB_XGEN(j)  (2304 + 64 * (j))
#define XB_TOP      3328
#define XB_TOPGEN   3392
#define XCD_BAR_WORDS 3456
#define XB_SPIN_CAP (1u << 18)

__device__ __forceinline__ unsigned xb_ld(unsigned* p)              { return __hip_atomic_load(p, __ATOMIC_RELAXED, __HIP_MEMORY_SCOPE_AGENT); }
__device__ __forceinline__ unsigned xb_add(unsigned* p, unsigned v) { return __hip_atomic_fetch_add(p, v, __ATOMIC_RELAXED, __HIP_MEMORY_SCOPE_AGENT); }
__device__ __forceinline__ unsigned xb_xcc_id() { return (unsigned)__builtin_amdgcn_s_getreg((3 << 11) | 20) & 0xFu; }
#define XB_SPIN(cond, bar) do { unsigned _sp = 0; while (cond) { __builtin_amdgcn_s_sleep(1); \
    if ((++_sp & 255u) == 0u) { if (xb_ld(&(bar)[XB_TMO])) break; if (_sp > XB_SPIN_CAP) { atomicAdd(&(bar)[XB_TMO], 1u); break; } } } } while (0)

struct XcdBarrier {
    unsigned* bar; unsigned x;
    volatile LAS unsigned* st;
};

__device__ __forceinline__ XcdBarrier xcd_barrier_post(unsigned* bar, volatile LAS unsigned* st) {
    XcdBarrier b; b.bar = bar; b.x = xb_xcc_id(); b.st = st;
    if (threadIdx.x == 0) (void)xb_add(&bar[XB_XCNT(b.x)], 1u);
    return b;
}
__device__ __forceinline__ void xcd_barrier_complete(unsigned* bar, unsigned x, unsigned& nloc, unsigned& nx) {
    const unsigned G = gridDim.x * gridDim.y * gridDim.z;
    unsigned sum, cnt, mine, sp = 0u;
    for (;;) {
        sum = 0u; cnt = 0u; mine = 0u;
#pragma unroll
        for (unsigned j = 0; j < 16; ++j) { const unsigned c = xb_ld(&bar[XB_XCNT(j)]); sum += c; cnt += (c > 0u) ? 1u : 0u; mine = (j == x) ? c : mine; }
        if (sum == G) break;
        __builtin_amdgcn_s_sleep(1);
        if ((++sp & 255u) == 0u) { if (xb_ld(&bar[XB_TMO])) break; if (sp > XB_SPIN_CAP) { atomicAdd(&bar[XB_TMO], 1u); break; } }
    }
    nloc = mine > 0u ? mine : 1u; nx = cnt > 0u ? cnt : 1u;
}

__device__ __forceinline__ void xcd_barrier(const XcdBarrier& b) {
    asm volatile("s_waitcnt vmcnt(0)" ::: "memory");
    __syncthreads();
    if (threadIdx.x == 0) {
        unsigned* bar = b.bar;
        __builtin_amdgcn_s_waitcnt(0);
        unsigned nloc = b.st[0], nx = b.st[1];
        if (nloc == 0u) { xcd_barrier_complete(bar, b.x, nloc, nx); b.st[0] = nloc; b.st[1] = nx; }
        const unsigned old = xb_add(&bar[XB_XSUB(b.x)], 1u);
        const unsigned gen = old / nloc;
        if (old + 1u == (gen + 1u) * nloc) {
            __builtin_amdgcn_fence(__ATOMIC_RELEASE, "agent");
            asm volatile("s_waitcnt vmcnt(0)" ::: "memory");
            const unsigned og = xb_add(&bar[XB_TOP], 1u);
            const unsigned tg = og / nx;
            if (og + 1u == (tg + 1u) * nx) xb_add(&bar[XB_TOPGEN], 1u);
            else XB_SPIN(xb_ld(&bar[XB_TOPGEN]) == tg, bar);
            __builtin_amdgcn_fence(__ATOMIC_ACQUIRE, "agent");
            xb_add(&bar[XB_XGEN(b.x)], 1u);
            asm volatile("s_waitcnt vmcnt(0)" ::: "memory");
        } else {
            XB_SPIN(xb_ld(&bar[XB_XGEN(b.x)]) == gen, bar);
            __builtin_amdgcn_fence(__ATOMIC_ACQUIRE, "agent");
            asm volatile("s_waitcnt vmcnt(0)" ::: "memory");
        }
    }
    __syncthreads();
}

#define EV_SUB(e, x) (512 + 256 * (e) + 8 * (x))
#define EV_TOP(e)    (512 + 256 * (e) + 192)
__device__ __forceinline__ void ev_arrive(const XcdBarrier& b, unsigned* ctl, int e) {
    asm volatile("s_waitcnt vmcnt(0)" ::: "memory");
    __syncthreads();
    if (threadIdx.x == 0) {
        __builtin_amdgcn_s_waitcnt(0);
        unsigned nloc = b.st[0], nx = b.st[1];
        if (nloc == 0u) { xcd_barrier_complete(b.bar, b.x, nloc, nx); b.st[0] = nloc; b.st[1] = nx; }
        const unsigned old = xb_add(&ctl[EV_SUB(e, b.x)], 1u);
        if (old + 1u == nloc) {
            __builtin_amdgcn_fence(__ATOMIC_RELEASE, "agent");
            asm volatile("s_waitcnt vmcnt(0)" ::: "memory");
            xb_add(&ctl[EV_TOP(e)], 1u);
        }
    }
}
__device__ __forceinline__ void ev_wait(const XcdBarrier& b, unsigned* ctl, int e) {
    if (threadIdx.x == 0) {
        const unsigned nx = b.st[1];
        XB_SPIN(xb_ld(&ctl[EV_TOP(e)]) < nx, b.bar);
        __builtin_amdgcn_fence(__ATOMIC_ACQUIRE, "agent");
        asm volatile("s_waitcnt vmcnt(0)" ::: "memory");
    }
    __syncthreads();
}
#define DEVI __device__ __forceinline__
typedef unsigned u32x2 __attribute__((ext_vector_type(2)));
typedef float f32x2 __attribute__((ext_vector_type(2)));
DEVI float bf2f(unsigned short v) { return __builtin_bit_cast(float, (unsigned)v << 16); }
DEVI float bflo(unsigned w) { return __builtin_bit_cast(float, w << 16); }
DEVI float bfhi(unsigned w) { return __builtin_bit_cast(float, w & 0xffff0000u); }
DEVI float wave_sum(float v) {
#pragma unroll
    for (int o = 1; o < 64; o <<= 1) v += __shfl_xor(v, o);
    return v;
}
DEVI float silu_f(float x) { return x * __builtin_amdgcn_rcpf(1.0f + __builtin_amdgcn_exp2f(x * -1.4426950408889634f)); }
#define MMA16(p1, p2, acc) __builtin_amdgcn_mfma_f32_16x16x32_bf16(p1, p2, acc, 0, 0, 0)
DEVI bf16x8 ldfrag(const LAS unsigned char* img, int stride, int row0, int k0, int lane) {
    return *(const LAS bf16x8*)(img + (row0 + (lane & 15)) * stride + (k0 + 8 * (lane >> 4)) * 2);
}

DEVI void phase_mod(const float* c, const float* w_ada, const float* b_ada, const float* n1, const float* n2, const float* n3, float* MOD,
                    LAS unsigned char* lds, int vcu, int G, int tid) {
    LAS float* cb = (LAS float*)lds;
    LAS float* part = cb + 8192;
    { float tmpc[16];
#pragma unroll
      for (int j = 0; j < 16; ++j) tmpc[j] = c[tid + 512 * j];
#pragma unroll
      for (int j = 0; j < 16; ++j) { const int i = tid + 512 * j, b = i >> 10, k = i & 1023; cb[k * 8 + b] = tmpc[j]; } }
    __syncthreads();
    const int lane = tid & 63, wave = tid >> 6;
    constexpr int NC = 9 * D;
    int per = (NC + G - 1) / G; if (per > 64) per = 64;
    for (int base = vcu * per; base < NC; base += G * per) {
        const int j = base + lane; const bool act = lane < per && j < NC;
        float acc[8];
#pragma unroll
        for (int b = 0; b < 8; ++b) acc[b] = 0.f;
        if (act) {
            const float* wp = w_ada + (size_t)(wave * 128) * NC + j;
#pragma nounroll
            for (int kb = 0; kb < 128; kb += 32) { float wvv[32];
#pragma unroll
            for (int k = 0; k < 32; ++k) wvv[k] = wp[(size_t)(kb + k) * NC];
#pragma unroll
            for (int kk = 0; kk < 32; ++kk) { const int k = kb + kk;
                const float wv = wvv[kk];
                const LAS f32x4* cp = (const LAS f32x4*)(cb + (wave * 128 + k) * 8); const f32x4 c0 = cp[0], c1 = cp[1];
                acc[0] += c0.x * wv; acc[1] += c0.y * wv; acc[2] += c0.z * wv; acc[3] += c0.w * wv;
                acc[4] += c1.x * wv; acc[5] += c1.y * wv; acc[6] += c1.z * wv; acc[7] += c1.w * wv;
            } }
        }
#pragma unroll
        for (int b = 0; b < 8; ++b) part[(wave * 8 + b) * 64 + lane] = acc[b];
        __syncthreads();
        { const int b = tid >> 6;
          if (act) { float s = 0.f;
#pragma unroll
              for (int w = 0; w < 8; ++w) s += part[(w * 8 + b) * 64 + lane];
              s += b_ada[j];
              const int i = j >> 10, d = j & 1023, r3 = i % 3; float v;
              if (r3 == 0) v = s;
              else if (r3 == 1) { const float* nw = (i == 1) ? n1 : (i == 4) ? n2 : n3; v = nw[d] * (1.0f + s); }
              else v = ((i == 5) ? 1.0f : 0.5f) * (1.0f + s);
              MOD[(size_t)(i * 8 + b) * D + d] = v; } }
        __syncthreads();
    }
}

DEVI void transpose_item(const float* W, int K, int N, bf16* WT, int mode, float scale, LAS float* scr, int item, int lane) {
    const int nblk = N / 32, kb = item / nblk, nb = item % nblk, k0 = 64 * kb, n0 = 32 * nb;
    const int rb = (mode == 0) ? n0 : ((n0 >> 7) * 256 + (n0 & 127) + (mode == 2 ? 128 : 0));
#pragma unroll
    for (int i = 0; i < 32; ++i) { const int kk = 2 * i + (lane >> 5); scr[kk * 33 + (lane & 31)] = W[(size_t)(k0 + kk) * N + n0 + (lane & 31)] * scale; }
    LDS_WAIT(); asm volatile("" ::: "memory");
    const int c = lane & 7;
#pragma unroll
    for (int j = 0; j < 4; ++j) { const int n = (lane >> 3) + 8 * j; const LAS float* s = scr + (8 * c) * 33 + n;
        v4u o; o.x = pk2(s[0 * 33], s[1 * 33]); o.y = pk2(s[2 * 33], s[3 * 33]); o.z = pk2(s[4 * 33], s[5 * 33]); o.w = pk2(s[6 * 33], s[7 * 33]);
        *(GAS v4u*)(WT + (size_t)(rb + n) * K + k0 + 8 * c) = o; }
    LDS_WAIT(); asm volatile("" ::: "memory");
}
DEVI unsigned pk4_fp8(float a, float b, float c, float d) {
    a = fminf(fmaxf(a, -448.f), 448.f); b = fminf(fmaxf(b, -448.f), 448.f); c = fminf(fmaxf(c, -448.f), 448.f); d = fminf(fmaxf(d, -448.f), 448.f);
    int w = __builtin_amdgcn_cvt_pk_fp8_f32(a, b, 0, false); w = __builtin_amdgcn_cvt_pk_fp8_f32(c, d, w, true); return (unsigned)w;
}
constexpr float W8SCALE_UP = 32.f, W8SCALE_DN = 64.f;
DEVI void transpose_item8(const float* W, int K, int N, unsigned char* WT, int mode, float scale, LAS float* scr, int item, int lane) {
    const int nblk = N / 32, kb = item / nblk, nb = item % nblk, k0 = 64 * kb, n0 = 32 * nb;
    const int rb = (mode == 0) ? n0 : ((n0 >> 7) * 256 + (n0 & 127) + (mode == 2 ? 128 : 0));
#pragma unroll
    for (int i = 0; i < 32; ++i) { const int kk = 2 * i + (lane >> 5); scr[kk * 33 + (lane & 31)] = W[(size_t)(k0 + kk) * N + n0 + (lane & 31)] * scale; }
    LDS_WAIT(); asm volatile("" ::: "memory");
#pragma unroll
    for (int j = 0; j < 2; ++j) { const int idx = lane + 64 * j, n = idx >> 2, c = idx & 3; const LAS float* s = scr + (16 * c) * 33 + n;
        v4u o; o.x = pk4_fp8(s[0 * 33], s[1 * 33], s[2 * 33], s[3 * 33]); o.y = pk4_fp8(s[4 * 33], s[5 * 33], s[6 * 33], s[7 * 33]);
        o.z = pk4_fp8(s[8 * 33], s[9 * 33], s[10 * 33], s[11 * 33]); o.w = pk4_fp8(s[12 * 33], s[13 * 33], s[14 * 33], s[15 * 33]);
        *(GAS v4u*)(WT + (size_t)(rb + n) * K + k0 + 16 * c) = o; }
    LDS_WAIT(); asm volatile("" ::: "memory");
}
DEVI void modnorm_rows8(const float* X, const float* A, const float* Bv, unsigned char* XN8, int gw, int NGW, int lane) {
    constexpr int R = 4;
    const int RPW = (M + NGW - 1) / NGW, mbeg = gw * RPW, mend = (mbeg + RPW < M) ? mbeg + RPW : M;
    int bcur = -1; f32x4 av[4], bv[4];
    for (int m0 = mbeg; m0 < mend; m0 += R) {
        f32x4 v[R][4];
#pragma unroll
        for (int r = 0; r < R; ++r) { const int m = m0 + r; const GAS f32x4* xr = (const GAS f32x4*)(X + (size_t)(m < mend ? m : mbeg) * D) + lane;
#pragma unroll
            for (int j = 0; j < 4; ++j) v[r][j] = __builtin_nontemporal_load(xr + 64 * j); }
#pragma unroll
        for (int r = 0; r < R; ++r) { const int m = m0 + r; if (m >= mend) break; const int b = m / SEQ; float s = 0.f;
            if (b != bcur) { bcur = b; const f32x4* ap = (const f32x4*)(A + (size_t)b * D) + lane; const f32x4* bp = (const f32x4*)(Bv + (size_t)b * D) + lane;
#pragma unroll
                for (int j = 0; j < 4; ++j) { av[j] = ap[64 * j]; bv[j] = bp[64 * j]; } }
#pragma unroll
            for (int j = 0; j < 4; ++j) s += (v[r][j].x * v[r][j].x + v[r][j].y * v[r][j].y) + (v[r][j].z * v[r][j].z + v[r][j].w * v[r][j].w);
            const float rstd = 1.0f / sqrtf(wave_sum(s) * (1.f / D) + EPS);
            GAS unsigned* o4 = (GAS unsigned*)(XN8 + (size_t)m * D) + lane;
#pragma unroll
            for (int j = 0; j < 4; ++j) { const f32x4 o = v[r][j] * rstd * av[j] + bv[j]; o4[64 * j] = pk4_fp8(o.x, o.y, o.z, o.w); } }
    }
}
DEVI void modnorm_rows8b(const bf16* X, const float* A, const float* Bv, unsigned char* XN8, int gw, int NGW, int lane) {
    constexpr int R = 4;
    const int RPW = (M + NGW - 1) / NGW, mbeg = gw * RPW, mend = (mbeg + RPW < M) ? mbeg + RPW : M;
    int bcur = -1; f32x4 av[4], bv[4];
    for (int m0 = mbeg; m0 < mend; m0 += R) {
        u32x2 w[R][4];
#pragma unroll
        for (int r = 0; r < R; ++r) { const int m = m0 + r; const GAS u32x2* xr = (const GAS u32x2*)(X + (size_t)(m < mend ? m : mbeg) * D) + lane;
#pragma unroll
            for (int j = 0; j < 4; ++j) w[r][j] = xr[64 * j]; }
#pragma unroll
        for (int r = 0; r < R; ++r) { const int m = m0 + r; if (m >= mend) break; const int b = m / SEQ; f32x4 v[4]; float s = 0.f;
            if (b != bcur) { bcur = b; const f32x4* ap = (const f32x4*)(A + (size_t)b * D) + lane; const f32x4* bp = (const f32x4*)(Bv + (size_t)b * D) + lane;
#pragma unroll
                for (int j = 0; j < 4; ++j) { av[j] = ap[64 * j]; bv[j] = bp[64 * j]; } }
#pragma unroll
            for (int j = 0; j < 4; ++j) { v[j] = (f32x4){bflo(w[r][j].x), bfhi(w[r][j].x), bflo(w[r][j].y), bfhi(w[r][j].y)}; s += (v[j].x * v[j].x + v[j].y * v[j].y) + (v[j].z * v[j].z + v[j].w * v[j].w); }
            const float rstd = 1.0f / sqrtf(wave_sum(s) * (1.f / D) + EPS);
            GAS unsigned* o4 = (GAS unsigned*)(XN8 + (size_t)m * D) + lane;
#pragma unroll
            for (int j = 0; j < 4; ++j) { const f32x4 o = v[j] * rstd * av[j] + bv[j]; o4[64 * j] = pk4_fp8(o.x, o.y, o.z, o.w); } }
    }
}
struct WPtrs { const float *g1, *u1, *d1, *g2, *u2, *d2, *win, *wout, *wq, *wk, *wv, *wif; };
constexpr int WI_G1 = 0, WI_U1 = 1408, WI_G2 = 2816, WI_U2 = 4224, WI_D1 = 5632, WI_D2 = 7040, WI_IN = 8448, WI_OUT = 9728, WI_MH = 10240, WI_END = 10336;
DEVI void phase_weights(const WPtrs& P, unsigned char* ws, LAS unsigned char* lds, int gw, int NGW, int wave, int lane, int it_lo, int it_hi) {
    LAS float* scr = (LAS float*)(lds + wave * 16384);
    constexpr int I_GU = (D / 64) * (FF / 32), I_DN = (FF / 64) * (D / 32), I_IN = (D / 64) * (NIN / 32), I_OUT = (D / 64) * (D / 32), I_MH = 2 * 4;
    constexpr int NITEMS = 4 * I_GU + 2 * I_DN + I_IN + I_OUT + 12 * I_MH;
    static_assert(NITEMS == WI_END && 4 * I_GU == WI_D1 && 4 * I_GU + 2 * I_DN == WI_IN && WI_IN + I_IN == WI_OUT && WI_OUT + I_OUT == WI_MH, "item ranges");
    for (int it = it_lo + gw; it < it_hi; it += NGW) {
        int r = it;
        if (r < I_GU) { transpose_item8(P.g1, D, FF, ws + WS_WGU1, 1, W8SCALE_UP, scr, r, lane); continue; } r -= I_GU;
        if (r < I_GU) { transpose_item8(P.u1, D, FF, ws + WS_WGU1, 2, W8SCALE_UP, scr, r, lane); continue; } r -= I_GU;
        if (r < I_GU) { transpose_item8(P.g2, D, FF, ws + WS_WGU2, 1, W8SCALE_UP, scr, r, lane); continue; } r -= I_GU;
        if (r < I_GU) { transpose_item8(P.u2, D, FF, ws + WS_WGU2, 2, W8SCALE_UP, scr, r, lane); continue; } r -= I_GU;
        if (r < I_DN) { transpose_item8(P.d1, FF, D, ws + WS_WD1, 0, W8SCALE_DN, scr, r, lane); continue; } r -= I_DN;
        if (r < I_DN) { transpose_item8(P.d2, FF, D, ws + WS_WD2, 0, W8SCALE_DN, scr, r, lane); continue; } r -= I_DN;
        if (r < I_IN) { transpose_item(P.win, D, NIN, (bf16*)(ws + WS_WIN), 0, 1.f, scr, r, lane); continue; } r -= I_IN;
        if (r < I_OUT) { transpose_item(P.wout, D, D, (bf16*)(ws + WS_WOUT), 0, 1.f, scr, r, lane); continue; } r -= I_OUT;
        const int which = r / (4 * I_MH), hh = (r / I_MH) & 3, sub = r % I_MH; const size_t ho = (size_t)hh * MHD * MHD;
        if (which == 0) transpose_item(P.wq + ho, MHD, MHD, (bf16*)(ws + WS_WQM) + ho, 0, 1.f, scr, sub, lane);
        else if (which == 1) transpose_item(P.wk + ho, MHD, MHD, (bf16*)(ws + WS_WKM) + ho, 0, 0.08838834764831845f, scr, sub, lane);
        else transpose_item(P.wv + ho, MHD, MHD, (bf16*)(ws + WS_WVM) + ho, 0, 1.f, scr, sub, lane);
    }
}
DEVI void phase_weff(const WPtrs& P, unsigned char* ws, int gw, int NGW, int lane) {
    bf16* WEC = (bf16*)(ws + WS_WEC); bf16* WEM = (bf16*)(ws + WS_WEM);
    for (int o8 = gw; o8 < 2 * MH * 16 * MHD / 8; o8 += NGW) {
        const int o = o8 * 8, m = o / (MH * 16 * MHD), r = o % (MH * 16 * MHD), hh = r / (16 * MHD), g = (r / MHD) & 15, d0 = r % MHD;
        bf16* dst = (m == 0 ? WEC : WEM) + r;
        if (g >= 8) { if (lane < 8) dst[lane] = (bf16)0; continue; }
        float s[8];
        if (m == 0) { const float g0a = P.wif[(size_t)(hh * 384 + lane) * 8 + g], g0b = P.wif[(size_t)(hh * 384 + 64 + lane) * 8 + g], g1a = P.wif[(size_t)(hh * 384 + 128 + lane) * 8 + g], g1b = P.wif[(size_t)(hh * 384 + 192 + lane) * 8 + g];
            float qa[8], qb[8], ka[8], kb[8];
#pragma unroll
            for (int i = 0; i < 8; ++i) { const float* a = P.wq + ((size_t)hh * MHD + d0 + i) * MHD; const float* b2 = P.wk + ((size_t)hh * MHD + d0 + i) * MHD; qa[i] = a[lane]; qb[i] = a[64 + lane]; ka[i] = b2[lane]; kb[i] = b2[64 + lane]; }
#pragma unroll
            for (int i = 0; i < 8; ++i) s[i] = (qa[i] * g0a + qb[i] * g0b) + (ka[i] * g1a + kb[i] * g1b); }
        else { const float g2a = P.wif[(size_t)(hh * 384 + 256 + lane) * 8 + g], g2b = P.wif[(size_t)(hh * 384 + 320 + lane) * 8 + g];
            float va[8], vb[8];
#pragma unroll
            for (int i = 0; i < 8; ++i) { const float* a = P.wv + ((size_t)hh * MHD + d0 + i) * MHD; va[i] = a[lane]; vb[i] = a[64 + lane]; }
#pragma unroll
            for (int i = 0; i < 8; ++i) s[i] = va[i] * g2a + vb[i] * g2b; }
#pragma unroll
        for (int i = 0; i < 8; ++i) s[i] = wave_sum(s[i]);
        if (lane == 0) {
#pragma unroll
            for (int i = 0; i < 8; ++i) dst[i] = (bf16)f2bf(s[i]); }
    }
}
DEVI void phase_bw(const float* MOD, const float* win, float* BW2, LAS unsigned char* lds, int vcu, int G, int tid) {
    LAS float* cb = (LAS float*)lds;
    LAS float* part = cb + 8192;
    const int lane = tid & 63, wave = tid >> 6, cl = lane & 15, kq = lane >> 4;
    constexpr int NIT = NIN / 16;
    bool staged = false;
    for (int it = vcu; it < NIT; it += G) {
        if (!staged) { staged = true; __syncthreads(); const float* Bs = MOD + (size_t)3 * 8 * D;
            { float tmpc[16];
#pragma unroll
              for (int j = 0; j < 16; ++j) tmpc[j] = Bs[tid + 512 * j];
#pragma unroll
              for (int j = 0; j < 16; ++j) { const int i = tid + 512 * j, b = i >> 10, k = i & 1023; cb[k * 8 + b] = tmpc[j]; } }
            __syncthreads(); }
        float acc[8];
#pragma unroll
        for (int b = 0; b < 8; ++b) acc[b] = 0.f;
        const int kbase = wave * 128 + kq * 32; const float* wp = win + (size_t)kbase * NIN + it * 16 + cl;
#pragma nounroll
        for (int k0 = 0; k0 < 32; k0 += 16) { float wvv[16];
#pragma unroll
            for (int k = 0; k < 16; ++k) wvv[k] = wp[(size_t)(k0 + k) * NIN];
#pragma unroll
            for (int kk = 0; kk < 16; ++kk) { const float wv = wvv[kk]; const LAS f32x4* cp = (const LAS f32x4*)(cb + (kbase + k0 + kk) * 8); const f32x4 c0 = cp[0], c1 = cp[1];
                acc[0] += c0.x * wv; acc[1] += c0.y * wv; acc[2] += c0.z * wv; acc[3] += c0.w * wv; acc[4] += c1.x * wv; acc[5] += c1.y * wv; acc[6] += c1.z * wv; acc[7] += c1.w * wv; } }
#pragma unroll
        for (int b = 0; b < 8; ++b) { acc[b] += __shfl_xor(acc[b], 16); acc[b] += __shfl_xor(acc[b], 32); if (kq == 0) part[(wave * 8 + b) * 16 + cl] = acc[b]; }
        __syncthreads();
        if (tid < 128) { const int b = tid >> 4, c = tid & 15; float s = 0.f;
#pragma unroll
            for (int w = 0; w < 8; ++w) s += part[(w * 8 + b) * 16 + c];
            BW2[(size_t)b * NIN + it * 16 + c] = s; }
        __syncthreads();
    }
}
DEVI void modnorm_rows(const float* X, const float* A, const float* Bv, bf16* XN, int gw, int NGW, int lane) {
    for (int m = gw; m < M; m += NGW) {
        const GAS f32x4* xr = (const GAS f32x4*)(X + (size_t)m * D) + lane; const int b = m / SEQ;
        f32x4 v[4]; float s = 0.f;
#pragma unroll
        for (int j = 0; j < 4; ++j) { v[j] = xr[64 * j]; s += (v[j].x * v[j].x + v[j].y * v[j].y) + (v[j].z * v[j].z + v[j].w * v[j].w); }
        const float rstd = 1.0f / sqrtf(wave_sum(s) * (1.f / D) + EPS);
        const f32x4* ap = (const f32x4*)(A + (size_t)b * D) + lane; const f32x4* bp = (const f32x4*)(Bv + (size_t)b * D) + lane;
        GAS unsigned long long* o8 = (GAS unsigned long long*)(XN + (size_t)m * D) + lane;
#pragma unroll
        for (int j = 0; j < 4; ++j) { const f32x4 a = ap[64 * j], bb = bp[64 * j]; const f32x4 o = v[j] * rstd * a + bb;
            o8[64 * j] = (unsigned long long)pk2(o.x, o.y) | ((unsigned long long)pk2(o.z, o.w) << 32); }
    }
}
DEVI void final_rows(float* X, const float* w, int gw, int NGW, int lane) {
    for (int m = gw; m < M; m += NGW) {
        GAS f32x4* xr = (GAS f32x4*)(X + (size_t)m * D) + lane;
        f32x4 v[4]; float s = 0.f;
#pragma unroll
        for (int j = 0; j < 4; ++j) { v[j] = xr[64 * j]; s += (v[j].x * v[j].x + v[j].y * v[j].y) + (v[j].z * v[j].z + v[j].w * v[j].w); }
        const float rstd = 1.0f / sqrtf(wave_sum(s) * (1.f / D) + EPS);
        const f32x4* wp = (const f32x4*)w + lane;
#pragma unroll
        for (int j = 0; j < 4; ++j) xr[64 * j] = v[j] * rstd * wp[64 * j];
    }
}
DEVI void final_rows_b(const bf16* X, float* O, const float* w, int gw, int NGW, int lane) {
    constexpr int R = 4;
    f32x4 wv[4];
#pragma unroll
    for (int j = 0; j < 4; ++j) wv[j] = ((const f32x4*)w + lane)[64 * j];
    for (int m0 = gw; m0 < M; m0 += R * NGW) {
        u32x2 q[R][4];
#pragma unroll
        for (int r = 0; r < R; ++r) { const int m = m0 + r * NGW; const GAS u32x2* xr = (const GAS u32x2*)(X + (size_t)(m < M ? m : 0) * D) + lane;
#pragma unroll
            for (int j = 0; j < 4; ++j) q[r][j] = xr[64 * j]; }
#pragma unroll
        for (int r = 0; r < R; ++r) { const int m = m0 + r * NGW; if (m >= M) break; GAS f32x4* orow = (GAS f32x4*)(O + (size_t)m * D) + lane; f32x4 v[4]; float s = 0.f;
#pragma unroll
            for (int j = 0; j < 4; ++j) { v[j] = (f32x4){bflo(q[r][j].x), bfhi(q[r][j].x), bflo(q[r][j].y), bfhi(q[r][j].y)}; s += (v[j].x * v[j].x + v[j].y * v[j].y) + (v[j].z * v[j].z + v[j].w * v[j].w); }
            const float rstd = 1.0f / sqrtf(wave_sum(s) * (1.f / D) + EPS);
#pragma unroll
            for (int j = 0; j < 4; ++j) __builtin_nontemporal_store(v[j] * rstd * wv[j], orow + 64 * j); }
    }
}
DEVI void catnorm_rows(bf16* CAT, const float* w, int gw, int NGW, int lane) {
    constexpr int R = 8;
    const f32x4 w0 = ((const f32x4*)w)[2 * lane], w1 = ((const f32x4*)w)[2 * lane + 1];
    for (int m0 = gw; m0 < M; m0 += R * NGW) {
        v4u q[R];
#pragma unroll
        for (int r = 0; r < R; ++r) { const int m = m0 + r * NGW; q[r] = *((const GAS v4u*)(CAT + (size_t)(m < M ? m : 0) * D) + lane); }
#pragma unroll
        for (int r = 0; r < R; ++r) { const int m = m0 + r * NGW; if (m >= M) break;
            float f[8] = {bflo(q[r].x), bfhi(q[r].x), bflo(q[r].y), bfhi(q[r].y), bflo(q[r].z), bfhi(q[r].z), bflo(q[r].w), bfhi(q[r].w)};
            float s = 0.f;
#pragma unroll
            for (int j = 0; j < 8; ++j) s += f[j] * f[j];
            const float rstd = 1.0f / sqrtf(wave_sum(s) * (1.f / AW) + EPS);
            v4u o; o.x = pk2(f[0] * rstd * w0.x, f[1] * rstd * w0.y); o.y = pk2(f[2] * rstd * w0.z, f[3] * rstd * w0.w);
            o.z = pk2(f[4] * rstd * w1.x, f[5] * rstd * w1.y); o.w = pk2(f[6] * rstd * w1.z, f[7] * rstd * w1.w);
            *((GAS v4u*)(CAT + (size_t)m * D) + lane) = o; }
    }
}

DEVI void phase_kmean(const bf16* K, float* KMP, LAS unsigned char* lds, int vcu, int G, int tid) {
    LAS float* red = (LAS float*)lds;
    const int c4 = tid & 127, rl = tid >> 7;
    for (int u = vcu; u < BATCH * NB * 4; u += G) {
        const int part = u & 3, bn = u >> 2, b = bn / NB, n = bn % NB;
        const bf16* kp = K + ((size_t)b * SEQ + n * 256 + part * 64 + rl) * AW + 4 * c4;
        u32x2 w[16];
#pragma unroll
        for (int r = 0; r < 16; ++r) w[r] = *(const u32x2*)(kp + (size_t)(4 * r) * AW);
        f32x4 s = (f32x4){0.f, 0.f, 0.f, 0.f};
#pragma unroll
        for (int r = 0; r < 16; ++r) s += (f32x4){bflo(w[r].x), bfhi(w[r].x), bflo(w[r].y), bfhi(w[r].y)};
        __syncthreads();
        *(LAS f32x4*)(red + rl * 512 + 4 * c4) = s;
        __syncthreads();
        const float t = (red[tid] + red[512 + tid]) + (red[1024 + tid] + red[1536 + tid]);
        KMP[((((size_t)part * BATCH + b) * AHN + (tid >> 6)) * NB + n) * 64 + (tid & 63)] = t * (1.0f / 256.0f);
    }
    __syncthreads();
}
DEVI void phase_topk(const bf16* Q, const float* KMEAN, unsigned short* SEL, LAS unsigned char* lds, int vcu, int G, int tid) {
    LAS float* km = (LAS float*)lds;
    for (int u = vcu; u < BATCH * AHN * 4; u += G) {
        const int bh = u >> 2, qtr = u & 3, b = bh / AHN, h = bh % AHN;
        __syncthreads();
        for (int i = tid; i < NB * 64; i += 512) { const float* kq = KMEAN + (size_t)bh * NB * 64 + i; constexpr size_t PS = (size_t)BATCH * AHN * NB * 64; km[i] = (kq[0] + kq[PS]) + (kq[2 * PS] + kq[3 * PS]); }
        __syncthreads();
        for (int it = 0; it < 2; ++it) {
            const int s = qtr * 1024 + it * 512 + tid, bq = s >> 8;
            LAS unsigned char* stg = lds + 4096 + (tid >> 6) * (64 * 144);
            { const int lane_ = tid & 63; const bf16* qb_ = Q + ((size_t)b * SEQ + (s - lane_)) * AW + h * 64; v4u t_[8];
#pragma unroll
              for (int i = 0; i < 8; ++i) t_[i] = *(const v4u*)(qb_ + (size_t)(8 * i + (lane_ >> 3)) * AW + (lane_ & 7) * 8);
#pragma unroll
              for (int i = 0; i < 8; ++i) *(LAS v4u*)(stg + (8 * i + (lane_ >> 3)) * 144 + (lane_ & 7) * 16) = t_[i]; }
            const LAS v4u* qp = (const LAS v4u*)(stg + (tid & 63) * 144);
            float q[64];
#pragma unroll
            for (int c = 0; c < 8; ++c) { const v4u w = qp[c]; q[8 * c] = bflo(w.x); q[8 * c + 1] = bfhi(w.x); q[8 * c + 2] = bflo(w.y); q[8 * c + 3] = bfhi(w.y);
                q[8 * c + 4] = bflo(w.z); q[8 * c + 5] = bfhi(w.z); q[8 * c + 6] = bflo(w.w); q[8 * c + 7] = bfhi(w.w); }
            float v1 = -INFINITY, v2 = -INFINITY, v3 = -INFINITY; int i1 = -1, i2 = -1, i3 = -1;
            for (int n = 0; n < bq; ++n) {
                float g = 0.f;
#pragma unroll
                for (int d = 0; d < 64; ++d) g += q[d] * km[n * 64 + d];
                if (g > v1) { v3 = v2; i3 = i2; v2 = v1; i2 = i1; v1 = g; i1 = n; }
                else if (g > v2) { v3 = v2; i3 = i2; v2 = g; i2 = n; }
                else if (g > v3) { v3 = g; i3 = n; }
            }
            unsigned mk = 0u; if (i1 >= 0) mk |= 1u << i1; if (i2 >= 0) mk |= 1u << i2; if (i3 >= 0) mk |= 1u << i3;
            SEL[(size_t)bh * SEQ + s] = (unsigned short)mk;
        }
    }
}
DEVI unsigned pkbf(float lo, float hi) { return pk2(lo, hi); }
constexpr int ST128 = 272, ST64 = 144;
DEVI void mlstm_pre_phase(const bf16* XM, const float* conv_w, const float* conv_b, const bf16* WQ, const bf16* WK, const bf16* WV, const bf16* WEC, const bf16* WEM,
                          bf16* XC, bf16* QM, bf16* KMT, bf16* VMT, float* GP, LAS unsigned char* lds, int vcu, int G, int tid) {
    const int lane = tid & 63, wave = __builtin_amdgcn_readfirstlane(tid >> 6), e0 = wave * 16, lr = lane & 15, lg = lane >> 4;
    LAS unsigned char* XmI = lds;
    LAS unsigned char* XcI = lds + 68 * ST128;
    LAS float* cw = (LAS float*)(lds + 132 * ST128);
    constexpr int NU = (M / 64) * MH;
    int u = vcu; if (u >= NU) return;
    v4u pf[3];
#define PRE_PF(uu) do { const int R0_ = ((uu) >> 2) * 64, h_ = (uu) & 3; const bool z_ = (R0_ % SEQ) == 0; _Pragma("unroll") for (int i = 0; i < 3; ++i) { const int ch = tid + 512 * i, ir = ch >> 4, cc = ch & 15; \
        pf[i] = (v4u){0u, 0u, 0u, 0u}; if (ch < 67 * 16 && (ir >= 3 || !z_)) pf[i] = *(const v4u*)(XM + (size_t)(R0_ - 3 + ir) * MW + h_ * MHD + cc * 8); } } while (0)
    PRE_PF(u);
    int hcur = -1; bf16x8 wq[4], wk[4], wv[4], wgc[4], wgm[4];
    for (; u < NU; u += G) {
        const int tt = u >> 2, h = u & 3, R0 = tt * 64, t0 = R0 % SEQ, b = R0 / SEQ;
        if (h != hcur) { hcur = h;
#pragma unroll
            for (int ks = 0; ks < 4; ++ks) { const size_t o = ((size_t)(h * MHD + e0 + lr)) * MHD + 32 * ks + 8 * lg; wq[ks] = *(const bf16x8*)(WQ + o); wk[ks] = *(const bf16x8*)(WK + o); wv[ks] = *(const bf16x8*)(WV + o); const size_t og = ((size_t)(h * 16 + lr)) * MHD + 32 * ks + 8 * lg; wgc[ks] = *(const bf16x8*)(WEC + og); wgm[ks] = *(const bf16x8*)(WEM + og); }
            for (int i = tid; i < 5 * 128; i += 512) cw[i] = (i < 512) ? conv_w[(i >> 7) * MW + h * MHD + (i & 127)] : conv_b[h * MHD + (i & 127)]; }
#pragma unroll
        for (int i = 0; i < 3; ++i) { const int ch = tid + 512 * i, ir = ch >> 4, cc = ch & 15; if (ch < 67 * 16) *(LAS v4u*)(XmI + ir * ST128 + cc * 16) = pf[i]; }
        __syncthreads();
        if (u + G < NU) PRE_PF(u + G);
        { const int t = tid >> 3, c0 = (tid & 7) * 8;
#pragma unroll
          for (int hf = 0; hf < 2; ++hf) { const int cb = c0 + 64 * hf; float a[8];
              { const f32x4 b0 = *(const LAS f32x4*)(cw + 512 + cb), b1 = *(const LAS f32x4*)(cw + 512 + cb + 4); a[0] = b0.x; a[1] = b0.y; a[2] = b0.z; a[3] = b0.w; a[4] = b1.x; a[5] = b1.y; a[6] = b1.z; a[7] = b1.w; }
#pragma unroll
              for (int j4 = 0; j4 < 4; ++j4) { const v4u xv = *(const LAS v4u*)(XmI + (t + j4) * ST128 + cb * 2); const f32x4 w0 = *(const LAS f32x4*)(cw + j4 * 128 + cb), w1 = *(const LAS f32x4*)(cw + j4 * 128 + cb + 4);
                  a[0] += w0.x * bflo(xv.x); a[1] += w0.y * bfhi(xv.x); a[2] += w0.z * bflo(xv.y); a[3] += w0.w * bfhi(xv.y);
                  a[4] += w1.x * bflo(xv.z); a[5] += w1.y * bfhi(xv.z); a[6] += w1.z * bflo(xv.w); a[7] += w1.w * bfhi(xv.w); }
#pragma unroll
              for (int j = 0; j < 8; ++j) a[j] = silu_f(a[j]);
              v4u o; o.x = pkbf(a[0], a[1]); o.y = pkbf(a[2], a[3]); o.z = pkbf(a[4], a[5]); o.w = pkbf(a[6], a[7]);
              *(LAS v4u*)(XcI + t * ST128 + cb * 2) = o; *(v4u*)(XC + (size_t)(R0 + t) * MW + h * MHD + cb) = o; } }
        __syncthreads();
        f32x4 aQ[4], aKT[4], aVT[4];
#pragma unroll
        for (int i = 0; i < 4; ++i) { aQ[i] = (f32x4){0.f, 0.f, 0.f, 0.f}; aKT[i] = aQ[i]; aVT[i] = aQ[i]; }
#pragma unroll
        for (int t4 = 0; t4 < 4; ++t4)
#pragma unroll
            for (int ks = 0; ks < 4; ++ks) { const bf16x8 xc = ldfrag(XcI, ST128, 16 * t4, 32 * ks, lane), xm = ldfrag(XmI, ST128, 16 * t4 + 3, 32 * ks, lane);
                aQ[t4] = MMA16(wq[ks], xc, aQ[t4]); aKT[t4] = MMA16(xc, wk[ks], aKT[t4]); aVT[t4] = MMA16(xm, wv[ks], aVT[t4]); }
        if (wave < 4) {
            f32x4 aG = (f32x4){0.f, 0.f, 0.f, 0.f};
#pragma unroll
            for (int ks = 0; ks < 4; ++ks) {
                const bf16x8 xc = ldfrag(XcI, ST128, 16 * wave, 32 * ks, lane), xm = ldfrag(XmI, ST128, 16 * wave + 3, 32 * ks, lane);
                aG = MMA16(wgc[ks], xc, aG); aG = MMA16(wgm[ks], xm, aG); }
            if (lg < 2) *(f32x4*)(GP + (size_t)(R0 + 16 * wave + lr) * 32 + h * 8 + 4 * lg) = aG;
        }
        LAS unsigned char* QS = lds + 40960; LAS unsigned char* KTS = QS + 64 * ST128; LAS unsigned char* VTS = KTS + 128 * ST64;
#pragma unroll
        for (int t4 = 0; t4 < 4; ++t4) {
            { const int o = (16 * t4 + lr) * ST128 + (e0 + 4 * lg) * 2;
              *(LAS u32x2*)(QS + o) = (u32x2){pkbf(aQ[t4][0], aQ[t4][1]), pkbf(aQ[t4][2], aQ[t4][3])}; }
            { const int o = (e0 + lr) * ST64 + (16 * t4 + 4 * lg) * 2;
              *(LAS u32x2*)(KTS + o) = (u32x2){pkbf(aKT[t4][0], aKT[t4][1]), pkbf(aKT[t4][2], aKT[t4][3])};
              *(LAS u32x2*)(VTS + o) = (u32x2){pkbf(aVT[t4][0], aVT[t4][1]), pkbf(aVT[t4][2], aVT[t4][3])}; }
        }
        __syncthreads();
        const size_t cbase = ((size_t)((b * MH + h) * 64 + (t0 >> 6))) * (MHD * 64);
#pragma unroll
        for (int i = 0; i < 2; ++i) { const int ch = tid + 512 * i;
            { const int row = ch >> 4, cc = ch & 15; const size_t o = (size_t)(R0 + row) * MW + h * MHD + cc * 8;
              *(v4u*)(QM + o) = *(const LAS v4u*)(QS + row * ST128 + cc * 16); }
            { const int row = ch >> 3, cc = ch & 7; const size_t o = cbase + (size_t)row * 64 + cc * 8;
              *(v4u*)(KMT + o) = *(const LAS v4u*)(KTS + row * ST64 + cc * 16); *(v4u*)(VMT + o) = *(const LAS v4u*)(VTS + row * ST64 + cc * 16); } }
    }
#undef PRE_PF
}
constexpr int L_QI = 0, L_KTU = L_QI + 64 * ST128, L_KTW = L_KTU + 128 * ST64, L_VTI = L_KTW + 128 * ST64, L_PI = L_VTI + SV * ST64, L_SI = L_PI + 64 * ST64, L_MISC = L_SI + SV * ST128;
constexpr int GJW = 264, MS_DEN = 4 * GJW, MS_LN1 = MS_DEN + 64, MS_LN2 = MS_LN1 + 128, MS_END = MS_LN2 + 128;
static_assert(L_MISC + MS_END * 4 <= RING_BYTES, "mLSTM LDS map");
DEVI void mlstm_gates4(const float* GP, const float* b_if, size_t row_sc, int h, LAS float* misc, int wave, int lane) {
    if (wave < 4) { const int t = lane; LAS float* gj = misc + wave * GJW; const float* gp = GP + (row_sc + wave * 64 + t) * 32; float ip = b_if[h], fp = b_if[4 + h]; float gvi[4], gvf[4];
#pragma unroll
        for (int hh = 0; hh < 4; ++hh) { gvi[hh] = gp[hh * 8 + h]; gvf[hh] = gp[hh * 8 + 4 + h]; }
        asm volatile("" : "+v"(gvi[0]), "+v"(gvi[1]), "+v"(gvi[2]), "+v"(gvi[3]), "+v"(gvf[0]), "+v"(gvf[1]), "+v"(gvf[2]), "+v"(gvf[3]));
#pragma unroll
        for (int hh = 0; hh < 4; ++hh) { ip += gvi[hh]; fp += gvf[hh]; }
        const float lf = fminf(fp, 0.f) - log1pf(expf(-fabsf(fp)));
        float F = lf;
#pragma unroll
        for (int o = 1; o < 64; o <<= 1) { const float v = __shfl_up(F, o); if (t >= o) F += v; }
        const float Fend = __shfl(F, 63);
        gj[t] = F; gj[64 + t] = ip - F; gj[128 + t] = expf(Fend - F + ip); gj[192 + t] = expf(F);
        if (t == 0) { gj[256] = expf(Fend); gj[257] = Fend; } }
}
DEVI void ones_rows(LAS unsigned char* VTi, int tid) {
    for (int ch = tid; ch < 16 * 8; ch += 512) { const int r = ch >> 3, cc = ch & 7; const unsigned w = (r == 0) ? 0x3f803f80u : 0u; *(LAS v4u*)(VTi + (128 + r) * ST64 + cc * 16) = (v4u){w, w, w, w}; }
}
typedef short s16x4_ __attribute__((ext_vector_type(4)));
DEVI bf16x8 ktfrag(const LAS unsigned char* img, int s0, int d0, int lane) {
    const int i = lane & 15, g = lane >> 4;
    const LAS unsigned char* p = img + (d0 + 8 * g + (i >> 2)) * ST64 + (s0 + 4 * (i & 3)) * 2;
    const s16x4_ lo = __builtin_amdgcn_ds_read_tr16_b64_v4i16((LAS s16x4_*)p), hi = __builtin_amdgcn_ds_read_tr16_b64_v4i16((LAS s16x4_*)(p + 4 * ST64));
    return (bf16x8){lo[0], lo[1], lo[2], lo[3], hi[0], hi[1], hi[2], hi[3]};
}
#define T_LOAD(dst, src) do { _Pragma("unroll") for (int i_ = 0; i_ < 2; ++i_) { const int ch_ = tid + 512 * i_; dst[i_] = *(const v4u*)((src) + (size_t)(ch_ >> 3) * 64 + (ch_ & 7) * 8); } } while (0)
#define T_LOAD_NT(dst, src) do { _Pragma("unroll") for (int i_ = 0; i_ < 2; ++i_) { const int ch_ = tid + 512 * i_; dst[i_] = __builtin_nontemporal_load((const v4u*)((src) + (size_t)(ch_ >> 3) * 64 + (ch_ & 7) * 8)); } } while (0)
#define VPOS(v_) (((v_) & 64) | (((v_) & 12) << 2) | (((v_) >> 2) & 12) | ((v_) & 3))
#define T_STORE_P(img, regs) do { _Pragma("unroll") for (int i_ = 0; i_ < 2; ++i_) { const int ch_ = tid + 512 * i_; *(LAS v4u*)((img) + VPOS(ch_ >> 3) * ST64 + (ch_ & 7) * 16) = regs[i_]; } } while (0)
#define T_STORE(img, regs) do { _Pragma("unroll") for (int i_ = 0; i_ < 2; ++i_) { const int ch_ = tid + 512 * i_; *(LAS v4u*)((img) + (ch_ >> 3) * ST64 + (ch_ & 7) * 16) = regs[i_]; } } while (0)
#define T_STORE_SCALED(img, regs, wS) do { _Pragma("unroll") for (int i_ = 0; i_ < 2; ++i_) { const int ch_ = tid + 512 * i_; const LAS float* w_ = (wS) + (ch_ & 7) * 8; v4u v_ = regs[i_]; \
        v_.x = pkbf(bflo(v_.x) * w_[0], bfhi(v_.x) * w_[1]); v_.y = pkbf(bflo(v_.y) * w_[2], bfhi(v_.y) * w_[3]); v_.z = pkbf(bflo(v_.z) * w_[4], bfhi(v_.z) * w_[5]); v_.w = pkbf(bflo(v_.w) * w_[6], bfhi(v_.w) * w_[7]); \
        *(LAS v4u*)((img) + (ch_ >> 3) * ST64 + (ch_ & 7) * 16) = v_; } } while (0)
#define R_LOAD(dst, src) do { _Pragma("unroll") for (int i_ = 0; i_ < 2; ++i_) { const int ch_ = tid + 512 * i_; dst[i_] = *(const v4u*)((src) + (size_t)(ch_ >> 4) * MW + (ch_ & 15) * 8); } } while (0)
#define R_LOAD_NT(dst, src) do { _Pragma("unroll") for (int i_ = 0; i_ < 2; ++i_) { const int ch_ = tid + 512 * i_; dst[i_] = __builtin_nontemporal_load((const v4u*)((src) + (size_t)(ch_ >> 4) * MW + (ch_ & 15) * 8)); } } while (0)
#define R_STORE(img, regs) do { _Pragma("unroll") for (int i_ = 0; i_ < 2; ++i_) { const int ch_ = tid + 512 * i_; *(LAS v4u*)((img) + (ch_ >> 4) * ST128 + (ch_ & 15) * 16) = regs[i_]; } } while (0)
DEVI void state_update(f32x4 (&accS)[9], const LAS unsigned char* lds, float g, int wave, int lane) {
    const bf16x8 k0 = ldfrag(lds + L_KTW, ST64, 16 * wave, 0, lane), k1 = ldfrag(lds + L_KTW, ST64, 16 * wave, 32, lane);
    bf16x8 f[2][6];
#pragma unroll
    for (int q = 0; q < 3; ++q) { f[0][2 * q] = ldfrag(lds + L_VTI, ST64, 16 * q, 0, lane); f[0][2 * q + 1] = ldfrag(lds + L_VTI, ST64, 16 * q, 32, lane); }
#pragma unroll
    for (int vt = 0; vt < 9; ++vt) accS[vt] = accS[vt] * g;
    __builtin_amdgcn_sched_barrier(0);
    asm volatile("s_nop 15\n\ts_nop 15" : "+v"(accS[0]), "+v"(accS[1]), "+v"(accS[2]), "+v"(accS[3]), "+v"(accS[4]), "+v"(accS[5]), "+v"(accS[6]), "+v"(accS[7]), "+v"(accS[8]));
    __builtin_amdgcn_sched_barrier(0);
#pragma unroll
    for (int grp = 0; grp < 3; ++grp) {
        if (grp < 2) {
#pragma unroll
            for (int q = 0; q < 3; ++q) { const int vt = 3 * (grp + 1) + q; f[(grp + 1) & 1][2 * q] = ldfrag(lds + L_VTI, ST64, 16 * vt, 0, lane); f[(grp + 1) & 1][2 * q + 1] = ldfrag(lds + L_VTI, ST64, 16 * vt, 32, lane); } }
#pragma unroll
        for (int q = 0; q < 3; ++q) { const int vt = 3 * grp + q; accS[vt] = MMA16(k0, f[grp & 1][2 * q], accS[vt]); accS[vt] = MMA16(k1, f[grp & 1][2 * q + 1], accS[vt]); }
    }
}
DEVI void mlstm_chunkstate_phase(const bf16* KMT, const bf16* VMT, const float* GP, const float* b_if, float* DST, float* GSUP, LAS unsigned char* lds, int vcu, int G, int tid) {
    const int lane = tid & 63, wave = __builtin_amdgcn_readfirstlane(tid >> 6);
    LAS float* misc = (LAS float*)(lds + L_MISC);
    constexpr int NU = BATCH * MH * 16;
    int u = vcu; if (u >= NU) return;
    v4u kt[2], vt[2];
    { const size_t cb0 = ((size_t)((u >> 4) * 64 + (u & 15) * 4)) * (MHD * 64); T_LOAD(kt, KMT + cb0); T_LOAD(vt, VMT + cb0); }
    for (; u < NU; u += G) {
        const int bh = u >> 4, sc = u & 15, b = bh / MH, h = bh % MH;
        f32x4 accS[9];
#pragma unroll
        for (int i = 0; i < 9; ++i) accS[i] = (f32x4){0.f, 0.f, 0.f, 0.f};
        ones_rows(lds + L_VTI, tid);
        mlstm_gates4(GP, b_if, (size_t)b * SEQ + (size_t)sc * 256, h, misc, wave, lane);
        __syncthreads();
        float Ftot = 0.f;
        for (int j = 0; j < 4; ++j) {
            const LAS float* gj = misc + j * GJW;
            T_STORE_SCALED(lds + L_KTW, kt, gj + 128); T_STORE_P(lds + L_VTI, vt);
            __syncthreads();
            { int un = u, jn = j + 1; if (jn == 4) { jn = 0; un = u + G; }
              if (un < NU) { const size_t cbn = ((size_t)((un >> 4) * 64 + (un & 15) * 4 + jn)) * (MHD * 64); T_LOAD(kt, KMT + cbn); T_LOAD(vt, VMT + cbn); } }
            state_update(accS, lds, gj[256], wave, lane); Ftot += gj[257];
            __syncthreads();
        }
        const size_t ub = ((size_t)(bh * 16 + sc)) * (SV * MHD);
#pragma unroll
        for (int vt2 = 0; vt2 < 9; ++vt2) *(f32x4*)(DST + ub + (size_t)(16 * vt2 + (lane & 15)) * MHD + 16 * wave + 4 * (lane >> 4)) = accS[vt2];
        if (tid == 0) GSUP[bh * 16 + sc] = expf(Ftot);
    }
}
DEVI void phase_scan(const float* DST, const float* GSUP, bf16* SST, int gtid, int NT_) {
    constexpr int E = SV * MHD;
    for (int e2 = gtid; e2 < BATCH * MH * E / 2; e2 += NT_) { const int bh = (2 * e2) / E, idx = (2 * e2) % E;
        f32x2 d[15]; float g[15];
#pragma unroll
        for (int c = 0; c < 15; ++c) { d[c] = *(const f32x2*)(DST + ((size_t)(bh * 16 + c)) * E + idx); g[c] = GSUP[bh * 16 + c]; }
        f32x2 s = (f32x2){0.f, 0.f};
#pragma unroll
        for (int c = 0; c < 16; ++c) { *(unsigned*)(SST + ((size_t)(bh * 16 + c)) * E + idx) = pk2(s.x, s.y); if (c < 15) s = s * g[c] + d[c]; } }
}
DEVI void mlstm_out_phase(const bf16* QM, const bf16* KMT, const bf16* VMT, const float* GP, const float* b_if, const bf16* SST,
                          const bf16* XC, const bf16* Z, const float* normw, const float* skipw, bf16* CAT, LAS unsigned char* lds, int vcu, int G, int tid) {
    const int lane = tid & 63, wave = __builtin_amdgcn_readfirstlane(tid >> 6), lr = lane & 15, lg = lane >> 4;
    LAS float* misc = (LAS float*)(lds + L_MISC);
    constexpr int NU = BATCH * MH * 16;
    int u = vcu; if (u >= NU) return;
    v4u qr[2], kt[2], vt[2];
#define OUT_PF(uu, jj) do { const int bh_ = (uu) >> 4, ck_ = ((uu) & 15) * 4 + (jj); const size_t row_ = (size_t)(bh_ / MH) * SEQ + (size_t)ck_ * 64, cb_ = ((size_t)(bh_ * 64 + ck_)) * (MHD * 64); \
        R_LOAD_NT(qr, QM + row_ * MW + (bh_ % MH) * MHD); T_LOAD_NT(kt, KMT + cb_); T_LOAD_NT(vt, VMT + cb_); } while (0)
    OUT_PF(u, 0);
    for (; u < NU; u += G) {
        const int bh = u >> 4, sc = u & 15, b = bh / MH, h = bh % MH;
        const size_t ub = ((size_t)(bh * 16 + sc)) * (SV * MHD);
        f32x4 accS[9];
#pragma unroll
        for (int vt2 = 0; vt2 < 9; ++vt2) { const u32x2 w = *(const u32x2*)(SST + ub + (size_t)(16 * vt2 + lr) * MHD + 16 * wave + 4 * lg); accS[vt2] = (f32x4){bflo(w.x), bfhi(w.x), bflo(w.y), bfhi(w.y)}; }
        { v4u sfill[5];
#pragma unroll
          for (int i = 0; i < 5; ++i) { const int ch = tid + 512 * i; sfill[i] = (v4u){0u, 0u, 0u, 0u}; if (ch < SV * 16) sfill[i] = *(const v4u*)(SST + ub + (size_t)(ch >> 4) * MHD + (ch & 15) * 8); }
          asm volatile("" : "+v"(sfill[0]), "+v"(sfill[1]), "+v"(sfill[2]), "+v"(sfill[3]), "+v"(sfill[4]));
#pragma unroll
          for (int i = 0; i < 5; ++i) { const int ch = tid + 512 * i; if (ch < SV * 16) *(LAS v4u*)(lds + L_SI + (ch >> 4) * ST128 + (ch & 15) * 16) = sfill[i]; } }
        ones_rows(lds + L_VTI, tid);
        mlstm_gates4(GP, b_if, (size_t)b * SEQ + (size_t)sc * 256, h, misc, wave, lane);
        __syncthreads();
        for (int j = 0; j < 4; ++j) {
            const int ck = sc * 4 + j; const size_t row0 = (size_t)b * SEQ + (size_t)ck * 64; const LAS float* gj = misc + j * GJW;
            R_STORE(lds + L_QI, qr); T_STORE(lds + L_KTU, kt); T_STORE_P(lds + L_VTI, vt); T_STORE_SCALED(lds + L_KTW, kt, gj + 128);
            __syncthreads();
            asm volatile("s_waitcnt vmcnt(0)" ::: "memory");
            u32x2 xcw[4], zw[4];
            { const int tt_ = wave & 3, hf_ = wave >> 2; const size_t ro = row0 + 16 * tt_ + lr; const int col = h * MHD + 64 * hf_ + 16 * lg;
              const v4u x0 = *(const v4u*)(XC + ro * MW + col), x1 = *(const v4u*)(XC + ro * MW + col + 8);
              const v4u z0 = *(const v4u*)(Z + ro * MW + col), z1 = *(const v4u*)(Z + ro * MW + col + 8);
              xcw[0] = (u32x2){x0.x, x0.y}; xcw[1] = (u32x2){x0.z, x0.w}; xcw[2] = (u32x2){x1.x, x1.y}; xcw[3] = (u32x2){x1.z, x1.w};
              zw[0] = (u32x2){z0.x, z0.y}; zw[1] = (u32x2){z0.z, z0.w}; zw[2] = (u32x2){z1.x, z1.y}; zw[3] = (u32x2){z1.z, z1.w}; }
            { int un = u, jn = j + 1; if (jn == 4) { jn = 0; un = u + G; } if (un < NU) OUT_PF(un, jn); }
            { const int tt = wave >> 1, t = 16 * tt + lr; const float Ft = gj[t];
#pragma unroll
              for (int q2 = 0; q2 < 2; ++q2) { const int st = 2 * (wave & 1) + q2; f32x4 a = (f32x4){0.f, 0.f, 0.f, 0.f};
                  if (st <= tt) {
#pragma unroll
                      for (int ks = 0; ks < 4; ++ks) a = MMA16(ktfrag(lds + L_KTU, 16 * st, 32 * ks, lane), ldfrag(lds + L_QI, ST128, 16 * tt, 32 * ks, lane), a);
#pragma unroll
                      for (int r = 0; r < 4; ++r) { const int s = 16 * st + 4 * lg + r; a[r] = (s <= t) ? a[r] * __builtin_amdgcn_exp2f((Ft + gj[64 + s]) * 1.4426950408889634f) : 0.f; } }
                  *(LAS u32x2*)(lds + L_PI + t * ST64 + (16 * st + 4 * lg) * 2) = (u32x2){pkbf(a[0], a[1]), pkbf(a[2], a[3])}; } }
            __syncthreads();
            const int tt = wave & 3, hf = wave >> 2, t = 16 * tt + lr; const float aT = gj[192 + t];
            f32x4 num[5];
            { bf16x8 pfr[2], qfr[4];
#pragma unroll
              for (int ks = 0; ks < 2; ++ks) pfr[ks] = ldfrag(lds + L_PI, ST64, 16 * tt, 32 * ks, lane);
#pragma unroll
              for (int ks = 0; ks < 4; ++ks) qfr[ks] = ldfrag(lds + L_QI, ST128, 16 * tt, 32 * ks, lane);
#pragma unroll
              for (int i = 0; i < 5; ++i) { const int vt2 = (i < 4) ? (4 * hf + i) : 8; f32x4 aI = (f32x4){0.f, 0.f, 0.f, 0.f}, aX = aI;
                if (i < 4 || hf == 0) { bf16x8 f[6];
#pragma unroll
                    for (int ks = 0; ks < 2; ++ks) f[ks] = ldfrag(lds + L_VTI, ST64, 16 * vt2, 32 * ks, lane);
#pragma unroll
                    for (int ks = 0; ks < 4; ++ks) f[2 + ks] = ldfrag(lds + L_SI, ST128, 16 * vt2, 32 * ks, lane);
#pragma unroll
                    for (int ks = 0; ks < 2; ++ks) aI = MMA16(f[ks], pfr[ks], aI);
#pragma unroll
                    for (int ks = 0; ks < 4; ++ks) aX = MMA16(f[2 + ks], qfr[ks], aX); }
                num[i] = aI + aX * aT; } }
            state_update(accS, lds, gj[256], wave, lane);
            if (hf == 0 && lg == 0) misc[MS_DEN + t] = num[4][0];
            __syncthreads();
            { const float dinv = 1.0f / fmaxf(fabsf(misc[MS_DEN + t]), 1.0f); float s1 = 0.f, s2 = 0.f;
#pragma unroll
              for (int i = 0; i < 4; ++i) { num[i] = num[i] * dinv; s1 += (num[i][0] + num[i][1]) + (num[i][2] + num[i][3]); s2 += (num[i][0] * num[i][0] + num[i][1] * num[i][1]) + (num[i][2] * num[i][2] + num[i][3] * num[i][3]); }
              s1 += __shfl_xor(s1, 16); s1 += __shfl_xor(s1, 32); s2 += __shfl_xor(s2, 16); s2 += __shfl_xor(s2, 32);
              if (lg == 0) { misc[MS_LN1 + hf * 64 + t] = s1; misc[MS_LN2 + hf * 64 + t] = s2; } }
            __syncthreads();
            { const float mean = (misc[MS_LN1 + t] + misc[MS_LN1 + 64 + t]) * (1.0f / MHD), var = (misc[MS_LN2 + t] + misc[MS_LN2 + 64 + t]) * (1.0f / MHD) - mean * mean, rstd = 1.0f / sqrtf(fmaxf(var, 0.f) + EPS);
              u32x2 opk[4]; const size_t ro = row0 + t;
#pragma unroll
              for (int i = 0; i < 4; ++i) { const int v = 64 * hf + 16 * lg + 4 * i, col = h * MHD + v;
                  const f32x4 nw = *(const f32x4*)(normw + col), sw = *(const f32x4*)(skipw + col);
                  const float xc[4] = {bflo(xcw[i].x), bfhi(xcw[i].x), bflo(xcw[i].y), bfhi(xcw[i].y)}, zz[4] = {bflo(zw[i].x), bfhi(zw[i].x), bflo(zw[i].y), bfhi(zw[i].y)}; float o[4];
#pragma unroll
                  for (int r = 0; r < 4; ++r) { const float hn = (num[i][r] - mean) * rstd * nw[r]; o[r] = (hn + sw[r] * xc[r]) * silu_f(zz[r]); }
                  opk[i] = (u32x2){pkbf(o[0], o[1]), pkbf(o[2], o[3])}; }
              { bf16* cp = CAT + ro * D + AW + h * MHD + 64 * hf + 16 * lg; *(v4u*)cp = (v4u){opk[0].x, opk[0].y, opk[1].x, opk[1].y}; *(v4u*)(cp + 8) = (v4u){opk[2].x, opk[2].y, opk[3].x, opk[3].y}; } }
            if (j < 3) {

#pragma unroll
                for (int vt2 = 0; vt2 < 9; ++vt2) *(LAS u32x2*)(lds + L_SI + (16 * vt2 + lr) * ST128 + (16 * wave + 4 * lg) * 2) = (u32x2){pkbf(accS[vt2][0], accS[vt2][1]), pkbf(accS[vt2][2], accS[vt2][3])};
            }
        }
        __syncthreads();
    }
#undef OUT_PF
}
#ifndef DUP_MLSTM
#define DUP_MLSTM 0
#endif
#ifndef DUP_ATTN
#define DUP_ATTN 0
#endif
#ifndef MK_PER_PHASE
#define MK_PER_PHASE 0
#endif
#ifndef EV_ON
#define EV_ON (!MK_PER_PHASE)
#endif
constexpr int NPHASE = 14;
struct Args { const float* in[26]; float* out; unsigned char* ws; int ph_lo, ph_hi; };
typedef const __attribute__((address_space(4))) Args* KArgs;
DEVI KArgs ka_fresh() { KArgs p = (KArgs)__builtin_amdgcn_kernarg_segment_ptr(); asm volatile("" : "+s"(p)); return p; }
DEVI int tid_fresh() { int t = threadIdx.x; asm volatile("" : "+v"(t)); return t; }
#define WSP(off) (A_->ws + (off))
__global__ void __launch_bounds__(NWAVES * 64, 2) mk_fwd(Args args) {
    extern __shared__ __attribute__((aligned(16))) unsigned char lds_raw[];
    LAS unsigned char* lds = (LAS unsigned char*)lds_raw;
    volatile LAS unsigned* MISC = (volatile LAS unsigned*)(lds + MISC_OFF);
    const int G = gridDim.x; const int bx = blockIdx.x; const int vcu = (G % 8 == 0) ? (bx % 8) * (G / 8) + bx / 8 : bx;
    { const int tid = threadIdx.x; for (int u = tid; u < (LDS_BYTES - LDSCTL_OFF) / 4; u += NWAVES * 64) ((LAS unsigned*)(lds + LDSCTL_OFF))[u] = 0u; }
    __syncthreads();
    XcdBarrier bar; { gu32* ctl = (gu32*)(args.ws + WS_CTL); bar.bar = (unsigned*)(ctl + CW_BAR); bar.x = 0; bar.st = nullptr;
        if (!MK_PER_PHASE) bar = xcd_barrier_post((unsigned*)(ctl + CW_BAR), MISC + 8); }
    const int lo = args.ph_lo, hi = args.ph_hi;
#ifndef DBG_SKIP_LO
#define DBG_SKIP_LO 99
#define DBG_SKIP_HI 99
#endif
#define IN(k) (lo <= (k) && (k) < hi && !((k) >= DBG_SKIP_LO && (k) < DBG_SKIP_HI))
#define SEAM(k) do { if (IN(k) && IN((k) + 1)) xcd_barrier(bar); } while (0)
#define PHASE_VARS const KArgs A_ = ka_fresh(); const int tid = tid_fresh(), lane = tid & 63, wave = __builtin_amdgcn_readfirstlane(tid >> 6); \
    const int gw = vcu * NWAVES + wave, NGW = G * NWAVES, gtid = vcu * (NWAVES * 64) + tid, NTH = G * NWAVES * 64; (void)lane; (void)gw; (void)NGW; (void)gtid; (void)NTH; (void)A_

    const bool EVF = EV_ON && lo == 0 && hi == NPHASE;
#define WFILL(lo_, hi_) do { WPtrs P_{A_->in[5], A_->in[6], A_->in[7], A_->in[22], A_->in[23], A_->in[24], A_->in[9], A_->in[20], A_->in[12], A_->in[13], A_->in[14], A_->in[15]}; phase_weights(P_, A_->ws, lds, gw, NGW, wave, lane, lo_, hi_); } while (0)
#define EVA(e) do { if (EVF) ev_arrive(bar, (unsigned*)WSP(WS_CTL), e); else __syncthreads(); } while (0)
#define EVW(e) do { if (EVF) ev_wait(bar, (unsigned*)WSP(WS_CTL), e); } while (0)
    if (IN(0)) { PHASE_VARS; phase_mod(A_->in[1], A_->in[2], A_->in[3], A_->in[4], A_->in[8], A_->in[21], (float*)WSP(WS_MOD), lds, vcu, G, tid); __syncthreads(); if (EV_ON && IN(1)) ev_arrive(bar, (unsigned*)WSP(WS_CTL), 0); }
    if (!EV_ON) SEAM(0);
    if (IN(1)) { PHASE_VARS;
        WPtrs P{A_->in[5], A_->in[6], A_->in[7], A_->in[22], A_->in[23], A_->in[24], A_->in[9], A_->in[20], A_->in[12], A_->in[13], A_->in[14], A_->in[15]};
        phase_weights(P, A_->ws, lds, gw, NGW, wave, lane, WI_G1, WI_G2);
        if (EV_ON && IN(0)) ev_wait(bar, (unsigned*)WSP(WS_CTL), 0);
        const float* MOD = (const float*)WSP(WS_MOD);
        modnorm_rows8(A_->in[0], MOD + 1 * 8 * D, MOD + 0 * 8 * D, WSP(WS_XN), gw, NGW, lane);
        EVA(7); WFILL(WI_D1, WI_D2);
    }
    if (!EVF) SEAM(1);
    if (IN(2)) { PHASE_VARS; EVW(7); pg8::Gemm g{(const bf16*)WSP(WS_XN), (const bf16*)WSP(WS_WGU1), M, NGU, D}; pg8::StaticOrder S; S.init(M, NGU, G, bx);
        pg8::EpiSwiGLU<true> E{A_->ws, (unsigned)WS_HB, 0u, 0u, FF, 1.0f / W8SCALE_UP, 0, SEQ / 256}; pg8::gemm_phase8<pg8::EpiSwiGLU<true>, pg8::StaticOrder, PG8_ALIGN, true>(lds + RING_OFF, g, S, E);
        EVA(8); WFILL(WI_IN, WI_OUT); phase_bw((const float*)WSP(WS_MOD), A_->in[9], (float*)WSP(WS_BW2), lds, vcu, G, tid); }
    if (!EVF) SEAM(2);
    if (IN(3)) { PHASE_VARS; EVW(8); pg8::bf16_t* XB1_ = (pg8::bf16_t*)A_->out; pg8::Gemm g{(const bf16*)WSP(WS_HB), (const bf16*)WSP(WS_WD1), M, D, FF}; pg8::StaticOrder S; S.init(M, D, G, bx);
        pg8::EpiResidY<false> E{A_->in[0], XB1_, (const float*)WSP(WS_MOD) + 2 * 8 * D, (const float*)WSP(WS_MOD) + 4 * 8 * D, (void*)WSP(WS_XN), (float*)WSP(WS_SSQ1), D, SEQ / 256, 1.0f / W8SCALE_DN, 0};
        pg8::gemm_phase8<pg8::EpiResidY<false>, pg8::StaticOrder, PG8_ALIGN, true>(lds + RING_OFF, g, S, E);
        EVA(9); WFILL(WI_MH, WI_END); { WPtrs P_{A_->in[5], A_->in[6], A_->in[7], A_->in[22], A_->in[23], A_->in[24], A_->in[9], A_->in[20], A_->in[12], A_->in[13], A_->in[14], A_->in[15]}; phase_weff(P_, A_->ws, gw, NGW, lane); } }
    if (!EVF) SEAM(3);
    if (IN(4)) { PHASE_VARS; EVW(9); pg8::Gemm g{(const bf16*)WSP(WS_XN), (const bf16*)WSP(WS_WIN), M, NIN, D}; pg8::StaticOrder S; S.init(M, NIN, G, bx);
        pg8::EpiBf16N E{(bf16*)WSP(WS_Q), (const float*)WSP(WS_BW2), (const float*)WSP(WS_SSQ1), (size_t)(WS_K - WS_Q) / 2, AW, NIN, AW, SEQ / 256, attn_body::C2, 0};
        pg8::gemm_phase<pg8::EpiBf16N, pg8::StaticOrder, PG8_ALIGN, PG8_SP2>(lds + RING_OFF, g, S, E);
        EVA(10); WFILL(WI_OUT, WI_MH); }
    if (!EVF) SEAM(4);
    const bool EVR = EV_ON && lo <= 5 && hi >= 9;
    enum { EV_MOD = 0, EV_K = 1, EV_P = 2, EV_S = 3, EV_D = 4, EV_A = 5, EV_T = 6 };
    if (IN(5)) { PHASE_VARS; EVW(10);
        phase_kmean((const bf16*)WSP(WS_K), (float*)WSP(WS_KMEAN), lds, vcu, G, tid);
        if (EVR) ev_arrive(bar, (unsigned*)WSP(WS_CTL), EV_K);
        mlstm_pre_phase((const bf16*)WSP(WS_XM), A_->in[10], A_->in[11], (const bf16*)WSP(WS_WQM), (const bf16*)WSP(WS_WKM), (const bf16*)WSP(WS_WVM), (const bf16*)WSP(WS_WEC), (const bf16*)WSP(WS_WEM),
                        (bf16*)WSP(WS_XC), (bf16*)WSP(WS_QM), (bf16*)WSP(WS_KMT), (bf16*)WSP(WS_VMT), (float*)WSP(WS_GP), lds, vcu, G, tid);
        if (EVR) ev_arrive(bar, (unsigned*)WSP(WS_CTL), EV_P);
    }
    if (!EVR) SEAM(5);
    if (IN(6)) { PHASE_VARS;
        if (EVR) ev_wait(bar, (unsigned*)WSP(WS_CTL), EV_K);
        phase_topk((const bf16*)WSP(WS_Q), (const float*)WSP(WS_KMEAN), (unsigned short*)WSP(WS_SEL), lds, vcu, G, tid);
        __syncthreads();
        if (EVR) { ev_arrive(bar, (unsigned*)WSP(WS_CTL), EV_S); ev_wait(bar, (unsigned*)WSP(WS_CTL), EV_P); }
        mlstm_chunkstate_phase((const bf16*)WSP(WS_KMT), (const bf16*)WSP(WS_VMT), (const float*)WSP(WS_GP), A_->in[16], (float*)WSP(WS_DST), (float*)WSP(WS_GSUP), lds, vcu, G, tid);
        if (EVR) ev_arrive(bar, (unsigned*)WSP(WS_CTL), EV_D);
    }
    if (!EVR) SEAM(6);
    if (IN(7)) { PHASE_VARS;
        if (!EVR) phase_scan((const float*)WSP(WS_DST), (const float*)WSP(WS_GSUP), (bf16*)WSP(WS_SST), gtid, NTH);
        else ev_wait(bar, (unsigned*)WSP(WS_CTL), EV_S);
        const attn_body::AttnTensors AT{(const attn_body::bf16*)WSP(WS_Q), (const attn_body::bf16*)WSP(WS_K), (const attn_body::bf16*)WSP(WS_V), (attn_body::bf16*)WSP(WS_CAT), (const unsigned short*)WSP(WS_SEL)};
        const attn_body::StaticOrder S(G, bx);
        for (int rep_ = 0; rep_ < 1 + DUP_ATTN; ++rep_) attn_body::attn_phase<attn_body::StaticOrder>((char*)lds_raw + RING_OFF, AT, S);
        if (EVR) { ev_arrive(bar, (unsigned*)WSP(WS_CTL), EV_A); ev_wait(bar, (unsigned*)WSP(WS_CTL), EV_D);
            phase_scan((const float*)WSP(WS_DST), (const float*)WSP(WS_GSUP), (bf16*)WSP(WS_SST), gtid, NTH);
            ev_arrive(bar, (unsigned*)WSP(WS_CTL), EV_T); }
    }
    if (!EVR) SEAM(7);
    if (IN(8)) { PHASE_VARS;
        if (EVR) { ev_wait(bar, (unsigned*)WSP(WS_CTL), EV_A); catnorm_rows((bf16*)WSP(WS_CAT), A_->in[19], gw, NGW, lane); ev_wait(bar, (unsigned*)WSP(WS_CTL), EV_T); }
        mlstm_out_phase((const bf16*)WSP(WS_QM), (const bf16*)WSP(WS_KMT), (const bf16*)WSP(WS_VMT), (const float*)WSP(WS_GP), A_->in[16],
                        (const bf16*)WSP(WS_SST), (const bf16*)WSP(WS_XC), (const bf16*)WSP(WS_Z), A_->in[17], A_->in[18], (bf16*)WSP(WS_CAT), lds, vcu, G, tid);
        if (!EVR) catnorm_rows((bf16*)WSP(WS_CAT), A_->in[19], gw, NGW, lane);
        EVA(11); WFILL(WI_G2, WI_U2);
    }
    if (!EVF) SEAM(8);
    if (IN(9)) { PHASE_VARS; EVW(11); pg8::Gemm g{(const bf16*)WSP(WS_CAT), (const bf16*)WSP(WS_WOUT), M, D, D}; pg8::StaticOrder S; S.init(M, D, G, bx);
        pg8::EpiResidB E{(const pg8::bf16_t*)A_->out, (pg8::bf16_t*)A_->out + (size_t)M * D, (const float*)WSP(WS_MOD) + 5 * 8 * D, D, SEQ / 256, 1.0f, 0}; pg8::gemm_phase<pg8::EpiResidB, pg8::StaticOrder, PG8_ALIGN, PG8_SP2>(lds + RING_OFF, g, S, E);
        EVA(12); WFILL(WI_U2, WI_D1); }
    if (!EVF) SEAM(9);
    if (IN(10)) { PHASE_VARS; EVW(12); const float* MOD = (const float*)WSP(WS_MOD); modnorm_rows8b((const bf16*)A_->out + (size_t)M * D, MOD + 7 * 8 * D, MOD + 6 * 8 * D, WSP(WS_XN), gw, NGW, lane);
        EVA(13); WFILL(WI_D2, WI_IN); }
    if (!EVF) SEAM(10);
    if (IN(11)) { PHASE_VARS; EVW(13); pg8::Gemm g{(const bf16*)WSP(WS_XN), (const bf16*)WSP(WS_WGU2), M, NGU, D}; pg8::StaticOrder S; S.init(M, NGU, G, bx);
        pg8::EpiSwiGLU<true> E{A_->ws, (unsigned)WS_HB, 0u, 0u, FF, 1.0f / W8SCALE_UP, 0, SEQ / 256}; pg8::gemm_phase8<pg8::EpiSwiGLU<true>, pg8::StaticOrder, PG8_ALIGN, true>(lds + RING_OFF, g, S, E); }
    SEAM(11);
    if (IN(12)) { PHASE_VARS; pg8::Gemm g{(const bf16*)WSP(WS_HB), (const bf16*)WSP(WS_WD2), M, D, FF}; pg8::StaticOrder S; S.init(M, D, G, bx);
        pg8::EpiResidB E{(const pg8::bf16_t*)A_->out + (size_t)M * D, (pg8::bf16_t*)WSP(WS_XN), (const float*)WSP(WS_MOD) + 8 * 8 * D, D, SEQ / 256, 1.0f / W8SCALE_DN, 0}; pg8::gemm_phase8<pg8::EpiResidB, pg8::StaticOrder, PG8_ALIGN, true>(lds + RING_OFF, g, S, E); }
    SEAM(12);
    if (IN(13)) { PHASE_VARS; final_rows_b((const bf16*)WSP(WS_XN), A_->out, A_->in[25], gw, NGW, lane); }
#undef IN
#undef SEAM
}

extern "C" void kernel_launch(void* const* d_in, const int* in_sizes, int n_in, void* d_out, int out_size, void* d_ws, size_t ws_size, hipStream_t stream) {
    static int grid = 0;
    if (grid == 0) {
        if (n_in != 26 || in_sizes[0] != M * D || out_size != M * D || ws_size < WS_END) { fprintf(stderr, "kernel_launch: unexpected shapes (n_in %d, in0 %d, out %d, ws %zu); nothing launched\n", n_in, n_in > 0 ? in_sizes[0] : -1, out_size, ws_size); grid = -1; return; }
        int dev = 0, cus = 0, per_cu = 0;
        if (hipGetDevice(&dev) != hipSuccess || hipDeviceGetAttribute(&cus, hipDeviceAttributeMultiprocessorCount, dev) != hipSuccess) { grid = -1; return; }
        if (hipFuncSetAttribute((const void*)mk_fwd, hipFuncAttributeMaxDynamicSharedMemorySize, LDS_BYTES) != hipSuccess) { fprintf(stderr, "kernel_launch: hipFuncSetAttribute failed\n"); grid = -1; return; }
        if (hipOccupancyMaxActiveBlocksPerMultiprocessor(&per_cu, (const void*)mk_fwd, NWAVES * 64, LDS_BYTES) != hipSuccess || per_cu < 1) { fprintf(stderr, "kernel_launch: occupancy query says %d blocks per CU\n", per_cu); per_cu = 1; }
        (void)hipGetLastError();
        grid = cus;
        if (grid > 256) grid = 256;
    }
    if (grid < 0) return;
    if (hipMemsetAsync((char*)d_ws + WS_CTL, 0, CTL_ZERO_BYTES, stream) != hipSuccess) return;
    Args a{};
    for (int i = 0; i < 26; ++i) a.in[i] = (const float*)d_in[i];
    a.out = (float*)d_out; a.ws = (unsigned char*)d_ws;
#if MK_PER_PHASE
    for (int p = 0; p < NPHASE; ++p) { a.ph_lo = p; a.ph_hi = p + 1; hipLaunchKernelGGL(mk_fwd, dim3(grid), dim3(NWAVES * 64), LDS_BYTES, stream, a); }
#else
    a.ph_lo = 0; a.ph_hi = NPHASE;
    void* kargs[] = {&a};
    hipError_t e = hipLaunchCooperativeKernel((const void*)mk_fwd, dim3(grid), dim3(NWAVES * 64), kargs, LDS_BYTES, stream);
    if (e != hipSuccess) fprintf(stderr, "kernel_launch: cooperative launch failed: %s (grid %d)\n", hipGetErrorString(e), grid);
#endif
#ifdef PROBE_PH
    { Args b2 = a; b2.ph_lo = PROBE_PH; b2.ph_hi = PROBE_PH + 1; for (int r = 0; r < 2; ++r) hipLaunchKernelGGL(mk_fwd, dim3(grid), dim3(NWAVES * 64), LDS_BYTES, stream, b2); }
#endif
}
```
